# Optimizing an MI355X kernel written in HIP

```python
import jax, jax.numpy as jnp
from jax import lax
import numpy as np

D_MODEL = 1024
BATCH = 2
SEQ = 8192
DEPTH = 4

GRID_W = 64
NA_HEADS = 8
NA_HEAD_DIM = 64
NA_WIDTH = NA_HEADS * NA_HEAD_DIM
NA_KH_MAX = 8
NA_KW = 16
FN_GROUPS = 8
FN_GROUP_DIM = 64
FN_WIDTH = FN_GROUPS * FN_GROUP_DIM
LRU_BLOCKS = 8
LRU_BLOCK_DIM = 64
LRU_WIDTH = LRU_BLOCKS * LRU_BLOCK_DIM
LRU_C = 8.0
CONV_W = 4
CONV_PAD_LEFT = 2
N_BRANCH = 3
BRANCH_WIDTH = 512
SPLITS = [NA_WIDTH, 2 * NA_WIDTH, 3 * NA_WIDTH, 3 * NA_WIDTH + FN_WIDTH,
          3 * NA_WIDTH + FN_WIDTH + LRU_WIDTH, 3 * NA_WIDTH + FN_WIDTH + 2 * LRU_WIDTH]
IN_COLS = 3 * NA_WIDTH + FN_WIDTH + 2 * LRU_WIDTH + N_BRANCH * D_MODEL
D_FF = 3 * D_MODEL
N_EXPERTS = 8
TOP_K = 2
D_FF_EXPERT = D_FF // TOP_K
N_DENSE = (DEPTH + 1) // 2
N_MOE = DEPTH // 2
RMS_EPS = 1e-6

kernel_name = 'hybrid_na_fnet_rglru_moe_encoder'


def rms_norm(x, g):
    xf = x.astype(jnp.float32)
    y = xf * lax.rsqrt(jnp.mean(xf * xf, axis=-1, keepdims=True) + RMS_EPS)
    return (y * g.astype(jnp.float32)).astype(x.dtype)


def neighbourhood_attention(q, k, v, rpb, rows):
    b, s, _ = q.shape
    kh = min(NA_KH_MAX, rows)

    def to_grid(t):
        return t.reshape(b, rows, GRID_W, NA_HEADS, NA_HEAD_DIM).transpose(0, 3, 1, 2, 4)

    qg, kg, vg = to_grid(q), to_grid(k), to_grid(v)
    cols = np.arange(GRID_W)
    col_start = np.clip(cols - NA_KW // 2, 0, GRID_W - NA_KW)
    col_idx = col_start[:, None] + np.arange(NA_KW)[None, :]
    col_off = col_idx - cols[:, None] + (NA_KW - 1)
    rpb_c = rpb.astype(jnp.float32)[:, :, col_off]
    scale = NA_HEAD_DIM ** -0.5

    def one_row(r):
        rs = jnp.clip(r - kh // 2, 0, rows - kh)
        k_band = lax.dynamic_slice_in_dim(kg, rs, kh, axis=2)
        v_band = lax.dynamic_slice_in_dim(vg, rs, kh, axis=2)
        q_row = lax.dynamic_index_in_dim(qg, r, axis=2, keepdims=False)
        k_win = k_band[:, :, :, col_idx, :]
        v_win = v_band[:, :, :, col_idx, :]
        row_off = rs + jnp.arange(kh) - r + (NA_KH_MAX - 1)
        bias = jnp.take(rpb_c, row_off, axis=1).transpose(0, 2, 1, 3)
        scores = jnp.einsum('bhcd,bhicjd->bhcij', q_row, k_win,
                            preferred_element_type=jnp.float32) * scale + bias[None]
        p = jax.nn.softmax(scores.reshape(b, NA_HEADS, GRID_W, kh * NA_KW), axis=-1)
        p = p.reshape(scores.shape).astype(v.dtype)
        return jnp.einsum('bhcij,bhicjd->bhcd', p, v_win)

    out = lax.map(one_row, jnp.arange(rows))
    return out.transpose(1, 0, 3, 2, 4).reshape(b, s, NA_WIDTH)


def fourier_mix(u):
    b, s, _ = u.shape
    ug = u.astype(jnp.float32).reshape(b, s, FN_GROUPS, FN_GROUP_DIM)
    f = jnp.fft.fft2(ug, axes=(1, 3), norm='ortho').real
    return f.reshape(b, s, FN_WIDTH).astype(u.dtype)


def centred_depthwise_conv(u, w, bias):
    s = u.shape[1]
    up = jnp.pad(u, ((0, 0), (CONV_PAD_LEFT, CONV_W - 1 - CONV_PAD_LEFT), (0, 0)))
    y = up[:, 0:s] * w[0]
    for t in range(1, CONV_W):
        y = y + up[:, t:t + s] * w[t]
    return y + bias


def block_diag(u, w, bias):
    b, s, _ = u.shape
    ub = u.reshape(b, s, LRU_BLOCKS, LRU_BLOCK_DIM)
    return jnp.einsum('bsnc,ncd->bsnd', ub, w).reshape(b, s, LRU_WIDTH) + bias


def rg_lru_direction(u, wa, ba, wx, bx, lam, reverse):
    s = u.shape[1]
    uf = u.astype(jnp.float32)
    r = jax.nn.sigmoid(block_diag(u, wa, ba).astype(jnp.float32))
    i = jax.nn.sigmoid(block_diag(u, wx, bx).astype(jnp.float32))
    log_a = -LRU_C * r * jax.nn.softplus(-lam.astype(jnp.float32))
    a = jnp.exp(log_a)
    mult = jnp.sqrt(-jnp.expm1(2.0 * log_a))
    first = s - 1 if reverse else 0
    mult = jnp.where((jnp.arange(s) == first)[None, :, None], jnp.ones_like(mult), mult)
    bterm = mult * i * uf

    def combine(c1, c2):
        a1, b1 = c1
        a2, b2 = c2
        return a1 * a2, a2 * b1 + b2

    _, h = lax.associative_scan(combine, (a, bterm), axis=1, reverse=reverse)
    return h


def recurrent_branch(u_x, u_gate, conv_w, conv_b, wa, ba, wx, bx, lam):
    c = centred_depthwise_conv(u_x, conv_w, conv_b)
    h = (rg_lru_direction(c, wa[0], ba[0], wx[0], bx[0], lam[0], False)
         + rg_lru_direction(c, wa[1], ba[1], wx[1], bx[1], lam[1], True))
    return (h * jax.nn.gelu(u_gate.astype(jnp.float32))).astype(u_x.dtype)


def hybrid_mixer(xn, rows, w_in, b_in, rpb, conv_w, conv_b, wa, ba, wx, bx, lam, w_branch, w_out):
    b, s, d = xn.shape
    proj = xn @ w_in + b_in
    q, k, v, u_f, u_x, u_g, gates = jnp.split(proj, SPLITS, axis=-1)
    y_a = neighbourhood_attention(q, k, v, rpb, rows)
    y_b = fourier_mix(u_f)
    y_c = recurrent_branch(u_x, u_g, conv_w, conv_b, wa, ba, wx, bx, lam)
    br = jnp.stack([y_a, y_b, y_c], axis=2)
    y_br = jnp.einsum('bskc,kcd->bskd', br, w_branch)
    g = jax.nn.sigmoid(gates.astype(jnp.float32)).reshape(b, s, N_BRANCH, d)
    merged = jnp.sum(g * y_br.astype(jnp.float32), axis=2).astype(xn.dtype)
    return merged @ w_out


def swiglu(x, w_gu, w_down):
    g, u = jnp.split(x @ w_gu, 2, axis=-1)
    return (jax.nn.silu(g) * u) @ w_down


def moe_swiglu(x, w_router, w_gu, w_down):
    b, s, d = x.shape
    xt = x.reshape(b * s, d)
    logits = (xt @ w_router).astype(jnp.float32)
    top_v, top_i = lax.top_k(logits, TOP_K)
    top_w = jax.nn.softmax(top_v, axis=-1)
    comb = jnp.sum(jax.nn.one_hot(top_i, N_EXPERTS, dtype=jnp.float32) * top_w[..., None], axis=1)
    y = jnp.zeros((b * s, d), jnp.float32)
    for e in range(N_EXPERTS):
        y = y + comb[:, e:e + 1] * swiglu(xt, w_gu[e], w_down[e]).astype(jnp.float32)
    return y.astype(x.dtype).reshape(b, s, d)


def setup_inputs(seed: int = 0) -> dict:
    key = jax.random.key(seed)
    ks = jax.random.split(key, 24)
    f32 = jnp.float32

    def nrm(kk, shape, scale):
        return jax.random.normal(kk, shape, f32) * scale

    a_c = jax.random.uniform(ks[11], (DEPTH, 2, LRU_WIDTH), f32, 0.9, 0.999)
    a_base = a_c ** (1.0 / LRU_C)
    lru_lambda = jnp.log(a_base) - jnp.log1p(-a_base)
    return {
        'x': nrm(ks[0], (BATCH, SEQ, D_MODEL), 1.0),
        'norm_mix_g': 1.0 + nrm(ks[1], (DEPTH, D_MODEL), 0.02),
        'w_in': nrm(ks[2], (DEPTH, D_MODEL, IN_COLS), D_MODEL ** -0.5),
        'b_in': nrm(ks[3], (DEPTH, IN_COLS), 0.02),
        'na_rpb': nrm(ks[4], (DEPTH, NA_HEADS, 2 * NA_KH_MAX - 1, 2 * NA_KW - 1), 0.02),
        'conv_w': nrm(ks[5], (DEPTH, CONV_W, LRU_WIDTH), CONV_W ** -0.5),
        'conv_b': nrm(ks[6], (DEPTH, LRU_WIDTH), 0.02),
        'lru_wa': nrm(ks[7], (DEPTH, 2, LRU_BLOCKS, LRU_BLOCK_DIM, LRU_BLOCK_DIM), LRU_BLOCK_DIM ** -0.5),
        'lru_ba': nrm(ks[8], (DEPTH, 2, LRU_WIDTH), 0.02),
        'lru_wx': nrm(ks[9], (DEPTH, 2, LRU_BLOCKS, LRU_BLOCK_DIM, LRU_BLOCK_DIM), LRU_BLOCK_DIM ** -0.5),
        'lru_bx': nrm(ks[10], (DEPTH, 2, LRU_WIDTH), 0.02),
        'lru_lambda': lru_lambda,
        'w_branch': nrm(ks[12], (DEPTH, N_BRANCH, BRANCH_WIDTH, D_MODEL), BRANCH_WIDTH ** -0.5),
        'w_out': nrm(ks[13], (DEPTH, D_MODEL, D_MODEL), D_MODEL ** -0.5),
        'norm_ffn_g': 1.0 + nrm(ks[14], (DEPTH, D_MODEL), 0.02),
        'ffn_w_gu': nrm(ks[15], (N_DENSE, D_MODEL, 2 * D_FF), D_MODEL ** -0.5),
        'ffn_w_down': nrm(ks[16], (N_DENSE, D_FF, D_MODEL), D_FF ** -0.5),
        'router_w': nrm(ks[17], (N_MOE, D_MODEL, N_EXPERTS), D_MODEL ** -0.5),
        'moe_w_gu': nrm(ks[18], (N_MOE, N_EXPERTS, D_MODEL, 2 * D_FF_EXPERT), D_MODEL ** -0.5),
        'moe_w_down': nrm(ks[19], (N_MOE, N_EXPERTS, D_FF_EXPERT, D_MODEL), D_FF_EXPERT ** -0.5),
        'final_g': 1.0 + nrm(ks[20], (D_MODEL,), 0.02),
    }


def reference(x, norm_mix_g, w_in, b_in, na_rpb, conv_w, conv_b, lru_wa, lru_ba, lru_wx, lru_bx,
              lru_lambda, w_branch, w_out, norm_ffn_g, ffn_w_gu, ffn_w_down, router_w, moe_w_gu,
              moe_w_down, final_g):
    rows = x.shape[1] // GRID_W
    h = x
    for l in range(DEPTH):
        xn = rms_norm(h, norm_mix_g[l])
        h = h + hybrid_mixer(xn, rows, w_in[l], b_in[l], na_rpb[l], conv_w[l], conv_b[l],
                             lru_wa[l], lru_ba[l], lru_wx[l], lru_bx[l], lru_lambda[l],
                             w_branch[l], w_out[l])
        xn = rms_norm(h, norm_ffn_g[l])
        if l % 2 == 0:
            h = h + swiglu(xn, ffn_w_gu[l // 2], ffn_w_down[l // 2])
        else:
            h = h + moe_swiglu(xn, router_w[l // 2], moe_w_gu[l // 2], moe_w_down[l // 2])
    return rms_norm(h, final_g)
```

```cpp
#include <hip/hip_runtime.h>
#include <cstdio>
#include <cstdint>

#ifndef ABL
#define ABL 0
#endif
#define LAS __attribute__((address_space(3)))
#define GAS __attribute__((address_space(1)))
typedef unsigned short bf16;
typedef short bf16x8 __attribute__((ext_vector_type(8)));
typedef short s16x4 __attribute__((ext_vector_type(4)));
typedef float f32x4 __attribute__((ext_vector_type(4)));
typedef float f32x2 __attribute__((ext_vector_type(2)));
typedef unsigned u32x4 __attribute__((ext_vector_type(4)));
typedef unsigned u32x2 __attribute__((ext_vector_type(2)));
typedef __bf16 bf16x2_t __attribute__((ext_vector_type(2)));
typedef GAS unsigned gu32;
#define RLX_AGENT __ATOMIC_RELAXED, __HIP_MEMORY_SCOPE_AGENT
#define LDS_WAIT() asm volatile("s_waitcnt lgkmcnt(0)" ::: "memory")
#define VM_WAIT() asm volatile("s_waitcnt vmcnt(0)" ::: "memory")

constexpr int NB = 2, SEQ = 8192, M = NB * SEQ, D = 1024, DEPTH = 4;
constexpr int INC = 6144;
constexpr int PPITCH = 6208;
constexpr int VTP = 8256;
constexpr int C_Q = 0, C_K = 512, C_V = 1024, C_UF = 1536, C_UX = 2048, C_UG = 2560, C_GATE = 3072;
constexpr int BRP = 2112;
constexpr int DFF = 3072, DFE = 1536, NEXP = 8;
constexpr float RMS_EPS = 1e-6f;
constexpr int NWAVES = 8;

constexpr size_t MiB = 1u << 20;
constexpr size_t WS_CTL = 0, CTL_ZERO_BYTES = 1 * MiB;
constexpr size_t WS_WIN = 1 * MiB;
constexpr size_t WS_WBR = 714 * MiB;
constexpr size_t WS_WOUT = 65 * MiB;
constexpr size_t WS_WGU = 73 * MiB;
constexpr size_t WS_WDN = 97 * MiB;
constexpr size_t WS_MGU = 109 * MiB;
constexpr size_t WS_MDN = 205 * MiB;
constexpr size_t WS_WL = 253 * MiB;
constexpr size_t WS_MISC = 254 * MiB;
constexpr size_t WS_LSUM = 255 * MiB;
constexpr size_t WS_MOEI = 257 * MiB;
constexpr size_t WS_HB = 259 * MiB;
constexpr size_t WS_HB8 = 291 * MiB;
constexpr size_t WS_WIN8 = 630 * MiB;
constexpr size_t WS_BR = 647 * MiB;
constexpr size_t WS_TP = 371 * MiB;
constexpr size_t WS_MERGED = 403 * MiB;
constexpr size_t WS_PROJ = 435 * MiB;
constexpr size_t WS_HID = 435 * MiB;
constexpr size_t WS_YBUF = 537 * MiB;
constexpr size_t WS_RS = 629 * MiB;
constexpr size_t WS_END = 731 * MiB;
constexpr int CW_BAR = 4096;
constexpr int CW_MOE = 16384;

constexpr int LDS_BYTES = 147456;
constexpr int SCR_BYTES = 139264;
constexpr int MISC_OFF = SCR_BYTES;

__device__ __forceinline__ unsigned pk2(float lo, float hi) { f32x2 v = {lo, hi}; bf16x2_t b = __builtin_convertvector(v, bf16x2_t); return __builtin_bit_cast(unsigned, b); }
__device__ __forceinline__ int opaque_i(int v) { asm volatile("" : "+v"(v)); return v; }
__device__ __forceinline__ int lane_id() { int l; asm volatile("v_mbcnt_lo_u32_b32 %0, -1, 0\n\tv_mbcnt_hi_u32_b32 %0, -1, %0" : "=&v"(l)); return l; }
__device__ __forceinline__ int tid_of(int wave0) { int w = wave0; asm volatile("" : "+s"(w)); return opaque_i(w * 64 + lane_id()); }
__device__ __forceinline__ float bf2f(unsigned short x) { return __uint_as_float((unsigned)x << 16); }
__device__ __forceinline__ float bflo(unsigned x) { return __uint_as_float(x << 16); }
__device__ __forceinline__ float bfhi(unsigned x) { return __uint_as_float(x & 0xffff0000u); }
__device__ __forceinline__ float wave_sum(float v) {
#pragma unroll
    for (int o = 1; o < 64; o <<= 1) v += __shfl_xor(v, o);
    return v;
}
constexpr float RS_SCALE = 16777216.0f;
constexpr float W8S = 64.0f, H8S = 8.0f;
typedef int i32x8 __attribute__((ext_vector_type(8)));
__device__ __forceinline__ float sat8(float x) { return __builtin_amdgcn_fmed3f(x, -448.0f, 448.0f); }
__device__ __forceinline__ unsigned pk4_fp8(float a, float b, float c, float d) { int r = 0; a = sat8(a); b = sat8(b); c = sat8(c); d = sat8(d); r = __builtin_amdgcn_cvt_pk_fp8_f32(a, b, r, false); r = __builtin_amdgcn_cvt_pk_fp8_f32(c, d, r, true); return (unsigned)r; }
__device__ __forceinline__ float rs_rstd(unsigned long long v) { return __builtin_amdgcn_rsqf((float)v * (1.0f / (RS_SCALE * D)) + RMS_EPS); }
__device__ __forceinline__ float fast_sigmoid(float x) { return __builtin_amdgcn_rcpf(1.0f + __builtin_amdgcn_exp2f(-1.44269504f * x)); }
__device__ __forceinline__ float gelu_tanh(float x) { const float z = 0.7978845608f * (x + 0.044715f * x * x * x); return x * fast_sigmoid(2.0f * z); }

namespace pg8 {
constexpr int BM = 256, BK = 64, HALF = 128, HTB = HALF * BK * 2, STAGE_BYTES = 8 * HTB, NXCD = 8, WGM = 8;
__host__ __device__ __forceinline__ int lds_byte(int r, int c) { const int st = (r >> 4) * 2 + (c >> 5), rr = r & 15, cc = c & 31, ob = rr * 64 + cc * 2; return st * 1024 + (ob ^ (((ob >> 9) & 1) << 5)); }
__host__ __device__ __forceinline__ void stage_rc(int b, int& R, int& C) { const int st = b / 1024, sb = b % 1024, swz = sb ^ (((sb >> 9) & 1) << 5); R = (st >> 1) * 16 + swz / 64; C = (st & 1) * 32 + (swz % 64) / 2; }
__host__ __device__ __forceinline__ int perm32(int rho) { const int n = rho >> 4, i = rho & 15; return 8 * (i >> 2) + 4 * n + (i & 3); }

struct Unit { int pm, pn, sub, aux; };
__device__ __forceinline__ bool tile_of(long L, int nM, int nN, int& pm, int& pn) {
    const int nwg = nM * nN; if (L >= nwg) return false;
    int wgid = (int)L; { const int q = nwg / NXCD, r = nwg % NXCD, xcd = wgid % NXCD, off = wgid / NXCD; wgid = (xcd < r ? xcd * (q + 1) : r * (q + 1) + (xcd - r) * q) + off; }
    const int nig = WGM * nN, gid = wgid / nig, fm = gid * WGM, gsz = (nM - fm) < WGM ? (nM - fm) : WGM;
    pm = fm + ((wgid % nig) % gsz); pn = (wgid % nig) / gsz; return true;
}
struct SchedPlain {
    const char* A; const char* B; int lda2, ldb2, nt, nM, nN, G, c;
    __device__ __forceinline__ bool next(int i, Unit& u) const { u.sub = 0; u.aux = 0; return tile_of((long)i * G + c, nM, nN, u.pm, u.pn); }
    __device__ __forceinline__ const char* a_ptr(const Unit& u) const { return A + (size_t)u.pm * 256 * lda2; }
    __device__ __forceinline__ const char* b_ptr(const Unit& u) const { return B + (size_t)u.pn * 256 * ldb2; }
    __device__ __forceinline__ int ntiles(const Unit&) const { return nt; }
    __device__ __forceinline__ unsigned row_off(const Unit&, int) const { return 0u; }
};
struct SchedMerge {
    const char* A; const char* B; int lda2, ldb2, nM, nN, G, c;
    __device__ __forceinline__ bool next(int i, Unit& u) const { u.sub = i % 3; u.aux = 0; return tile_of((long)(i / 3) * G + c, nM, nN, u.pm, u.pn); }
    __device__ __forceinline__ int koff(const Unit& u) const { return u.sub == 0 ? 0 : (u.sub == 1 ? 512 : 1536); }
    __device__ __forceinline__ const char* a_ptr(const Unit& u) const { return A + (size_t)u.pm * 256 * lda2 + koff(u) * 2; }
    __device__ __forceinline__ const char* b_ptr(const Unit& u) const { return B + (size_t)u.pn * 256 * ldb2 + koff(u) * 2; }
    __device__ __forceinline__ int ntiles(const Unit& u) const { return u.sub == 1 ? 16 : 8; }
    __device__ __forceinline__ unsigned row_off(const Unit&, int) const { return 0u; }
};
struct SchedMoe {
    const char* A; const char* B; const int* list; int lda2, ldb2, nt, nN, G, c; size_t bstride; bool gather;
    int t1, t2, t3, t4, t5, t6, t7, t8;
    const unsigned* cntp;
    __device__ __forceinline__ bool next(int i, Unit& u) const {
        if (!tile_of((long)i * G + c, t8, nN, u.pm, u.pn)) return false;
        const int pm = u.pm; int e = 0, a = 0;
        if (pm >= t1) { e = 1; a = t1; } if (pm >= t2) { e = 2; a = t2; } if (pm >= t3) { e = 3; a = t3; } if (pm >= t4) { e = 4; a = t4; }
        if (pm >= t5) { e = 5; a = t5; } if (pm >= t6) { e = 6; a = t6; } if (pm >= t7) { e = 7; a = t7; }
        u.sub = e; u.aux = a; return true;
    }
    __device__ __forceinline__ int cnt_of(int e) const { return __builtin_amdgcn_readfirstlane((int)cntp[e * 64]); }
    __device__ __forceinline__ const char* a_ptr(const Unit& u) const { return gather ? A : A + (size_t)u.pm * 256 * lda2; }
    __device__ __forceinline__ const char* b_ptr(const Unit& u) const { return B + (size_t)u.sub * bstride + (size_t)u.pn * 256 * ldb2; }
    __device__ __forceinline__ int ntiles(const Unit&) const { return nt; }
    __device__ __forceinline__ unsigned row_off(const Unit& u, int lrow) const {
        const int pos = (u.pm - u.aux) * 256 + lrow; const int cn = cnt_of(u.sub);
        const int tok = list[u.sub * 16384 + (pos < cn ? pos : 0)];
        return (unsigned)tok * (unsigned)lda2;
    }
};

template <class Epi, class Sched, bool ALIGN_EPI, bool GATHER, bool FP8 = false>
__device__ __forceinline__ void gemm_phase(LAS unsigned char* lds, const Sched& S, const Epi& E, int wave0) {
    const int tid = tid_of(wave0), wid = __builtin_amdgcn_readfirstlane(tid >> 6), lane = tid & 63, wr = wid >> 2, wc = wid & 3, fr = lane & 15, fq = lane >> 4;
    const int lda2 = S.lda2, ldb2 = S.ldb2;
    unsigned vA0[2], vA1[2], voffB[2];
    LAS unsigned* rowtab = (LAS unsigned*)(lds + STAGE_BYTES);
#pragma unroll
    for (int i = 0; i < 2; ++i) { int R, C; stage_rc(tid * 16 + i * 8192, R, C); const int Rb = Epi::PERM ? ((R & ~31) + perm32(R & 31)) : R;
        voffB[i] = (unsigned)(Rb * ldb2 + C * 2); vA0[i] = (unsigned)(R * lda2 + C * 2); vA1[i] = vA0[i] + (unsigned)(HALF * lda2); }
    const size_t kstep = (size_t)(BK * 2);
    const size_t hstepB = (size_t)HALF * ldb2;
    const unsigned ldsw = (unsigned)wid * 1024u;
    const int aoff = lds_byte(wr * 64 + fr, fq * 8), boff = lds_byte(wc * 32 + fr, fq * 8);
#define PG8_SA(b, h) (((b) * 2 + (h)) * HTB)
#define PG8_SB(b, h) ((4 + (b) * 2 + (h)) * HTB)
#define PG8_STAGE(bufoff, gbase, voff) do { _Pragma("unroll") for (int _i = 0; _i < 2; ++_i) \
        __builtin_amdgcn_global_load_lds((const unsigned*)((const char*)(gbase) + (voff)[_i]), (LAS unsigned*)(lds + (bufoff) + ldsw + _i * 8192), 16, 0, 0); } while (0)
#define PG8_LDA(dst, b, h) do { if constexpr (FP8) { _Pragma("unroll") for (int m = 0; m < 4; ++m) { const u32x4 lo_ = *(const LAS u32x4*)(lds + PG8_SA(b, h) + aoff + m * 2048), hi_ = *(const LAS u32x4*)(lds + PG8_SA(b, h) + aoff + m * 2048 + 1024); \
        dst##8[m] = __builtin_bit_cast(i32x8, __builtin_shufflevector(lo_, hi_, 0, 1, 2, 3, 4, 5, 6, 7)); } } \
    else { _Pragma("unroll") for (int m = 0; m < 4; ++m) _Pragma("unroll") for (int k = 0; k < 2; ++k) dst[m][k] = *(const LAS bf16x8*)(lds + PG8_SA(b, h) + aoff + m * 2048 + k * 1024); } } while (0)
#define PG8_LDB(dst, b, h) do { if constexpr (FP8) { _Pragma("unroll") for (int n = 0; n < 2; ++n) { const u32x4 lo_ = *(const LAS u32x4*)(lds + PG8_SB(b, h) + boff + n * 2048), hi_ = *(const LAS u32x4*)(lds + PG8_SB(b, h) + boff + n * 2048 + 1024); \
        dst##8[n] = __builtin_bit_cast(i32x8, __builtin_shufflevector(lo_, hi_, 0, 1, 2, 3, 4, 5, 6, 7)); } } \
    else { _Pragma("unroll") for (int n = 0; n < 2; ++n) _Pragma("unroll") for (int k = 0; k < 2; ++k) dst[n][k] = *(const LAS bf16x8*)(lds + PG8_SB(b, h) + boff + n * 2048 + k * 1024); } } while (0)
#define PG8_MMA(ai, bj, At, Bt) do { __builtin_amdgcn_s_setprio(1); _Pragma("unroll") for (int m = 0; m < 4; ++m) _Pragma("unroll") for (int n = 0; n < 2; ++n) { \
        if constexpr (FP8) asm volatile("v_mfma_scale_f32_16x16x128_f8f6f4 %0, %1, %2, %0, %3, %3 op_sel_hi:[0,0,0]" : "+v"(acc[ai][bj][m][n]) : "v"(Bt##8[n]), "v"(At##8[m]), "v"(sc1)); \
        else { _Pragma("unroll") for (int k = 0; k < 2; ++k) acc[ai][bj][m][n] = __builtin_amdgcn_mfma_f32_16x16x32_bf16(Bt[n][k], At[m][k], acc[ai][bj][m][n], 0, 0, 0); } } \
        __builtin_amdgcn_s_setprio(0); } while (0)
#define PG8_WAIT_V(n) asm volatile("s_waitcnt vmcnt(" #n ")" ::: "memory")
#define PG8_WAIT_L(n) asm volatile("s_waitcnt lgkmcnt(" #n ")" ::: "memory")
#define PG8_BAR __builtin_amdgcn_s_barrier()
#define PG8_SCHED __builtin_amdgcn_sched_barrier(0)
    Unit cur, nxt; int ui = 0;
    if (!S.next(0, cur)) return;
    f32x4 acc[2][2][4][2];
#pragma unroll
    for (int a = 0; a < 2; ++a)
#pragma unroll
        for (int b = 0; b < 2; ++b)
#pragma unroll
            for (int m = 0; m < 4; ++m)
#pragma unroll
                for (int n = 0; n < 2; ++n) acc[a][b][m][n] = (f32x4){0.f, 0.f, 0.f, 0.f};
    bf16x8 At[4][2], B0[2][2], B1[2][2];
    i32x8 At8[4], B08[2], B18[2]; const int sc1 = 0x7F7F7F7F;
    const char* cA = S.a_ptr(cur); const char* cB = S.b_ptr(cur); int nt = S.ntiles(cur);
    if constexpr (GATHER) {
#pragma unroll
        for (int i = 0; i < 2; ++i) { int R, C; stage_rc(tid * 16 + i * 8192, R, C); vA0[i] = S.row_off(cur, R) + (unsigned)(C * 2); vA1[i] = S.row_off(cur, HALF + R) + (unsigned)(C * 2); }
    }
    PG8_STAGE(PG8_SB(0, 0), cB, voffB); PG8_STAGE(PG8_SB(0, 1), cB + hstepB, voffB); PG8_STAGE(PG8_SA(0, 0), cA, vA0); PG8_STAGE(PG8_SA(0, 1), cA, vA1);
    if (wr == 1) PG8_BAR;
    PG8_WAIT_V(2); PG8_BAR;
    PG8_STAGE(PG8_SB(1, 0), cB + kstep, voffB); PG8_STAGE(PG8_SA(1, 0), cA + kstep, vA0); PG8_STAGE(PG8_SB(1, 1), cB + hstepB + kstep, voffB);
    PG8_WAIT_V(6); PG8_BAR;
    for (;;) {
        const bool has_next = S.next(ui + 1, nxt);
        const char* nA = has_next ? S.a_ptr(nxt) : cA; const char* nB = has_next ? S.b_ptr(nxt) : cB;
        LAS unsigned char* etab = lds + STAGE_BYTES + 2048 + (ui & 1) * 3072;
        E.prefetch(etab, cur, tid, wid);
        for (int t = 0; t < nt; t += 2) {
            const bool last = (t == nt - 2);
            const char* a1 = cA + (size_t)(t + 1) * kstep;
            const char* a2 = last ? nA : cA + (size_t)(t + 2) * kstep; const char* b2 = last ? nB : cB + (size_t)(t + 2) * kstep;
            const char* a3 = a2 + kstep; const char* b3 = b2 + kstep;
            if constexpr (GATHER) { if (last && has_next) { if (tid < 256) rowtab[tid] = S.row_off(nxt, tid); } }
            PG8_LDB(B0, 0, 0); PG8_LDB(B1, 0, 1); PG8_SCHED; PG8_LDA(At, 0, 0); PG8_STAGE(PG8_SA(1, 1), a1, vA1);
            PG8_WAIT_V(8); PG8_WAIT_L(0); PG8_BAR; PG8_MMA(0, 0, At, B0); PG8_MMA(0, 1, At, B1); PG8_BAR; PG8_SCHED;
            if constexpr (GATHER) { if (last && has_next) {
_Pragma("unroll") for (int i = 0; i < 2; ++i) { int R, C; stage_rc(tid * 16 + i * 8192, R, C); vA0[i] = rowtab[R] + (unsigned)(C * 2); vA1[i] = rowtab[HALF + R] + (unsigned)(C * 2); } } }
            PG8_LDA(At, 0, 1); PG8_STAGE(PG8_SB(0, 0), b2, voffB); PG8_STAGE(PG8_SB(0, 1), b2 + hstepB, voffB); PG8_STAGE(PG8_SA(0, 0), a2, vA0);
            PG8_WAIT_V(8); PG8_WAIT_L(0); PG8_BAR; PG8_MMA(1, 0, At, B0); PG8_MMA(1, 1, At, B1); PG8_BAR; PG8_SCHED;
            PG8_LDB(B0, 1, 0); PG8_LDB(B1, 1, 1); PG8_SCHED; PG8_LDA(At, 1, 0); PG8_STAGE(PG8_SA(0, 1), a2, vA1);
            PG8_WAIT_V(8); PG8_WAIT_L(0); PG8_BAR; PG8_MMA(0, 0, At, B0); PG8_MMA(0, 1, At, B1); PG8_BAR; PG8_SCHED;
            PG8_LDA(At, 1, 1); PG8_STAGE(PG8_SB(1, 0), b3, voffB); PG8_STAGE(PG8_SB(1, 1), b3 + hstepB, voffB); PG8_STAGE(PG8_SA(1, 0), a3, vA0);
            PG8_WAIT_V(8); PG8_WAIT_L(0); PG8_BAR; PG8_MMA(1, 0, At, B0); PG8_MMA(1, 1, At, B1); PG8_BAR; PG8_SCHED;
        }
        if constexpr (ALIGN_EPI) { if (wr == 0) PG8_BAR; }
        if constexpr (FP8) asm volatile("s_nop 15\n\ts_nop 15" ::: "memory");
        E(acc, cur, wr, wc, opaque_i(fr), opaque_i(fq), etab);
        if (!has_next) break;
        if (!(Epi::CARRY && E.keep(cur))) {
#pragma unroll
            for (int a = 0; a < 2; ++a)
#pragma unroll
                for (int b = 0; b < 2; ++b)
#pragma unroll
                    for (int m = 0; m < 4; ++m)
#pragma unroll
                        for (int n = 0; n < 2; ++n) acc[a][b][m][n] = (f32x4){0.f, 0.f, 0.f, 0.f};
        }
        cur = nxt; cA = nA; cB = nB; nt = S.ntiles(cur); ++ui;
        if constexpr (ALIGN_EPI) { if (wr == 1) PG8_BAR; }
    }
    PG8_WAIT_V(0);
    if constexpr (!ALIGN_EPI) { if (wr == 0) PG8_BAR; }
    PG8_BAR;
#undef PG8_SA
#undef PG8_SB
#undef PG8_STAGE
#undef PG8_LDA
#undef PG8_LDB
#undef PG8_MMA
#undef PG8_WAIT_V
#undef PG8_WAIT_L
#undef PG8_BAR
#undef PG8_SCHED
}

struct EpiProj {
    static constexpr bool PERM = true, CARRY = false;
    bf16* P; bf16* VT; const float* bias; const unsigned long long* rs; int pn_off; float cs;
    __device__ __forceinline__ bool keep(const Unit&) const { return false; }
    __device__ __forceinline__ void prefetch(LAS unsigned char* etab, const Unit& u, int tid, int wid) const {
        __builtin_amdgcn_global_load_lds((const unsigned*)(rs + u.pm * BM) + tid, (LAS unsigned*)(etab + wid * 256), 4, 0, 0);
        if (wid < 4) __builtin_amdgcn_global_load_lds((const unsigned*)(bias + (u.pn + pn_off) * BM) + tid, (LAS unsigned*)(etab + 2048 + wid * 256), 4, 0, 0);
    }
    __device__ __forceinline__ void operator()(f32x4 (&acc)[2][2][4][2], const Unit& u, int wr, int wc, int fr, int fq, LAS unsigned char* etab) const {
        const int pn = u.pn + pn_off; const int row0 = u.pm * BM + wr * 64 + fr, colb = pn * BM + wc * 32 + 8 * fq;
        const int kind = (pn < 2) ? 0 : (pn < 10) ? 1 : (pn < 12) ? 3 : 4;
        unsigned long long rsv[8]; f32x4 bv[2][2];
#pragma unroll
        for (int k = 0; k < 8; ++k) rsv[k] = *(const LAS unsigned long long*)(etab + (wr * 64 + fr + (k >> 2) * HALF + (k & 3) * 16) * 8);
#pragma unroll
        for (int bj = 0; bj < 2; ++bj) { const LAS f32x4* bp = (const LAS f32x4*)(etab + 2048 + (wc * 32 + 8 * fq + bj * HALF) * 4); bv[bj][0] = bp[0]; bv[bj][1] = bp[1]; }
        __builtin_amdgcn_sched_barrier(0);
#pragma unroll
        for (int ai = 0; ai < 2; ++ai)
#pragma unroll
            for (int m = 0; m < 4; ++m) {
                const int row = row0 + ai * HALF + m * 16;
                const float sr = rs_rstd(rsv[ai * 4 + m]) * cs;
#pragma unroll
                for (int bj = 0; bj < 2; ++bj) {
                    float v[8];
                    const f32x4 bv0 = bv[bj][0], bv1 = bv[bj][1];
#pragma unroll
                    for (int i = 0; i < 4; ++i) { v[i] = acc[ai][bj][m][0][i] * sr + bv0[i]; v[4 + i] = acc[ai][bj][m][1][i] * sr + bv1[i]; }
                    if (kind == 0) {
#pragma unroll
                        for (int e = 0; e < 8; ++e) v[e] *= 0.125f;
                    } else if (kind == 3) {
#pragma unroll
                        for (int e = 0; e < 8; ++e) v[e] = gelu_tanh(v[e]);
                    } else if (kind == 4) {
#pragma unroll
                        for (int e = 0; e < 8; ++e) v[e] = fast_sigmoid(fminf(fmaxf(v[e], -30.f), 30.f));
                    }
                    { u32x4 w; w.x = pk2(v[0], v[1]); w.y = pk2(v[2], v[3]); w.z = pk2(v[4], v[5]); w.w = pk2(v[6], v[7]);
                      *(u32x4*)(P + (size_t)row * PPITCH + colb + bj * HALF) = w; }
                }
            }
    }
};
struct EpiMerge {
    static constexpr bool PERM = true, CARRY = true;
    const bf16* G; bf16* O;
    __device__ __forceinline__ bool keep(const Unit& u) const { return u.sub < 2; }
    __device__ __forceinline__ void prefetch(LAS unsigned char*, const Unit&, int, int) const {}
    __device__ __forceinline__ void operator()(f32x4 (&acc)[2][2][4][2], const Unit& u, int wr, int wc, int fr, int fq, LAS unsigned char* etab) const {
        const int row0 = u.pm * BM + wr * 64 + fr, colb = u.pn * BM + wc * 32 + 8 * fq, sub = u.sub;
#pragma unroll
        for (int ai = 0; ai < 2; ++ai) {
            u32x4 gk[4][2], gn[4][2];
#pragma unroll
            for (int m = 0; m < 4; ++m)
#pragma unroll
                for (int bj = 0; bj < 2; ++bj) {
                    const bf16* gp = G + (size_t)(row0 + ai * HALF + m * 16) * PPITCH + sub * D + colb + bj * HALF;
                    gk[m][bj] = *(const u32x4*)gp;
                    if (sub < 2) gn[m][bj] = *(const u32x4*)(gp + D);
                }
            __builtin_amdgcn_sched_barrier(0);
#pragma unroll
            for (int m = 0; m < 4; ++m) {
                const int row = row0 + ai * HALF + m * 16;
#pragma unroll
                for (int bj = 0; bj < 2; ++bj) {
                    const u32x4 g4 = gk[m][bj];
                    float f[8] = {bflo(g4.x), bfhi(g4.x), bflo(g4.y), bfhi(g4.y), bflo(g4.z), bfhi(g4.z), bflo(g4.w), bfhi(g4.w)};
                    if (sub < 2) {
                        const u32x4 n4 = gn[m][bj];
                        const float d[8] = {bflo(n4.x), bfhi(n4.x), bflo(n4.y), bfhi(n4.y), bflo(n4.z), bfhi(n4.z), bflo(n4.w), bfhi(n4.w)};
#pragma unroll
                        for (int e = 0; e < 8; ++e) f[e] *= __builtin_amdgcn_rcpf(d[e]);
                    }
#pragma unroll
                    for (int n = 0; n < 2; ++n)
#pragma unroll
                        for (int i = 0; i < 4; ++i) acc[ai][bj][m][n][i] *= f[n * 4 + i];
                    if (sub == 2) {
                        u32x4 w; w.x = pk2(acc[ai][bj][m][0][0], acc[ai][bj][m][0][1]); w.y = pk2(acc[ai][bj][m][0][2], acc[ai][bj][m][0][3]);
                        w.z = pk2(acc[ai][bj][m][1][0], acc[ai][bj][m][1][1]); w.w = pk2(acc[ai][bj][m][1][2], acc[ai][bj][m][1][3]);
                        *(u32x4*)(O + (size_t)row * D + colb + bj * HALF) = w;
                    }
                }
            }
        }
    }
};
struct EpiOut {
    static constexpr bool PERM = true, CARRY = false;
    bf16* hb; unsigned long long* rs; unsigned char* hb8; float cs;
    __device__ __forceinline__ bool keep(const Unit&) const { return false; }
    __device__ __forceinline__ void prefetch(LAS unsigned char*, const Unit&, int, int) const {}
    __device__ __forceinline__ void operator()(f32x4 (&acc)[2][2][4][2], const Unit& u, int wr, int wc, int fr, int fq, LAS unsigned char* etab) const {
        const int row0 = u.pm * BM + wr * 64 + fr, colb = u.pn * BM + wc * 32 + 8 * fq;
#pragma unroll
        for (int ai = 0; ai < 2; ++ai) {
            u32x4 hv[4][2];
#pragma unroll
            for (int m = 0; m < 4; ++m)
#pragma unroll
                for (int bj = 0; bj < 2; ++bj) hv[m][bj] = *(const u32x4*)(hb + (size_t)(row0 + ai * HALF + m * 16) * D + colb + bj * HALF);
            __builtin_amdgcn_sched_barrier(0);
#pragma unroll
            for (int m = 0; m < 4; ++m) {
                const int row = row0 + ai * HALF + m * 16; float ss = 0.f;
#pragma unroll
                for (int bj = 0; bj < 2; ++bj) {
                    bf16* hp = hb + (size_t)row * D + colb + bj * HALF;
                    const u32x4 h4 = hv[m][bj];
                    float v[8] = {bflo(h4.x), bfhi(h4.x), bflo(h4.y), bfhi(h4.y), bflo(h4.z), bfhi(h4.z), bflo(h4.w), bfhi(h4.w)};
#pragma unroll
                    for (int n = 0; n < 2; ++n)
#pragma unroll
                        for (int i = 0; i < 4; ++i) { v[n * 4 + i] += acc[ai][bj][m][n][i] * cs; ss += v[n * 4 + i] * v[n * 4 + i]; }
                    u32x4 w; w.x = pk2(v[0], v[1]); w.y = pk2(v[2], v[3]); w.z = pk2(v[4], v[5]); w.w = pk2(v[6], v[7]);
                    *(u32x4*)hp = w;
                    if (hb8) { u32x2 w8; w8.x = pk4_fp8(v[0], v[1], v[2], v[3]); w8.y = pk4_fp8(v[4], v[5], v[6], v[7]); *(u32x2*)(hb8 + (size_t)row * D + colb + bj * HALF) = w8; }
                }
                ss += __shfl_xor(ss, 16); ss += __shfl_xor(ss, 32);
                if (fq == 0) atomicAdd(rs + row, (unsigned long long)(ss * RS_SCALE));
            }
        }
    }
};
struct EpiGU {
    static constexpr bool PERM = true, CARRY = false;
    unsigned char* Hd; int ldh; const unsigned long long* rs; const float* srow; bool moe; float cs;
    __device__ __forceinline__ bool keep(const Unit&) const { return false; }
    __device__ __forceinline__ void prefetch(LAS unsigned char* etab, const Unit& u, int tid, int wid) const {
        if (moe) { if (wid < 4) __builtin_amdgcn_global_load_lds((const unsigned*)(srow + u.sub * 16384 + (u.pm - u.aux) * 256) + tid, (LAS unsigned*)(etab + wid * 256), 4, 0, 0); }
        else __builtin_amdgcn_global_load_lds((const unsigned*)(rs + u.pm * BM) + tid, (LAS unsigned*)(etab + wid * 256), 4, 0, 0);
    }
    __device__ __forceinline__ void operator()(f32x4 (&acc)[2][2][4][2], const Unit& u, int wr, int wc, int fr, int fq, LAS unsigned char* etab) const {
        const int lrow0 = wr * 64 + fr, hcol = u.pn * HALF + wc * 32 + 8 * fq;
        float srv[8];
#pragma unroll
        for (int k = 0; k < 8; ++k) { const int lrow = lrow0 + (k >> 2) * HALF + (k & 3) * 16;
            if (moe) srv[k] = *(const LAS float*)(etab + lrow * 4); else srv[k] = rs_rstd(*(const LAS unsigned long long*)(etab + lrow * 8)); }
        __builtin_amdgcn_sched_barrier(0);
#pragma unroll
        for (int ai = 0; ai < 2; ++ai)
#pragma unroll
            for (int m = 0; m < 4; ++m) {
                const int lrow = lrow0 + ai * HALF + m * 16; const int row = u.pm * BM + lrow;
                const float sr = srv[ai * 4 + m] * cs;
                float o[8];
#pragma unroll
                for (int n = 0; n < 2; ++n)
#pragma unroll
                    for (int i = 0; i < 4; ++i) { const float g = acc[ai][0][m][n][i] * sr, uu = acc[ai][1][m][n][i] * sr; o[n * 4 + i] = g * fast_sigmoid(g) * uu * H8S; }
                u32x2 w; w.x = pk4_fp8(o[0], o[1], o[2], o[3]); w.y = pk4_fp8(o[4], o[5], o[6], o[7]);
                *(u32x2*)(Hd + (size_t)row * ldh + hcol) = w;
            }
    }
};
struct EpiMoeDown {
    static constexpr bool PERM = true, CARRY = false;
    bf16* Y; const float* wslot;
    __device__ __forceinline__ bool keep(const Unit&) const { return false; }
    __device__ __forceinline__ void prefetch(LAS unsigned char* etab, const Unit& u, int tid, int wid) const {
        if (wid < 4) __builtin_amdgcn_global_load_lds((const unsigned*)(wslot + u.sub * 16384 + (u.pm - u.aux) * 256) + tid, (LAS unsigned*)(etab + wid * 256), 4, 0, 0);
    }
    __device__ __forceinline__ void operator()(f32x4 (&acc)[2][2][4][2], const Unit& u, int wr, int wc, int fr, int fq, LAS unsigned char* etab) const {
        const int lrow0 = wr * 64 + fr, colb = u.pn * BM + wc * 32 + 8 * fq;
        float wtv[8];
#pragma unroll
        for (int k = 0; k < 8; ++k) wtv[k] = *(const LAS float*)(etab + (lrow0 + (k >> 2) * HALF + (k & 3) * 16) * 4);
        __builtin_amdgcn_sched_barrier(0);
#pragma unroll
        for (int ai = 0; ai < 2; ++ai)
#pragma unroll
            for (int m = 0; m < 4; ++m) {
                const int lrow = lrow0 + ai * HALF + m * 16; const int row = u.pm * BM + lrow;
                const float wt = wtv[ai * 4 + m] * (1.0f / (W8S * H8S));
#pragma unroll
                for (int bj = 0; bj < 2; ++bj) {
                    const f32x4 v0 = acc[ai][bj][m][0] * wt, v1 = acc[ai][bj][m][1] * wt;
                    u32x4 w; w.x = pk2(v0[0], v0[1]); w.y = pk2(v0[2], v0[3]); w.z = pk2(v1[0], v1[1]); w.w = pk2(v1[2], v1[3]);
                    *(u32x4*)(Y + (size_t)row * D + colb + bj * HALF) = w;
                }
            }
    }
};
}

#define XB_TMO      128
#define XB_XCNT(j)  (256  + 64 * (j))
#define XB_XSUB(j)  (1280 + 64 * (j))
#define XB_XGEN(j)  (2304 + 64 * (j))
#define XB_TOP      3328
#define XB_TOPGEN   3392
#define XCD_BAR_WORDS 3456
#define XB_SPIN_CAP (1u << 18)
__device__ __forceinline__ unsigned xb_ld(unsigned* p)              { return __hip_atomic_load(p, __ATOMIC_RELAXED, __HIP_MEMORY_SCOPE_AGENT); }
__device__ __forceinline__ unsigned xb_add(unsigned* p, unsigned v) { return __hip_atomic_fetch_add(p, v, __ATOMIC_RELAXED, __HIP_MEMORY_SCOPE_AGENT); }
__device__ __forceinline__ unsigned xb_xcc_id() { return (unsigned)__builtin_amdgcn_s_getreg((3 << 11) | 20) & 0xFu; }
#define XB_SPIN(cond, bar) do { unsigned _sp = 0; while (cond) { __builtin_amdgcn_s_sleep(1); \
    if ((++_sp & 255u) == 0u) { if (xb_ld(&(bar)[XB_TMO])) break; if (_sp > XB_SPIN_CAP) { atomicAdd(&(bar)[XB_TMO], 1u); break; } } } } while (0)
struct XcdBarrier { unsigned* bar; unsigned x; volatile LAS unsigned* st; };
__device__ __forceinline__ XcdBarrier xcd_barrier_post(unsigned* bar, volatile LAS unsigned* st, int wave0) {
    XcdBarrier b; b.bar = bar; b.x = xb_xcc_id(); b.st = st;
    if (wave0 == 0 && lane_id() == 0) (void)xb_add(&bar[XB_XCNT(b.x)], 1u);
    return b;
}
__device__ __forceinline__ void xcd_barrier_complete(unsigned* bar, unsigned x, unsigned& nloc, unsigned& nx) {
    const unsigned G = gridDim.x * gridDim.y * gridDim.z;
    unsigned sum, cnt, mine, sp = 0u;
    for (;;) {
        sum = 0u; cnt = 0u; mine = 0u;
#pragma unroll
        for (unsigned j = 0; j < 16; ++j) { const unsigned c = xb_ld(&bar[XB_XCNT(j)]); sum += c; cnt += (c > 0u) ? 1u : 0u; mine = (j == x) ? c : mine; }
        if (sum == G) break;
        __builtin_amdgcn_s_sleep(1);
        if ((++sp & 255u) == 0u) { if (xb_ld(&bar[XB_TMO])) break; if (sp > XB_SPIN_CAP) { atomicAdd(&bar[XB_TMO], 1u); break; } }
    }
    nloc = mine > 0u ? mine : 1u; nx = cnt > 0u ? cnt : 1u;
}
__device__ __forceinline__ void xcd_barrier(const XcdBarrier& b, int wave0) {
    asm volatile("s_waitcnt vmcnt(0)" ::: "memory");
    __syncthreads();
    if (wave0 == 0 && lane_id() == 0) {
        unsigned* bar = b.bar;
        __builtin_amdgcn_s_waitcnt(0);
        unsigned nloc = b.st[0], nx = b.st[1];
        if (nloc == 0u) { xcd_barrier_complete(bar, b.x, nloc, nx); b.st[0] = nloc; b.st[1] = nx; }
        const unsigned old = xb_add(&bar[XB_XSUB(b.x)], 1u);
        const unsigned gen = old / nloc;
        if (old + 1u == (gen + 1u) * nloc) {
            __builtin_amdgcn_fence(__ATOMIC_RELEASE, "agent");
            asm volatile("s_waitcnt vmcnt(0)" ::: "memory");
            const unsigned og = xb_add(&bar[XB_TOP], 1u);
            const unsigned tg = og / nx;
            if (og + 1u == (tg + 1u) * nx) xb_add(&bar[XB_TOPGEN], 1u);
            else XB_SPIN(xb_ld(&bar[XB_TOPGEN]) == tg, bar);
            __builtin_amdgcn_fence(__ATOMIC_ACQUIRE, "agent");
            xb_add(&bar[XB_XGEN(b.x)], 1u);
            asm volatile("s_waitcnt vmcnt(0)" ::: "memory");
        } else {
            XB_SPIN(xb_ld(&bar[XB_XGEN(b.x)]) == gen, bar);
            __builtin_amdgcn_fence(__ATOMIC_ACQUIRE, "agent");
            asm volatile("s_waitcnt vmcnt(0)" ::: "memory");
        }
    }
    __syncthreads();
}

struct Args {
    const float* x; const float* norm_mix_g; const float* w_in; const float* b_in; const float* na_rpb; const float* conv_w; const float* conv_b;
    const float* lru_wa; const float* lru_ba; const float* lru_wx; const float* lru_bx; const float* lru_lambda; const float* w_branch; const float* w_out;
    const float* norm_ffn_g; const float* ffn_w_gu; const float* ffn_w_down; const float* router_w; const float* moe_w_gu; const float* moe_w_down; const float* final_g;
    float* out; unsigned char* ws; int ph_lo, ph_hi, bar_region, pad;
};
struct Frame {
    LAS unsigned char* lds;
    int tid, lane, wave, vcu, G;
    unsigned* ctl;
    float* H;
    bf16 *HB, *VT, *BR, *TP, *MERGED, *PROJ, *HID, *YBUF; unsigned char* HB8;
    bf16 *WIN, *WBR, *WOUT, *WGU, *WDN, *MGU, *MDN, *WL; unsigned char* WIN8;
    float *NSP, *GW; f32x2* LSUM; unsigned long long* RS;
    int* LIST; float* SROW; float* WSLOT; int* TOKI;
};

template <int STEP> __device__ __forceinline__ u32x4 dft_table_entry(int idx);
struct TrDesc { const float* W; const float* ks; unsigned char* WT; int ldw, k0, n0, ldwt, drow0, dcol0, fp8; };
__device__ __forceinline__ void tr_load(const TrDesc& d, float (&tv)[32], float (&kv)[32], int lane) {
#pragma unroll
    for (int i = 0; i < 32; ++i) tv[i] = __builtin_nontemporal_load(d.W + (size_t)(d.k0 + 2 * i + (lane >> 5)) * d.ldw + d.n0 + (lane & 31));
    if (d.ks) {
#pragma unroll
        for (int i = 0; i < 32; ++i) kv[i] = d.ks[d.k0 + 2 * i + (lane >> 5)];
    } else {
#pragma unroll
        for (int i = 0; i < 32; ++i) kv[i] = 1.0f;
    }
}
__device__ __forceinline__ void tr_store(const TrDesc& d, const float (&tv)[32], const float (&kv)[32], LAS float* scr, int lane) {
    const float sc = d.fp8 ? W8S : 1.0f;
#pragma unroll
    for (int i = 0; i < 32; ++i) scr[(2 * i + (lane >> 5)) * 33 + (lane & 31)] = tv[i] * kv[i] * sc;
    LDS_WAIT(); asm volatile("" ::: "memory");
    const int c = lane & 7;
#pragma unroll
    for (int j = 0; j < 4; ++j) { const int n = (lane >> 3) + 8 * j; const LAS float* s = scr + (8 * c) * 33 + n;
        if (d.fp8) { u32x2 o; o.x = pk4_fp8(s[0 * 33], s[1 * 33], s[2 * 33], s[3 * 33]); o.y = pk4_fp8(s[4 * 33], s[5 * 33], s[6 * 33], s[7 * 33]);
            *(u32x2*)(d.WT + (size_t)(d.drow0 + n) * d.ldwt + d.dcol0 + d.k0 + 8 * c) = o; }
        else { u32x4 o; o.x = pk2(s[0 * 33], s[1 * 33]); o.y = pk2(s[2 * 33], s[3 * 33]); o.z = pk2(s[4 * 33], s[5 * 33]); o.w = pk2(s[6 * 33], s[7 * 33]);
            *(u32x4*)((bf16*)d.WT + (size_t)(d.drow0 + n) * d.ldwt + d.dcol0 + d.k0 + 8 * c) = o; } }
    LDS_WAIT(); asm volatile("" ::: "memory");
}
__device__ __forceinline__ int gu_row(int n0, int half) { const int isu = n0 >= half ? 1 : 0; const int hid = n0 - isu * half; return 256 * (hid >> 7) + 128 * isu + (hid & 127); }
template <int STEP> __device__ __forceinline__ u32x4 dft_table_entry(int idx);
__device__ __forceinline__ const Args& fresh_args() { const Args* p = (const Args*)__builtin_amdgcn_kernarg_segment_ptr(); asm volatile("" : "+s"(p)); return *p; }
constexpr int I_IN = 16 * 192, I_BR = 8 * 32, I_OUT = 16 * 32, I_GU = 16 * 192, I_DN = 48 * 32, I_MGU = 16 * 96, I_MDN = 24 * 32;
constexpr int N_IN = 4 * I_IN, N_BR = 8 * I_BR, N_OUT = 4 * I_OUT, N_GU = 2 * I_GU, N_DN = 2 * I_DN, N_MGU = 16 * I_MGU, N_MDN = 16 * I_MDN;
constexpr int NITEMS = N_IN + N_BR + N_OUT + N_GU + N_DN + N_MGU + N_MDN;
__device__ __forceinline__ TrDesc tr_decode(Frame& F, int it) {
    const Args& a = fresh_args(); TrDesc d; d.ks = nullptr; d.dcol0 = 0; d.fp8 = 0;
    int r = it;
    if (r < N_IN) { const int l = r / I_IN, q = r % I_IN, half = q / (I_IN / 2), q2 = q % (I_IN / 2), kb = q2 / 96, nb = q2 % 96;
        d.W = a.w_in + (size_t)l * D * INC; d.ldw = INC; d.k0 = 64 * kb; d.ks = a.norm_mix_g + l * D; d.ldwt = D; d.drow0 = 32 * nb;
        if (half == 0) { d.n0 = 32 * nb; d.WT = (unsigned char*)(F.WIN + (size_t)l * INC * D); } else { d.n0 = 3072 + 32 * nb; d.WT = F.WIN8 + (size_t)l * 3072 * D; d.fp8 = 1; }
        return d; } r -= N_IN;
    if (r < N_BR) { const int lk = r / I_BR, l = lk >> 1, k = (lk & 1) * 2, q = r % I_BR, kb = q / 32, nb = q % 32;
        d.W = a.w_branch + ((size_t)(l * 3 + k) * 512) * D; d.ldw = D; d.k0 = 64 * kb; d.n0 = 32 * nb; d.WT = (unsigned char*)(F.WBR + (size_t)l * D * BRP); d.ldwt = BRP; d.drow0 = 32 * nb; d.dcol0 = k == 0 ? 0 : 1536; return d; } r -= N_BR;
    if (r < N_OUT) { const int l = r / I_OUT, q = r % I_OUT, kb = q / 32, nb = q % 32;
        d.W = a.w_out + (size_t)l * D * D; d.ldw = D; d.k0 = 64 * kb; d.n0 = 32 * nb; d.WT = (unsigned char*)(F.WOUT + (size_t)l * D * D); d.ldwt = D; d.drow0 = 32 * nb; return d; } r -= N_OUT;
    if (r < N_GU) { const int j = r / I_GU, q = r % I_GU, kb = q / 192, nb = q % 192;
        d.W = a.ffn_w_gu + (size_t)j * D * 2 * DFF; d.ldw = 2 * DFF; d.k0 = 64 * kb; d.n0 = 32 * nb; d.ks = a.norm_ffn_g + (2 * j) * D; d.WT = (unsigned char*)(F.WGU + (size_t)j * 2 * DFF * D); d.ldwt = D; d.drow0 = gu_row(32 * nb, DFF); return d; } r -= N_GU;
    if (r < N_DN) { const int j = r / I_DN, q = r % I_DN, kb = q / 32, nb = q % 32;
        d.W = a.ffn_w_down + (size_t)j * DFF * D; d.ldw = D; d.k0 = 64 * kb; d.n0 = 32 * nb; d.WT = (unsigned char*)F.WDN + (size_t)j * D * DFF; d.ldwt = DFF; d.drow0 = 32 * nb; d.fp8 = 1; return d; } r -= N_DN;
    if (r < N_MGU) { const int je = r / I_MGU, j = je >> 3, q = r % I_MGU, kb = q / 96, nb = q % 96;
        d.W = a.moe_w_gu + (size_t)je * D * 2 * DFE; d.ldw = 2 * DFE; d.k0 = 64 * kb; d.n0 = 32 * nb; d.ks = a.norm_ffn_g + (2 * j + 1) * D; d.WT = (unsigned char*)(F.MGU + (size_t)je * 2 * DFE * D); d.ldwt = D; d.drow0 = gu_row(32 * nb, DFE); return d; } r -= N_MGU;
    { const int je = r / I_MDN, q = r % I_MDN, kb = q / 32, nb = q % 32;
        d.W = a.moe_w_down + (size_t)je * DFE * D; d.ldw = D; d.k0 = 64 * kb; d.n0 = 32 * nb; d.WT = (unsigned char*)F.MDN + (size_t)je * D * DFE; d.ldwt = DFE; d.drow0 = 32 * nb; d.fp8 = 1; return d; }
}
__device__ __forceinline__ void p0_prologue(Frame& F, const Args& a_unused) {
    LAS float* scr = (LAS float*)(F.lds + F.wave * 16384);
    const int gw = F.vcu * NWAVES + F.wave, NGW = F.G * NWAVES, lane = F.lane;
    if (gw < NITEMS) {
        TrDesc dc = tr_decode(F, gw); float tv[32], kv[32];
        tr_load(dc, tv, kv, lane);
        for (int it = gw;;) {
            const int itn = it + NGW; const bool has = itn < NITEMS;
            TrDesc dn = dc; float tn[32], kn[32];
            if (has) { dn = tr_decode(F, itn); tr_load(dn, tn, kn, lane); }
            tr_store(dc, tv, kv, scr, lane);
            if (!has) break;
            dc = dn; it = itn;
#pragma unroll
            for (int i = 0; i < 32; ++i) { tv[i] = tn[i]; kv[i] = kn[i]; }
        }
    }
    const Args& a = fresh_args();
    {
        float sv, cv; sincospif((float)lane * (1.0f / 32.0f), &sv, &cv); const float ctab = cv * 0.125f, stab = sv * 0.125f;
        for (int it = (gw & 3) ? 512 : (gw >> 2); it < 4 * 8 * 16; it += NGW) {
            const int l = it >> 7, g = (it >> 4) & 7, db = it & 15, d = db * 64 + lane;
            const float* wsrc = a.w_branch + ((size_t)(l * 3 + 1) * 512 + g * 64) * D + d;
            float w[64];
#pragma unroll
            for (int c = 0; c < 64; ++c) w[c] = wsrc[(size_t)c * D];
            bf16* dst = F.WBR + (size_t)l * D * BRP + (size_t)d * BRP + 512 + g * 64;
            for (int j = 0; j < 64; ++j) {
                float ac = 0.f, as = 0.f;
#pragma unroll
                for (int c = 0; c < 64; ++c) { const int mi = (j * c) & 63; ac += __uint_as_float((unsigned)__builtin_amdgcn_readlane((int)__float_as_uint(ctab), mi)) * w[c]; as += __uint_as_float((unsigned)__builtin_amdgcn_readlane((int)__float_as_uint(stab), mi)) * w[c]; }
                dst[j] = (bf16)(pk2(ac, 0.f) & 0xffffu); dst[512 + j] = (bf16)(pk2(as, 0.f) & 0xffffu);
            }
        }
    }
    const int gt = F.vcu * 512 + F.tid, NGT = F.G * 512;
    for (int o = gt; o < 4 * 8 * 4 * 4096; o += NGT) {
        const int in = o & 63, out = (o >> 6) & 63, mat = (o >> 12) & 3, n = (o >> 14) & 7, l = o >> 17, dir = mat >> 1;
        const float* src = (mat & 1) ? a.lru_wx : a.lru_wa;
        F.WL[o] = (bf16)(pk2(src[((((size_t)(l * 2 + dir) * 8 + n) * 64 + in) * 64) + out], 0.f) & 0xffffu);
    }
    for (int o = gt; o < 4096 + 2048; o += NGT) { u32x4* dst = (u32x4*)(F.GW) + 12288; if (o < 4096) dst[o] = dft_table_entry<0>(o); else dst[o] = dft_table_entry<1>(o - 4096); }
    for (int o = gt; o < 4 * 2 * 512; o += NGT) { const float lam = a.lru_lambda[o]; F.NSP[o] = -8.0f * log1pf(expf(-lam)); }
    for (int o = gt; o < 2 * 1024 * 8; o += NGT) { const int j = o >> 13, k = (o >> 3) & 1023; F.GW[o] = a.norm_ffn_g[(2 * j + 1) * D + k] * a.router_w[o]; }
    for (int m = gw; m < M; m += NGW) {
        const f32x4* xr = (const f32x4*)(a.x + (size_t)m * D) + lane; f32x4 v[4]; float s = 0.f;
#pragma unroll
        for (int j = 0; j < 4; ++j) { v[j] = xr[64 * j]; s += (v[j][0] * v[j][0] + v[j][1] * v[j][1]) + (v[j][2] * v[j][2] + v[j][3] * v[j][3]); }
        s = wave_sum(s);
        u32x2* o8 = (u32x2*)(F.HB + (size_t)m * D) + lane;
#pragma unroll
        for (int j = 0; j < 4; ++j) { u32x2 w; w.x = pk2(v[j][0], v[j][1]); w.y = pk2(v[j][2], v[j][3]); o8[64 * j] = w; }
        { unsigned* q8 = (unsigned*)(F.HB8 + (size_t)m * D) + lane;
#pragma unroll
          for (int j = 0; j < 4; ++j) q8[64 * j] = pk4_fp8(v[j][0], v[j][1], v[j][2], v[j][3]); }
        if (lane == 0) F.RS[m] = (unsigned long long)(s * RS_SCALE);
    }
}

__device__ __forceinline__ f32x4 mfma16(bf16x8 a, bf16x8 b, f32x4 c) { return __builtin_amdgcn_mfma_f32_16x16x32_bf16(a, b, c, 0, 0, 0); }
__device__ __forceinline__ bf16x8 tr_frag(const LAS unsigned char* p0, const LAS unsigned char* p1) {
    const s16x4 lo = __builtin_bit_cast(s16x4, __builtin_amdgcn_ds_read_tr16_b64_v4i16((LAS s16x4*)p0));
    const s16x4 hi = __builtin_bit_cast(s16x4, __builtin_amdgcn_ds_read_tr16_b64_v4i16((LAS s16x4*)p1));
    bf16x8 r; r[0] = lo[0]; r[1] = lo[1]; r[2] = lo[2]; r[3] = lo[3]; r[4] = hi[0]; r[5] = hi[1]; r[6] = hi[2]; r[7] = hi[3]; return r;
}
constexpr int AT_V1 = 65536, AT_RPB = 131072;
struct AttnK { bf16x8 q0, q1; bf16x8 kf[8][2][2]; };
__device__ __forceinline__ void attn_load_k(AttnK& K, const bf16* __restrict__ PROJ, int b, int r, int h, int j, int lane) {
    const int fr = lane & 15, rq = lane >> 4;
    const int rs = min(max(r - 4, 0), 120);
    const int cb = (j == 0) ? 0 : (j == 1) ? 8 : (j == 2) ? 24 : 32;
    const size_t tq = (size_t)b * SEQ + 64 * r + 16 * j + fr;
    const bf16* qp = PROJ + tq * PPITCH + C_Q + h * 64 + 16 * rq;
    K.q0 = *(const bf16x8*)qp; K.q1 = *(const bf16x8*)(qp + 8);
    const bf16* kbase = PROJ + ((size_t)b * SEQ + 64 * rs + cb + fr) * PPITCH + C_K + h * 64 + 16 * rq;
#pragma unroll
    for (int ir = 0; ir < 8; ++ir)
#pragma unroll
        for (int hf = 0; hf < 2; ++hf) {
            const bf16* kp = kbase + (size_t)(64 * ir + 16 * hf) * PPITCH;
            K.kf[ir][hf][0] = *(const bf16x8*)kp; K.kf[ir][hf][1] = *(const bf16x8*)(kp + 8);
        }
}
__device__ __forceinline__ void attn_compute(const AttnK& K, const LAS unsigned char* vt, const LAS float* rpb, bf16* __restrict__ BR, int b, int r, int h, int j, int lane) {
    const int fr = lane & 15, rq = lane >> 4;
    const int rs = min(max(r - 4, 0), 120);
    const int cb = (j == 0) ? 0 : (j == 1) ? 8 : (j == 2) ? 24 : 32;
    const size_t tq = (size_t)b * SEQ + 64 * r + 16 * j + fr;
    f32x4 S[8][2];
#pragma unroll
    for (int ir = 0; ir < 8; ++ir)
#pragma unroll
        for (int hf = 0; hf < 2; ++hf) {
            f32x4 s = {0.f, 0.f, 0.f, 0.f};
            s = mfma16(K.kf[ir][hf][0], K.q0, s); s = mfma16(K.kf[ir][hf][1], K.q1, s);
            S[ir][hf] = s;
        }
    const int c = 16 * j + fr, cs = min(max(c - 8, 0), 48);
    float mx = -1e30f;
#pragma unroll
    for (int ir = 0; ir < 8; ++ir) {
        const LAS float* brow = rpb + (rs + ir - r + 7) * 31;
#pragma unroll
        for (int hf = 0; hf < 2; ++hf)
#pragma unroll
            for (int i = 0; i < 4; ++i) {
                const int kc = cb + 16 * hf + 4 * rq + i; const bool valid = (kc >= cs) && (kc < cs + 16);
                const int bi = min(max(kc - c + 15, 0), 30);
                const float sv = valid ? S[ir][hf][i] + brow[bi] : -1e30f;
                S[ir][hf][i] = sv; mx = fmaxf(mx, sv);
            }
    }
    mx = fmaxf(mx, __shfl_xor(mx, 16)); mx = fmaxf(mx, __shfl_xor(mx, 32));
    float sum = 0.f;
#pragma unroll
    for (int ir = 0; ir < 8; ++ir)
#pragma unroll
        for (int hf = 0; hf < 2; ++hf)
#pragma unroll
            for (int i = 0; i < 4; ++i) { const float p = __builtin_amdgcn_exp2f((S[ir][hf][i] - mx) * 1.44269504f); S[ir][hf][i] = p; sum += p; }
    sum += __shfl_xor(sum, 16); sum += __shfl_xor(sum, 32);
    f32x4 O[4];
#pragma unroll
    for (int d = 0; d < 4; ++d) O[d] = (f32x4){0.f, 0.f, 0.f, 0.f};
    const int q4 = (lane & 15) >> 2, p4 = lane & 3;
    const LAS unsigned char* vb = vt + (cb + 4 * rq + q4) * 128 + 8 * p4;
#pragma unroll
    for (int ir = 0; ir < 8; ++ir) {
        u32x4 pw; pw.x = pk2(S[ir][0][0], S[ir][0][1]); pw.y = pk2(S[ir][0][2], S[ir][0][3]); pw.z = pk2(S[ir][1][0], S[ir][1][1]); pw.w = pk2(S[ir][1][2], S[ir][1][3]);
        const bf16x8 Bp = __builtin_bit_cast(bf16x8, pw);
#pragma unroll
        for (int d = 0; d < 4; ++d) {
            const LAS unsigned char* p0 = vb + (64 * ir) * 128 + 32 * d;
            O[d] = mfma16(tr_frag(p0, p0 + 16 * 128), Bp, O[d]);
        }
    }
    const float inv = 1.0f / sum;
#pragma unroll
    for (int d = 0; d < 4; ++d) { u32x2 w; w.x = pk2(O[d][0] * inv, O[d][1] * inv); w.y = pk2(O[d][2] * inv, O[d][3] * inv);
        *(u32x2*)(BR + tq * BRP + h * 64 + 16 * d + 4 * rq) = w; }
}
constexpr int XP = 544;
constexpr int FX_OFF = 0, FT_OFF = 128 * XP;
template <int NMT, int NNT>
__device__ __forceinline__ void dft_core(const LAS unsigned char* xl, const LAS unsigned char* tl, int wm, int cbase, int lane, f32x4 (&acc)[2][NMT][NNT]) {
#pragma unroll
    for (int p = 0; p < 2; ++p)
#pragma unroll
        for (int m = 0; m < NMT; ++m)
#pragma unroll
            for (int n = 0; n < NNT; ++n) acc[p][m][n] = (f32x4){0.f, 0.f, 0.f, 0.f};
    const int g = lane >> 4, q = (lane & 15) >> 2, p4 = lane & 3;
#pragma unroll 1
    for (int ks = 0; ks < 4; ++ks) {
        bf16x8 Bf[NNT];
#pragma unroll
        for (int n = 0; n < NNT; ++n) {
            const LAS unsigned char* p0 = xl + (32 * ks + 8 * g + q) * XP + (cbase + 16 * n + 4 * p4) * 2;
            Bf[n] = tr_frag(p0, p0 + 4 * XP);
        }
#pragma unroll
        for (int p = 0; p < 2; ++p)
#pragma unroll
            for (int m = 0; m < NMT; ++m) {
                const int tile = p * (2 * NMT) + wm * NMT + m;
                const bf16x8 Af = *(const LAS bf16x8*)(tl + ((tile * 4 + ks) * 64 + lane) * 16);
#pragma unroll
                for (int n = 0; n < NNT; ++n) acc[p][m][n] = mfma16(Af, Bf[n], acc[p][m][n]);
            }
    }
}
__device__ __forceinline__ void dft_load_x(Frame& F, const bf16* src, size_t rstride) {
    const int chunk = F.tid & 31, row0 = F.tid >> 5;
    u32x4 v[8];
#pragma unroll
    for (int it = 0; it < 8; ++it) v[it] = *(const u32x4*)(src + (size_t)(row0 + 16 * it) * rstride + chunk * 8);
#pragma unroll
    for (int it = 0; it < 8; ++it) *(LAS u32x4*)(F.lds + FX_OFF + (row0 + 16 * it) * XP + chunk * 16) = v[it];
}
template <int STEP>
__device__ __forceinline__ u32x4 dft_table_entry(int idx) {
    const int tile = idx >> 8, ks = (idx >> 6) & 3, ln = idx & 63;
    float v[8];
#pragma unroll
    for (int j = 0; j < 8; ++j) {
        const int k = 32 * ks + 8 * (ln >> 4) + j; float sv, cv;
        if (STEP == 0) { const int part = tile >> 3, prow = (tile & 7) * 16 + (ln & 15); const int mi = (prow * k) & 127; sincospif((float)mi * (1.0f / 64.0f), &sv, &cv);
            v[j] = (part == 0 ? cv : -sv) * 0.08838834764831845f; }
        else { const int part = tile >> 2, prow = (tile & 3) * 16 + (ln & 15), pin = k >> 6, n2 = k & 63; const int mi = (prow * n2) & 63; sincospif((float)mi * (1.0f / 32.0f), &sv, &cv);
            v[j] = (part == 0 ? (pin == 0 ? cv : sv) : (pin == 0 ? -sv : cv)) * 0.125f; }
    }
    u32x4 w; w.x = pk2(v[0], v[1]); w.y = pk2(v[2], v[3]); w.z = pk2(v[4], v[5]); w.w = pk2(v[6], v[7]);
    return w;
}
template <int STEP>
__device__ __forceinline__ void dft_fill_table(Frame& F) {
    constexpr int NE = (STEP == 0 ? 16 : 8) * 256;
    const u32x4* src = (const u32x4*)(F.GW) + (STEP == 0 ? 12288 : 16384);
#pragma unroll
    for (int it = 0; it < NE / 512; ++it) { const int idx = F.tid + 512 * it; *(LAS u32x4*)(F.lds + FT_OFF + idx * 16) = src[idx]; }
}
__device__ __forceinline__ void fft_a_unit(Frame& F, int unit) {
    const int b = unit >> 7, n2 = (unit >> 1) & 63, chh = unit & 1, lane = F.lane, wm = F.wave >> 2, wn = F.wave & 3, rq = lane >> 4;
    dft_load_x(F, F.PROJ + ((size_t)b * SEQ + n2) * PPITCH + C_UF + 256 * chh, (size_t)64 * PPITCH);
    LDS_WAIT(); __syncthreads();
#pragma unroll 1
    for (int cp = 0; cp < 2; ++cp) {
    f32x4 acc[2][4][2];
    dft_core<4, 2>(F.lds + FX_OFF, F.lds + FT_OFF, wm, 64 * wn + 32 * cp, lane, acc);
#pragma unroll
    for (int m = 0; m < 4; ++m)
#pragma unroll
        for (int i = 0; i < 4; ++i) {
            const int k1 = 64 * wm + 16 * m + 4 * rq + i; float sv, cv; sincospif((float)(n2 * k1) * (1.0f / 4096.0f), &sv, &cv);
            bf16* o0 = F.TP + ((((size_t)(b * 128 + k1) * 2 + 0) * 64 + n2) * 512) + 256 * chh + 64 * wn + 32 * cp + (lane & 15);
#pragma unroll
            for (int n = 0; n < 2; ++n) {
                const float tr = acc[0][m][n][i], ti = acc[1][m][n][i];
                o0[16 * n] = (bf16)(pk2(tr * cv + ti * sv, 0.f) & 0xffffu);
                o0[16 * n + 64 * 512] = (bf16)(pk2(ti * cv - tr * sv, 0.f) & 0xffffu);
            }
        }
    }
    __syncthreads();
}
__device__ __forceinline__ void fft_c_unit(Frame& F, int unit) {
    const int b = unit >> 8, k1 = (unit >> 1) & 127, chh = unit & 1, lane = F.lane, wm = F.wave >> 2, wn = F.wave & 3, rq = lane >> 4;
    dft_load_x(F, F.TP + ((size_t)(b * 128 + k1) * 128) * 512 + 256 * chh, (size_t)512);
    LDS_WAIT(); __syncthreads();
    f32x4 acc[2][2][4];
    dft_core<2, 4>(F.lds + FX_OFF, F.lds + FT_OFF, wm, 64 * wn, lane, acc);
#pragma unroll
    for (int p = 0; p < 2; ++p)
#pragma unroll
        for (int m = 0; m < 2; ++m)
#pragma unroll
            for (int i = 0; i < 4; ++i) {
                const int k2 = 32 * wm + 16 * m + 4 * rq + i;
                bf16* o0 = F.BR + ((size_t)b * SEQ + k1 + 128 * k2) * BRP + 512 + p * 512 + 256 * chh + 64 * wn + (lane & 15);
#pragma unroll
                for (int n = 0; n < 4; ++n) o0[16 * n] = (ABL & 2) ? (bf16)0 : (bf16)(pk2(acc[p][m][n][i], 0.f) & 0xffffu);
            }
    __syncthreads();
}

template <bool REV, bool FULL>
__device__ __forceinline__ void lru_scan(const f32x4 (&a)[4], const f32x4 (&bt)[4], float carry_in, f32x4 (&h)[4], float& Atot, float& Btot, int lane) {
    const int rq = lane >> 4, fr = lane & 15;
    float carry = carry_in, At = 1.f;
#pragma unroll
    for (int mm = 0; mm < 4; ++mm) {
        const int mt = REV ? 3 - mm : mm;
        float hl[4], cA[4];
        if (!REV) { hl[0] = bt[mt][0]; cA[0] = a[mt][0];
#pragma unroll
            for (int i = 1; i < 4; ++i) { hl[i] = a[mt][i] * hl[i - 1] + bt[mt][i]; cA[i] = a[mt][i] * cA[i - 1]; } }
        else { hl[3] = bt[mt][3]; cA[3] = a[mt][3];
#pragma unroll
            for (int i = 2; i >= 0; --i) { hl[i] = a[mt][i] * hl[i + 1] + bt[mt][i]; cA[i] = a[mt][i] * cA[i + 1]; } }
        float SA = REV ? cA[0] : cA[3], SB = REV ? hl[0] : hl[3];
        float pA, pB;
        if (!REV) {
            pA = __shfl_up(SA, 16); pB = __shfl_up(SB, 16); if (rq >= 1) { SB = SA * pB + SB; SA = SA * pA; }
            pA = __shfl_up(SA, 32); pB = __shfl_up(SB, 32); if (rq >= 2) { SB = SA * pB + SB; SA = SA * pA; }
        } else {
            pA = __shfl_down(SA, 16); pB = __shfl_down(SB, 16); if (rq <= 2) { SB = SA * pB + SB; SA = SA * pA; }
            pA = __shfl_down(SA, 32); pB = __shfl_down(SB, 32); if (rq <= 1) { SB = SA * pB + SB; SA = SA * pA; }
        }
        float eA, eB;
        if (!REV) { eA = __shfl_up(SA, 16); eB = __shfl_up(SB, 16); if (rq == 0) { eA = 1.f; eB = 0.f; } }
        else { eA = __shfl_down(SA, 16); eB = __shfl_down(SB, 16); if (rq == 3) { eA = 1.f; eB = 0.f; } }
        const float tA = __shfl(SA, REV ? fr : 48 + fr), tB = __shfl(SB, REV ? fr : 48 + fr);
        if (FULL) { const float hs = eA * carry + eB;
#pragma unroll
            for (int i = 0; i < 4; ++i) h[mt][i] += hl[i] + cA[i] * hs; }
        carry = tA * carry + tB; At *= tA;
        __builtin_amdgcn_sched_barrier(0);
    }
    Atot = At; Btot = carry;
}
template <int PASS>
__device__ __forceinline__ void lru_unit(Frame& F, const Args& a, int l, int b, int r) {
    const int w = F.wave, ch0 = 64 * w;
    LAS float* carry_lds = (LAS float*)(F.lds);
    if (PASS == 2) {
        const int ch = F.wave * 64 + lane_id(); float hf = 0.f, hb = 0.f;
        const f32x2* sf = F.LSUM + ((size_t)(0 * 2 + b) * 128) * 512 + ch; const f32x2* sb = F.LSUM + ((size_t)(1 * 2 + b) * 128) * 512 + ch;
        for (int r0 = 0; r0 < r; r0 += 32) {
            f32x2 sv[32];
#pragma unroll
            for (int k = 0; k < 32; ++k) sv[k] = sf[(size_t)min(r0 + k, 127) * 512];
#pragma unroll
            for (int k = 0; k < 32; ++k) if (r0 + k < r) hf = sv[k].x * hf + sv[k].y;
        }
        for (int r0 = 127; r0 > r; r0 -= 32) {
            f32x2 sv[32];
#pragma unroll
            for (int k = 0; k < 32; ++k) sv[k] = sb[(size_t)max(r0 - k, 0) * 512];
#pragma unroll
            for (int k = 0; k < 32; ++k) if (r0 - k > r) hb = sv[k].x * hb + sv[k].y;
        }
        carry_lds[ch] = hf; carry_lds[512 + ch] = hb;
        LDS_WAIT(); __syncthreads();
    }
    const int lane = lane_id(), fr = lane & 15, rq = lane >> 4;
    bf16x8 Af[4][2];
#pragma unroll
    for (int ks = 0; ks < 2; ++ks) {
        const int chA = ch0 + 32 * ks + 8 * rq;
        float cw[4][8], cbv[8];
#pragma unroll
        for (int t = 0; t < 4; ++t) { const f32x4 w0 = *(const f32x4*)(a.conv_w + ((size_t)l * 4 + t) * 512 + chA), w1 = *(const f32x4*)(a.conv_w + ((size_t)l * 4 + t) * 512 + chA + 4);
            cw[t][0] = w0[0]; cw[t][1] = w0[1]; cw[t][2] = w0[2]; cw[t][3] = w0[3]; cw[t][4] = w1[0]; cw[t][5] = w1[1]; cw[t][6] = w1[2]; cw[t][7] = w1[3]; }
        { const f32x4 b0 = *(const f32x4*)(a.conv_b + (size_t)l * 512 + chA), b1 = *(const f32x4*)(a.conv_b + (size_t)l * 512 + chA + 4);
            cbv[0] = b0[0]; cbv[1] = b0[1]; cbv[2] = b0[2]; cbv[3] = b0[3]; cbv[4] = b1[0]; cbv[5] = b1[1]; cbv[6] = b1[2]; cbv[7] = b1[3]; }
#pragma unroll
        for (int mt = 0; mt < 4; ++mt) {
            const int s = 64 * r + 16 * mt + fr;
            float c8[8];
#pragma unroll
            for (int e = 0; e < 8; ++e) c8[e] = cbv[e];
#pragma unroll
            for (int t = 0; t < 4; ++t) {
                const int sp = s + t - 2;
                if (sp >= 0 && sp < SEQ) {
                    const u32x4 uv = *(const u32x4*)(F.PROJ + ((size_t)b * SEQ + sp) * PPITCH + C_UX + chA);
                    c8[0] += cw[t][0] * bflo(uv.x); c8[1] += cw[t][1] * bfhi(uv.x); c8[2] += cw[t][2] * bflo(uv.y); c8[3] += cw[t][3] * bfhi(uv.y);
                    c8[4] += cw[t][4] * bflo(uv.z); c8[5] += cw[t][5] * bfhi(uv.z); c8[6] += cw[t][6] * bflo(uv.w); c8[7] += cw[t][7] * bfhi(uv.w);
                }
            }
            u32x4 pw; pw.x = pk2(c8[0], c8[1]); pw.y = pk2(c8[2], c8[3]); pw.z = pk2(c8[4], c8[5]); pw.w = pk2(c8[6], c8[7]);
            Af[mt][ks] = __builtin_bit_cast(bf16x8, pw);
            __builtin_amdgcn_sched_barrier(0);
        }
    }
    const bf16* WLb = F.WL + ((size_t)(l * 8 + w) * 4) * 4096;
#pragma unroll 1
    for (int nt = 0; nt < 4; ++nt) {
        const int ch = ch0 + 16 * nt + fr;
        f32x4 cD[4];
#pragma unroll
        for (int mt = 0; mt < 4; ++mt) cD[mt] = (f32x4){0.f, 0.f, 0.f, 0.f};
#pragma unroll
        for (int ks = 0; ks < 2; ++ks) {
            bf16x8 I8;
#pragma unroll
            for (int j = 0; j < 8; ++j) I8[j] = (32 * ks + 8 * rq + j == 16 * nt + fr) ? (short)0x3F80 : (short)0;
#pragma unroll
            for (int mt = 0; mt < 4; ++mt) cD[mt] = mfma16(Af[mt][ks], I8, cD[mt]);
        }
        f32x4 hsum[4];
#pragma unroll
        for (int mt = 0; mt < 4; ++mt) hsum[mt] = (f32x4){0.f, 0.f, 0.f, 0.f};
        bf16x8 Bw[2][2][2];
#pragma unroll
        for (int dir = 0; dir < 2; ++dir)
#pragma unroll
            for (int mat = 0; mat < 2; ++mat)
#pragma unroll
                for (int ks = 0; ks < 2; ++ks) Bw[dir][mat][ks] = *(const bf16x8*)(WLb + (size_t)(2 * dir + mat) * 4096 + (16 * nt + fr) * 64 + 32 * ks + 8 * rq);
        float pba[2], pbx[2], pns[2];
#pragma unroll
        for (int dir = 0; dir < 2; ++dir) { pba[dir] = -1.44269504f * a.lru_ba[(size_t)(l * 2 + dir) * 512 + ch]; pbx[dir] = -1.44269504f * a.lru_bx[(size_t)(l * 2 + dir) * 512 + ch]; pns[dir] = 1.44269504f * F.NSP[(l * 2 + dir) * 512 + ch]; }
        unsigned short ggv[4][4];
        if (PASS == 2) {
#pragma unroll
            for (int mt = 0; mt < 4; ++mt)
#pragma unroll
                for (int i = 0; i < 4; ++i) ggv[mt][i] = F.PROJ[((size_t)b * SEQ + 64 * r + 16 * mt + 4 * rq + i) * PPITCH + C_UG + ch];
        }
#pragma unroll
        for (int dir = 0; dir < 2; ++dir) {
            __builtin_amdgcn_sched_barrier(0);
            f32x4 xa[4], xx[4];
#pragma unroll
            for (int mt = 0; mt < 4; ++mt) { xa[mt] = (f32x4){0.f, 0.f, 0.f, 0.f}; xx[mt] = (f32x4){0.f, 0.f, 0.f, 0.f}; }
#pragma unroll
            for (int ks = 0; ks < 2; ++ks) {
#pragma unroll
                for (int mt = 0; mt < 4; ++mt) { xa[mt] = mfma16(Af[mt][ks], Bw[dir][0][ks], xa[mt]); xx[mt] = mfma16(Af[mt][ks], Bw[dir][1][ks], xx[mt]); }
            }
            const float ba = pba[dir], bx = pbx[dir], ns = pns[dir];
            f32x4 av[4], bt[4]; float igc_first = 0.f, igc_last = 0.f;
#pragma unroll
            for (int mt = 0; mt < 4; ++mt)
#pragma unroll
                for (int i = 0; i < 4; ++i) {
                    const float rg = __builtin_amdgcn_rcpf(1.0f + __builtin_amdgcn_exp2f(__builtin_fmaf(xa[mt][i], -1.44269504f, ba)));
                    const float ig = __builtin_amdgcn_rcpf(1.0f + __builtin_amdgcn_exp2f(__builtin_fmaf(xx[mt][i], -1.44269504f, bx)));
                    const float aa = __builtin_amdgcn_exp2f(ns * rg);
                    const float mult = __builtin_amdgcn_sqrtf(fmaxf(__builtin_fmaf(-aa, aa, 1.0f), 0.f));
                    const float igc = ig * cD[mt][i];
                    if (mt == 0 && i == 0) igc_first = igc;
                    if (mt == 3 && i == 3) igc_last = igc;
                    av[mt][i] = aa; bt[mt][i] = mult * igc;
                    if (i == 3) __builtin_amdgcn_sched_barrier(0);
                }
            if (dir == 0) { if (r == 0 && rq == 0) bt[0][0] = igc_first; }
            else { if (r == 127 && rq == 3) bt[3][3] = igc_last; }
            float At, Bt;
            const float cin = (PASS == 2) ? carry_lds[dir * 512 + ch] : 0.f;
            if (dir == 0) lru_scan<false, PASS == 2>(av, bt, cin, hsum, At, Bt, lane); else lru_scan<true, PASS == 2>(av, bt, cin, hsum, At, Bt, lane);
            if (PASS == 1) { if (rq == 0) { f32x2 sm; sm.x = At; sm.y = Bt; F.LSUM[((size_t)(dir * 2 + b) * 128 + r) * 512 + ch] = sm; } }

        }
        if (PASS == 2) {
#pragma unroll
            for (int mt = 0; mt < 4; ++mt)
#pragma unroll
                for (int i = 0; i < 4; ++i) {
                    const size_t tok = (size_t)b * SEQ + 64 * r + 16 * mt + 4 * rq + i;
                    const float gg = bf2f(ggv[mt][i]);
                    F.BR[tok * BRP + 1536 + ch] = (ABL & 4) ? (bf16)0 : (bf16)(pk2(hsum[mt][i] * gg, 0.f) & 0xffffu);
                }
        }
    }
    if (PASS == 2) __syncthreads();
}

__device__ __forceinline__ void moe_router(Frame& F, int jm, const unsigned long long* rs) {
    const int gw = F.vcu * NWAVES + F.wave, NGW = F.G * NWAVES, lane = F.lane;
    const float* GWj = F.GW + (size_t)jm * 1024 * 8;
    unsigned* cnt = F.ctl + CW_MOE + jm * 8 * 64;
    LAS float* gwt = (LAS float*)F.lds;
    for (int i = F.tid; i < 1024 * 8; i += 512) gwt[(i & 7) * 1024 + (i >> 3)] = GWj[i];
    LDS_WAIT(); __syncthreads();
    for (int t = gw; t < M; t += NGW) {
        const u32x2* hr = (const u32x2*)(F.HB + (size_t)t * D) + lane;
        float lg[8];
#pragma unroll
        for (int e = 0; e < 8; ++e) lg[e] = 0.f;
#pragma unroll
        for (int j = 0; j < 4; ++j) {
            const u32x2 hw = hr[64 * j]; const float hv[4] = {bflo(hw.x), bfhi(hw.x), bflo(hw.y), bfhi(hw.y)}; const int k0 = 4 * lane + 256 * j;
#pragma unroll
            for (int e = 0; e < 8; ++e) { const f32x4 g = *(const LAS f32x4*)(gwt + e * 1024 + k0); lg[e] += (hv[0] * g[0] + hv[1] * g[1]) + (hv[2] * g[2] + hv[3] * g[3]); }
        }
#pragma unroll
        for (int e = 0; e < 8; ++e) lg[e] = wave_sum(lg[e]);
        const float sr = 1.0f / sqrtf((float)rs[t] * (1.0f / (RS_SCALE * D)) + RMS_EPS);
        int e0 = 0; float v0 = lg[0];
#pragma unroll
        for (int e = 1; e < 8; ++e) if (lg[e] > v0) { v0 = lg[e]; e0 = e; }
        int e1 = -1; float v1 = -3.0e38f;
#pragma unroll
        for (int e = 0; e < 8; ++e) if (e != e0 && lg[e] > v1) { v1 = lg[e]; e1 = e; }
        const float w0 = 1.0f / (1.0f + expf((v1 - v0) * sr)), w1 = 1.0f - w0;
        if (lane == 0) {
            const int p0 = (int)atomicAdd(cnt + e0 * 64, 1u), p1 = (int)atomicAdd(cnt + e1 * 64, 1u);
            F.LIST[e0 * 16384 + p0] = t; F.LIST[e1 * 16384 + p1] = t;
            F.SROW[e0 * 16384 + p0] = sr; F.SROW[e1 * 16384 + p1] = sr;
            F.WSLOT[e0 * 16384 + p0] = w0; F.WSLOT[e1 * 16384 + p1] = w1;
            int4 ti; ti.x = e0; ti.y = p0; ti.z = e1; ti.w = p1; ((int4*)F.TOKI)[t] = ti;
        }
    }
    __syncthreads();
}
__device__ __forceinline__ void moe_sched_init(Frame& F, int jm, pg8::SchedMoe& S) {
    const unsigned* cnt = F.ctl + CW_MOE + jm * 8 * 64;
#define RFL(x) __builtin_amdgcn_readfirstlane((int)(x))
    S.cntp = cnt;
    const int c0 = RFL(cnt[0]), c1 = RFL(cnt[64]), c2 = RFL(cnt[128]), c3 = RFL(cnt[192]), c4 = RFL(cnt[256]), c5 = RFL(cnt[320]), c6 = RFL(cnt[384]), c7 = RFL(cnt[448]);
#undef RFL
    S.t1 = (c0 + 255) >> 8; S.t2 = S.t1 + ((c1 + 255) >> 8); S.t3 = S.t2 + ((c2 + 255) >> 8); S.t4 = S.t3 + ((c3 + 255) >> 8);
    S.t5 = S.t4 + ((c4 + 255) >> 8); S.t6 = S.t5 + ((c5 + 255) >> 8); S.t7 = S.t6 + ((c6 + 255) >> 8); S.t8 = S.t7 + ((c7 + 255) >> 8);
}
__device__ __forceinline__ void moe_combine(Frame& F, const Args& a, int jm, unsigned long long* rs_next, bool final_layer) {
    const int gw = F.vcu * NWAVES + F.wave, NGW = F.G * NWAVES, lane = F.lane;
    pg8::SchedMoe S; moe_sched_init(F, jm, S);
    for (int t = gw; t < M; t += NGW) {
        const int4 ti = ((const int4*)F.TOKI)[t];
        const int ta = ti.x == 0 ? 0 : ti.x == 1 ? S.t1 : ti.x == 2 ? S.t2 : ti.x == 3 ? S.t3 : ti.x == 4 ? S.t4 : ti.x == 5 ? S.t5 : ti.x == 6 ? S.t6 : S.t7;
        const int tb = ti.z == 0 ? 0 : ti.z == 1 ? S.t1 : ti.z == 2 ? S.t2 : ti.z == 3 ? S.t3 : ti.z == 4 ? S.t4 : ti.z == 5 ? S.t5 : ti.z == 6 ? S.t6 : S.t7;
        const size_t s0 = (size_t)ta * 256 + ti.y, s1 = (size_t)tb * 256 + ti.w;
        u32x2* hr = (u32x2*)(F.HB + (size_t)t * D) + lane;
        const u32x2* y0 = (const u32x2*)(F.YBUF + s0 * D) + lane; const u32x2* y1 = (const u32x2*)(F.YBUF + s1 * D) + lane;
        f32x4 v[4]; float ss = 0.f;
#pragma unroll
        for (int j = 0; j < 4; ++j) { const u32x2 a0 = y0[64 * j], a1 = y1[64 * j], hw = hr[64 * j]; f32x4 hv;
            hv[0] = bflo(hw.x) + bflo(a0.x) + bflo(a1.x); hv[1] = bfhi(hw.x) + bfhi(a0.x) + bfhi(a1.x); hv[2] = bflo(hw.y) + bflo(a0.y) + bflo(a1.y); hv[3] = bfhi(hw.y) + bfhi(a0.y) + bfhi(a1.y);
            v[j] = hv; ss += (hv[0] * hv[0] + hv[1] * hv[1]) + (hv[2] * hv[2] + hv[3] * hv[3]); }
        ss = wave_sum(ss);
        if (final_layer) {
            const float sr = 1.0f / sqrtf(ss * (1.0f / D) + RMS_EPS);
            f32x4* orow = (f32x4*)(F.H + (size_t)t * D) + lane;
#pragma unroll
            for (int j = 0; j < 4; ++j) { const f32x4 g = *((const f32x4*)a.final_g + lane + 64 * j); orow[64 * j] = v[j] * sr * g; }
        } else {
#pragma unroll
            for (int j = 0; j < 4; ++j) { u32x2 w; w.x = pk2(v[j][0], v[j][1]); w.y = pk2(v[j][2], v[j][3]); hr[64 * j] = w; }
            { unsigned* q8 = (unsigned*)(F.HB8 + (size_t)t * D) + lane;
#pragma unroll
              for (int j = 0; j < 4; ++j) q8[64 * j] = pk4_fp8(v[j][0], v[j][1], v[j][2], v[j][3]); }
            if (lane == 0) rs_next[t] = (unsigned long long)(ss * RS_SCALE);
        }
    }
}

__device__ __forceinline__ Frame mk_frame(const Args& args, LAS unsigned char* ldsp, int wave0) {
    Frame F;
    F.lds = ldsp;
    F.tid = tid_of(wave0); F.lane = F.tid & 63; F.wave = __builtin_amdgcn_readfirstlane(F.tid >> 6);
    F.G = gridDim.x; { const int bx = blockIdx.x; F.vcu = (F.G % 8 == 0) ? (bx % 8) * (F.G / 8) + bx / 8 : bx; }
    size_t zoff = 0; asm volatile("" : "+s"(zoff)); unsigned char* ws = args.ws + zoff; float* outp = args.out + zoff;
    F.ctl = (unsigned*)(ws + WS_CTL); F.H = outp;
    F.HB8 = ws + WS_HB8; F.HB = (bf16*)(ws + WS_HB); F.VT = nullptr; F.WIN8 = ws + WS_WIN8; F.BR = (bf16*)(ws + WS_BR); F.TP = (bf16*)(ws + WS_TP); F.MERGED = (bf16*)(ws + WS_MERGED);
    F.PROJ = (bf16*)(ws + WS_PROJ); F.HID = (bf16*)(ws + WS_HID); F.YBUF = (bf16*)(ws + WS_YBUF);
    F.WIN = (bf16*)(ws + WS_WIN); F.WBR = (bf16*)(ws + WS_WBR); F.WOUT = (bf16*)(ws + WS_WOUT); F.WGU = (bf16*)(ws + WS_WGU); F.WDN = (bf16*)(ws + WS_WDN);
    F.MGU = (bf16*)(ws + WS_MGU); F.MDN = (bf16*)(ws + WS_MDN); F.WL = (bf16*)(ws + WS_WL);
    F.NSP = (float*)(ws + WS_MISC); F.GW = (float*)(ws + WS_MISC + 65536); F.LSUM = (f32x2*)(ws + WS_LSUM); F.RS = (unsigned long long*)(ws + WS_RS);
    F.LIST = (int*)(ws + WS_MOEI); F.SROW = (float*)(ws + WS_MOEI + 524288); F.WSLOT = (float*)(ws + WS_MOEI + 2 * 524288); F.TOKI = (int*)(ws + WS_MOEI + 3 * 524288);
    return F;
}
__global__ void __launch_bounds__(NWAVES * 64, 2) enc_fwd(Args args) {
    extern __shared__ __attribute__((aligned(16))) unsigned char lds[];
    LAS unsigned char* const ldsp = (LAS unsigned char*)lds;
    volatile LAS unsigned* MISC = (volatile LAS unsigned*)(ldsp + MISC_OFF);
    const int wave0 = __builtin_amdgcn_readfirstlane((int)threadIdx.x >> 6);
    for (int u = wave0 * 64 + lane_id(); u < (LDS_BYTES - MISC_OFF) / 4; u += NWAVES * 64) ((LAS unsigned*)(ldsp + MISC_OFF))[u] = 0u;
    __syncthreads();
    XcdBarrier bar = xcd_barrier_post((unsigned*)(args.ws + WS_CTL) + CW_BAR + args.bar_region * XCD_BAR_WORDS, MISC + 8, wave0);
    const int lo = args.ph_lo, hi = args.ph_hi;
#ifndef PHASE_MASK
#define PHASE_MASK 0xFFFF
#endif
#define PM(k) (((PHASE_MASK) >> (k)) & 1)
#define IN(k) (lo <= (k) && (k) < hi)
#define SEAM(k) do { if (IN(k) && IN((k) + 1)) xcd_barrier(bar, wave0); } while (0)
#define RETID() Frame F = mk_frame(args, ldsp, wave0)

    if (PM(0) && IN(0)) { RETID(); p0_prologue(F, args); }
    SEAM(0);
#pragma unroll 1
    for (int l = 0; l < DEPTH; ++l) {
        const int pb = 1 + 9 * l;
        if (PM(1) && IN(pb + 0)) {
            RETID();
            { pg8::SchedPlain S; S.A = (const char*)F.HB; S.B = (const char*)(F.WIN + (size_t)l * INC * D); S.lda2 = D * 2; S.ldb2 = D * 2; S.nt = D / 64; S.nM = M / 256; S.nN = 12; S.G = F.G; S.c = (int)blockIdx.x;
              pg8::EpiProj E; E.P = F.PROJ; E.VT = F.VT; E.bias = args.b_in + (size_t)l * INC; E.rs = F.RS + (size_t)(2 * l) * M; E.pn_off = 0; E.cs = 1.0f;
              pg8::gemm_phase<pg8::EpiProj, pg8::SchedPlain, true, false>(F.lds, S, E, wave0); }
        }
        if (PM(1) && IN(pb + 0)) {
            RETID();
            { pg8::SchedPlain S; S.A = (const char*)F.HB8; S.B = (const char*)(F.WIN8 + (size_t)l * 3072 * D); S.lda2 = D; S.ldb2 = D; S.nt = D / 128; S.nM = M / 256; S.nN = 12; S.G = F.G; S.c = (int)blockIdx.x;
              pg8::EpiProj E; E.P = F.PROJ; E.VT = F.VT; E.bias = args.b_in + (size_t)l * INC; E.rs = F.RS + (size_t)(2 * l) * M; E.pn_off = 12; E.cs = 1.0f / W8S;
              pg8::gemm_phase<pg8::EpiProj, pg8::SchedPlain, true, false, true>(F.lds, S, E, wave0); }
        }
        SEAM(pb + 0);
        if (PM(2) && IN(pb + 1)) {
            RETID();
#ifndef P2M
#define P2M 7
#endif
            if (P2M & 1) {
            dft_fill_table<0>(F);
            LDS_WAIT(); __syncthreads();
            for (int u = F.vcu; u < 256; u += F.G) fft_a_unit(F, u);
            __syncthreads(); }
            if (P2M & 2) {
            for (int u = F.vcu; u < 256; u += F.G) { const int b = u >> 7, r = u & 127, rs = min(max(r - 4, 0), 120);
#pragma unroll 1
                for (int hp = 0; hp < 4; ++hp) {
                    const int h = 2 * hp + (F.wave >> 2), j = F.wave & 3;
                    AttnK K; attn_load_k(K, F.PROJ, b, r, h, j, F.lane);
                    __syncthreads();
                    { const int chunk = F.tid & 15, t0 = F.tid >> 4;
                      const bf16* vsrc = F.PROJ + ((size_t)b * SEQ + 64 * rs) * PPITCH + C_V + 128 * hp + 8 * chunk;
#pragma unroll 1
                      for (int hh = 0; hh < 2; ++hh) {
                      u32x4 vv[8];
#pragma unroll
                      for (int it = 0; it < 8; ++it) vv[it] = *(const u32x4*)(vsrc + (size_t)(t0 + 32 * (8 * hh + it)) * PPITCH);
#pragma unroll
                      for (int it = 0; it < 8; ++it) *(LAS u32x4*)(F.lds + (chunk >> 3) * AT_V1 + (t0 + 32 * (8 * hh + it)) * 128 + (chunk & 7) * 16) = vv[it];
                      }
                      const float* rp = args.na_rpb + ((size_t)l * 8 + 2 * hp) * 465; LAS float* rl = (LAS float*)(F.lds + AT_RPB);
                      for (int i = F.tid; i < 2 * 465; i += 512) rl[i] = rp[i]; }
                    LDS_WAIT(); __syncthreads();
                    attn_compute(K, F.lds + (F.wave >> 2) * AT_V1, (const LAS float*)(F.lds + AT_RPB) + (F.wave >> 2) * 465, F.BR, b, r, h, j, F.lane);
                } }
            __syncthreads(); }
            if (P2M & 4) for (int u = F.vcu; u < 256; u += F.G) lru_unit<1>(F, args, l, u >> 7, u & 127);
        }
        SEAM(pb + 1);
        if (PM(3) && IN(pb + 2)) {
            RETID();
            dft_fill_table<1>(F);
            LDS_WAIT(); __syncthreads();
            for (int u = F.vcu; u < 512; u += F.G) fft_c_unit(F, u);
            __syncthreads();
            for (int u = F.vcu; u < 256; u += F.G) lru_unit<2>(F, args, l, u >> 7, u & 127);
        }
        SEAM(pb + 2);
        if (PM(4) && IN(pb + 3)) {
            RETID();
            pg8::SchedMerge S; S.A = (const char*)F.BR; S.B = (const char*)(F.WBR + (size_t)l * D * BRP); S.lda2 = BRP * 2; S.ldb2 = BRP * 2; S.nM = M / 256; S.nN = D / 256; S.G = F.G; S.c = (int)blockIdx.x;
            pg8::EpiMerge E; E.G = F.PROJ + C_GATE; E.O = F.MERGED;
            pg8::gemm_phase<pg8::EpiMerge, pg8::SchedMerge, true, false>(F.lds, S, E, wave0);
        }
        SEAM(pb + 3);
        if (PM(5) && IN(pb + 4)) {
            RETID();
            pg8::SchedPlain S; S.A = (const char*)F.MERGED; S.B = (const char*)(F.WOUT + (size_t)l * D * D); S.lda2 = D * 2; S.ldb2 = D * 2; S.nt = D / 64; S.nM = M / 256; S.nN = D / 256; S.G = F.G; S.c = (int)blockIdx.x;
            pg8::EpiOut E; E.hb = F.HB; E.rs = F.RS + (size_t)(2 * l + 1) * M; E.hb8 = nullptr; E.cs = 1.0f;
            pg8::gemm_phase<pg8::EpiOut, pg8::SchedPlain, true, false>(F.lds, S, E, wave0);
        }
        SEAM(pb + 4);
        if ((l & 1) == 0) {
            const int j = l >> 1;
            if (PM(6) && IN(pb + 5)) {
                RETID();
                pg8::SchedPlain S; S.A = (const char*)F.HB; S.B = (const char*)(F.WGU + (size_t)j * 2 * DFF * D); S.lda2 = D * 2; S.ldb2 = D * 2; S.nt = D / 64; S.nM = M / 256; S.nN = 2 * DFF / 256; S.G = F.G; S.c = (int)blockIdx.x;
                pg8::EpiGU E; E.Hd = (unsigned char*)F.HID; E.ldh = DFF; E.rs = F.RS + (size_t)(2 * l + 1) * M; E.srow = nullptr; E.moe = false; E.cs = 1.0f;
                pg8::gemm_phase<pg8::EpiGU, pg8::SchedPlain, true, false, false>(F.lds, S, E, wave0);
            }
            SEAM(pb + 5);
            if (PM(7) && IN(pb + 6)) {
                RETID();
                pg8::SchedPlain S; S.A = (const char*)F.HID; S.B = (const char*)F.WDN + (size_t)j * D * DFF; S.lda2 = DFF; S.ldb2 = DFF; S.nt = DFF / 128; S.nM = M / 256; S.nN = D / 256; S.G = F.G; S.c = (int)blockIdx.x;
                pg8::EpiOut E; E.hb = F.HB; E.rs = F.RS + (size_t)(2 * l + 2) * M; E.hb8 = F.HB8; E.cs = 1.0f / (W8S * H8S);
                pg8::gemm_phase<pg8::EpiOut, pg8::SchedPlain, true, false, true>(F.lds, S, E, wave0);
            }
            SEAM(pb + 6);
        } else {
            const int jm = l >> 1;
            if (PM(8) && IN(pb + 5)) { RETID(); moe_router(F, jm, F.RS + (size_t)(2 * l + 1) * M); }
            SEAM(pb + 5);
            if (PM(9) && IN(pb + 6)) {
                RETID();
                pg8::SchedMoe S; moe_sched_init(F, jm, S);
                S.A = (const char*)F.HB; S.B = (const char*)(F.MGU + (size_t)(jm * 8) * 2 * DFE * D); S.list = F.LIST; S.lda2 = D * 2; S.ldb2 = D * 2; S.nt = D / 64; S.nN = 2 * DFE / 256; S.G = F.G; S.c = (int)blockIdx.x;
                S.bstride = (size_t)2 * DFE * D * 2; S.gather = true;
                pg8::EpiGU E; E.Hd = (unsigned char*)F.HID; E.ldh = DFE; E.rs = nullptr; E.srow = F.SROW; E.moe = true; E.cs = 1.0f;
                pg8::gemm_phase<pg8::EpiGU, pg8::SchedMoe, true, true, false>(F.lds, S, E, wave0);
            }
            SEAM(pb + 6);
            if (PM(10) && IN(pb + 7)) {
                RETID();
                pg8::SchedMoe S; moe_sched_init(F, jm, S);
                S.A = (const char*)F.HID; S.B = (const char*)F.MDN + (size_t)(jm * 8) * D * DFE; S.list = F.LIST; S.lda2 = DFE; S.ldb2 = DFE; S.nt = DFE / 128; S.nN = D / 256; S.G = F.G; S.c = (int)blockIdx.x;
                S.bstride = (size_t)D * DFE; S.gather = false;
                pg8::EpiMoeDown E; E.Y = F.YBUF; E.wslot = F.WSLOT;
                pg8::gemm_phase<pg8::EpiMoeDown, pg8::SchedMoe, true, false, true>(F.lds, S, E, wave0);
            }
            SEAM(pb + 7);
            if (PM(11) && IN(pb + 8)) { RETID(); moe_combine(F, args, jm, F.RS + (size_t)((2 * l + 2) & 7) * M, l == DEPTH - 1); }
            SEAM(pb + 8);
        }
    }
#undef IN
#undef SEAM
}

#ifndef ABL
#define ABL 0
#endif
#ifndef MK_PER_PHASE
#define MK_PER_PHASE 0
#endif
extern "C" void kernel_launch(void* const* d_in, const int* in_sizes, int n_in, void* d_out, int out_size, void* d_ws, size_t ws_size, hipStream_t stream) {
    static int grid = 0;
    if (grid == 0) {
        if (n_in != 21 || out_size != M * D || ws_size < WS_END) { fprintf(stderr, "kernel_launch: unexpected shapes (n_in %d out %d ws %zu)\n", n_in, out_size, ws_size); grid = -1; return; }
        int dev = 0, cus = 0, per_cu = 0;
        if (hipGetDevice(&dev) != hipSuccess || hipDeviceGetAttribute(&cus, hipDeviceAttributeMultiprocessorCount, dev) != hipSuccess) { grid = -1; return; }
        if (hipFuncSetAttribute((const void*)enc_fwd, hipFuncAttributeMaxDynamicSharedMemorySize, LDS_BYTES) != hipSuccess) { fprintf(stderr, "kernel_launch: hipFuncSetAttribute failed\n"); grid = -1; return; }
        if (hipOccupancyMaxActiveBlocksPerMultiprocessor(&per_cu, (const void*)enc_fwd, NWAVES * 64, LDS_BYTES) != hipSuccess || per_cu < 1)
            fprintf(stderr, "kernel_launch: note: occupancy query reports %d workgroups per CU\n", per_cu);
        (void)hipGetLastError();
        grid = cus;
    }
    if (grid < 0) return;
    (void)hipMemsetAsync((char*)d_ws + WS_CTL, 0, CTL_ZERO_BYTES, stream);
    (void)hipMemsetAsync((char*)d_ws + WS_RS, 0, 1 * MiB, stream);
    Args a{};
    a.x = (const float*)d_in[0]; a.norm_mix_g = (const float*)d_in[1]; a.w_in = (const float*)d_in[2]; a.b_in = (const float*)d_in[3]; a.na_rpb = (const float*)d_in[4];
    a.conv_w = (const float*)d_in[5]; a.conv_b = (const float*)d_in[6]; a.lru_wa = (const float*)d_in[7]; a.lru_ba = (const float*)d_in[8]; a.lru_wx = (const float*)d_in[9];
    a.lru_bx = (const float*)d_in[10]; a.lru_lambda = (const float*)d_in[11]; a.w_branch = (const float*)d_in[12]; a.w_out = (const float*)d_in[13]; a.norm_ffn_g = (const float*)d_in[14];
    a.ffn_w_gu = (const float*)d_in[15]; a.ffn_w_down = (const float*)d_in[16]; a.router_w = (const float*)d_in[17]; a.moe_w_gu = (const float*)d_in[18]; a.moe_w_down = (const float*)d_in[19];
    a.final_g = (const float*)d_in[20];
    a.out = (float*)d_out; a.ws = (unsigned char*)d_ws;
    constexpr int NPH = 1 + 9 * DEPTH;
#ifndef PROBE_LO
#define PROBE_LO -1
#define PROBE_HI -1
#endif
    if (PROBE_LO >= 0) {
        a.ph_lo = 0; a.ph_hi = PROBE_HI; a.bar_region = 0; hipLaunchKernelGGL(enc_fwd, dim3(grid), dim3(NWAVES * 64), LDS_BYTES, stream, a);
        a.ph_lo = PROBE_LO; a.ph_hi = PROBE_HI; a.bar_region = 1; hipLaunchKernelGGL(enc_fwd, dim3(grid), dim3(NWAVES * 64), LDS_BYTES, stream, a);
        a.ph_lo = PROBE_HI; a.ph_hi = NPH; a.bar_region = 2; hipLaunchKernelGGL(enc_fwd, dim3(grid), dim3(NWAVES * 64), LDS_BYTES, stream, a);
    } else {
        a.ph_lo = 0; a.ph_hi = NPH; a.bar_region = 0;
        hipLaunchKernelGGL(enc_fwd, dim3(grid), dim3(NWAVES * 64), LDS_BYTES, stream, a);
    }
    const hipError_t le = hipPeekAtLastError();
    if (le != hipSuccess) fprintf(stderr, "kernel_launch: launch failed: %s\n", hipGetErrorName(le));
}
```

```cpp
#include <hip/hip_runtime.h>
#include <cstdio>
#include <cstdint>

#ifndef ABL
#define ABL 0
#endif
#define LAS __attribute__((address_space(3)))
#define GAS __attribute__((address_space(1)))
typedef unsigned short bf16;
typedef short bf16x8 __attribute__((ext_vector_type(8)));
typedef short s16x4 __attribute__((ext_vector_type(4)));
typedef float f32x4 __attribute__((ext_vector_type(4)));
typedef float f32x2 __attribute__((ext_vector_type(2)));
typedef unsigned u32x4 __attribute__((ext_vector_type(4)));
typedef unsigned u32x2 __attribute__((ext_vector_type(2)));
typedef __bf16 bf16x2_t __attribute__((ext_vector_type(2)));
typedef GAS unsigned gu32;
#define RLX_AGENT __ATOMIC_RELAXED, __HIP_MEMORY_SCOPE_AGENT
#define LDS_WAIT() asm volatile("s_waitcnt lgkmcnt(0)" ::: "memory")
#define VM_WAIT() asm volatile("s_waitcnt vmcnt(0)" ::: "memory")

constexpr int NB = 2, SEQ = 8192, M = NB * SEQ, D = 1024, DEPTH = 4;
constexpr int INC = 6144;
constexpr int PPITCH = 6208;
constexpr int VTP = 8256;
constexpr int C_Q = 0, C_K = 512, C_V = 1024, C_UF = 1536, C_UX = 2048, C_UG = 2560, C_GATE = 3072;
constexpr int BRP = 2112;
constexpr int DFF = 3072, DFE = 1536, NEXP = 8;
constexpr float RMS_EPS = 1e-6f;
constexpr int NWAVES = 8;

constexpr size_t MiB = 1u << 20;
constexpr size_t WS_CTL = 0, CTL_ZERO_BYTES = 1 * MiB;
constexpr size_t WS_WIN = 1 * MiB;
constexpr size_t WS_WBR = 714 * MiB;
constexpr size_t WS_WOUT = 65 * MiB;
constexpr size_t WS_WGU = 73 * MiB;
constexpr size_t WS_WDN = 97 * MiB;
constexpr size_t WS_MGU = 109 * MiB;
constexpr size_t WS_MDN = 205 * MiB;
constexpr size_t WS_WL = 253 * MiB;
constexpr size_t WS_MISC = 254 * MiB;
constexpr size_t WS_LSUM = 255 * MiB;
constexpr size_t WS_MOEI = 257 * MiB;
constexpr size_t WS_HB = 259 * MiB;
constexpr size_t WS_HB8 = 291 * MiB;
constexpr size_t WS_WIN8 = 630 * MiB;
constexpr size_t WS_BR = 647 * MiB;
constexpr size_t WS_TP = 371 * MiB;
constexpr size_t WS_MERGED = 403 * MiB;
constexpr size_t WS_PROJ = 435 * MiB;
constexpr size_t WS_HID = 435 * MiB;
constexpr size_t WS_YBUF = 537 * MiB;
constexpr size_t WS_RS = 629 * MiB;
constexpr size_t WS_END = 731 * MiB;
constexpr int CW_BAR = 4096;
constexpr int CW_MOE = 16384;

constexpr int LDS_BYTES = 147456;
constexpr int SCR_BYTES = 139264;
constexpr int MISC_OFF = SCR_BYTES;

__device__ __forceinline__ unsigned pk2(float lo, float hi) { f32x2 v = {lo, hi}; bf16x2_t b = __builtin_convertvector(v, bf16x2_t); return __builtin_bit_cast(unsigned, b); }
__device__ __forceinline__ int opaque_i(int v) { asm volatile("" : "+v"(v)); return v; }
__device__ __forceinline__ int lane_id() { int l; asm volatile("v_mbcnt_lo_u32_b32 %0, -1, 0\n\tv_mbcnt_hi_u32_b32 %0, -1, %0" : "=&v"(l)); return l; }
__device__ __forceinline__ int tid_of(int wave0) { int w = wave0; asm volatile("" : "+s"(w)); return opaque_i(w * 64 + lane_id()); }
__device__ __forceinline__ float bf2f(unsigned short x) { return __uint_as_float((unsigned)x << 16); }
__device__ __forceinline__ unsigned pk4_u8(float a, float b, float c, float d) {
    unsigned r = 0; r = __builtin_amdgcn_cvt_pk_u8_f32(__builtin_fmaf(a, 256.f, -0.5f), 0, r); r = __builtin_amdgcn_cvt_pk_u8_f32(__builtin_fmaf(b, 256.f, -0.5f), 1, r);
    r = __builtin_amdgcn_cvt_pk_u8_f32(__builtin_fmaf(c, 256.f, -0.5f), 2, r); r = __builtin_amdgcn_cvt_pk_u8_f32(__builtin_fmaf(d, 256.f, -0.5f), 3, r); return r; }
__device__ __forceinline__ float ub8(unsigned x, int j) { return (float)((x >> (8 * j)) & 0xffu) + 0.5f; }
__device__ __forceinline__ float bflo(unsigned x) { return __uint_as_float(x << 16); }
__device__ __forceinline__ float bfhi(unsigned x) { return __uint_as_float(x & 0xffff0000u); }
__device__ __forceinline__ float wave_sum(float v) {
#pragma unroll
    for (int o = 1; o < 64; o <<= 1) v += __shfl_xor(v, o);
    return v;
}
constexpr float RS_SCALE = 16777216.0f;
constexpr float W8S = 64.0f, H8S = 8.0f;
typedef int i32x8 __attribute__((ext_vector_type(8)));
__device__ __forceinline__ float sat8(float x) { return __builtin_amdgcn_fmed3f(x, -448.0f, 448.0f); }
__device__ __forceinline__ unsigned pk4_fp8(float a, float b, float c, float d) { int r = 0; a = sat8(a); b = sat8(b); c = sat8(c); d = sat8(d); r = __builtin_amdgcn_cvt_pk_fp8_f32(a, b, r, false); r = __builtin_amdgcn_cvt_pk_fp8_f32(c, d, r, true); return (unsigned)r; }
__device__ __forceinline__ float rs_rstd(unsigned long long v) { return __builtin_amdgcn_rsqf((float)v * (1.0f / (RS_SCALE * D)) + RMS_EPS); }
__device__ __forceinline__ float fast_sigmoid(float x) { return __builtin_amdgcn_rcpf(1.0f + __builtin_amdgcn_exp2f(-1.44269504f * x)); }
__device__ __forceinline__ float gelu_tanh(float x) { const float z = 0.7978845608f * (x + 0.044715f * x * x * x); return x * fast_sigmoid(2.0f * z); }

namespace pg8 {
constexpr int BM = 256, BK = 64, HALF = 128, HTB = HALF * BK * 2, STAGE_BYTES = 8 * HTB, NXCD = 8, WGM = 8;
__host__ __device__ __forceinline__ int lds_byte(int r, int c) { const int st = (r >> 4) * 2 + (c >> 5), rr = r & 15, cc = c & 31, ob = rr * 64 + cc * 2; return st * 1024 + (ob ^ (((ob >> 9) & 1) << 5)); }
__host__ __device__ __forceinline__ void stage_rc(int b, int& R, int& C) { const int st = b / 1024, sb = b % 1024, swz = sb ^ (((sb >> 9) & 1) << 5); R = (st >> 1) * 16 + swz / 64; C = (st & 1) * 32 + (swz % 64) / 2; }
__host__ __device__ __forceinline__ int perm32(int rho) { const int n = rho >> 4, i = rho & 15; return 8 * (i >> 2) + 4 * n + (i & 3); }

struct Unit { int pm, pn, sub, aux; };
__device__ __forceinline__ bool tile_of(long L, int nM, int nN, int& pm, int& pn) {
    const int nwg = nM * nN; if (L >= nwg) return false;
    int wgid = (int)L; { const int q = nwg / NXCD, r = nwg % NXCD, xcd = wgid % NXCD, off = wgid / NXCD; wgid = (xcd < r ? xcd * (q + 1) : r * (q + 1) + (xcd - r) * q) + off; }
    const int nig = WGM * nN, gid = wgid / nig, fm = gid * WGM, gsz = (nM - fm) < WGM ? (nM - fm) : WGM;
    pm = fm + ((wgid % nig) % gsz); pn = (wgid % nig) / gsz; return true;
}
struct SchedPlain {
    const char* A; const char* B; int lda2, ldb2, nt, nM, nN, G, c;
    __device__ __forceinline__ bool next(int i, Unit& u) const { u.sub = 0; u.aux = 0; return tile_of((long)i * G + c, nM, nN, u.pm, u.pn); }
    __device__ __forceinline__ const char* a_ptr(const Unit& u) const { return A + (size_t)u.pm * 256 * lda2; }
    __device__ __forceinline__ const char* b_ptr(const Unit& u) const { return B + (size_t)u.pn * 256 * ldb2; }
    __device__ __forceinline__ int ntiles(const Unit&) const { return nt; }
    __device__ __forceinline__ unsigned row_off(const Unit&, int) const { return 0u; }
};
struct SchedMerge {
    const char* A; const char* B; int lda2, ldb2, nM, nN, G, c;
    __device__ __forceinline__ bool next(int i, Unit& u) const { u.sub = i % 3; u.aux = 0; return tile_of((long)(i / 3) * G + c, nM, nN, u.pm, u.pn); }
    __device__ __forceinline__ int koff(const Unit& u) const { return u.sub == 0 ? 0 : (u.sub == 1 ? 512 : 1536); }
    __device__ __forceinline__ const char* a_ptr(const Unit& u) const { return A + (size_t)u.pm * 256 * lda2 + koff(u) * 2; }
    __device__ __forceinline__ const char* b_ptr(const Unit& u) const { return B + (size_t)u.pn * 256 * ldb2 + koff(u) * 2; }
    __device__ __forceinline__ int ntiles(const Unit& u) const { return u.sub == 1 ? 16 : 8; }
    __device__ __forceinline__ unsigned row_off(const Unit&, int) const { return 0u; }
};
struct SchedMoe {
    const char* A; const char* B; const int* list; int lda2, ldb2, nt, nN, G, c; size_t bstride; bool gather;
    int t1, t2, t3, t4, t5, t6, t7, t8;
    const unsigned* cntp;
    __device__ __forceinline__ bool next(int i, Unit& u) const {
        if (!tile_of((long)i * G + c, t8, nN, u.pm, u.pn)) return false;
        const int pm = u.pm; int e = 0, a = 0;
        if (pm >= t1) { e = 1; a = t1; } if (pm >= t2) { e = 2; a = t2; } if (pm >= t3) { e = 3; a = t3; } if (pm >= t4) { e = 4; a = t4; }
        if (pm >= t5) { e = 5; a = t5; } if (pm >= t6) { e = 6; a = t6; } if (pm >= t7) { e = 7; a = t7; }
        u.sub = e; u.aux = a; return true;
    }
    __device__ __forceinline__ int cnt_of(int e) const { return __builtin_amdgcn_readfirstlane((int)cntp[e * 64]); }
    __device__ __forceinline__ const char* a_ptr(const Unit& u) const { return gather ? A : A + (size_t)u.pm * 256 * lda2; }
    __device__ __forceinline__ const char* b_ptr(const Unit& u) const { return B + (size_t)u.sub * bstride + (size_t)u.pn * 256 * ldb2; }
    __device__ __forceinline__ int ntiles(const Unit&) const { return nt; }
    __device__ __forceinline__ unsigned row_off(const Unit& u, int lrow) const {
        const int pos = (u.pm - u.aux) * 256 + lrow; const int cn = cnt_of(u.sub);
        const int tok = list[u.sub * 16384 + (pos < cn ? pos : 0)];
        return (unsigned)tok * (unsigned)lda2;
    }
};

template <class Epi, class Sched, bool ALIGN_EPI, bool GATHER, bool FP8 = false>
__device__ __forceinline__ void gemm_phase(LAS unsigned char* lds, const Sched& S, const Epi& E, int wave0) {
    const int tid = tid_of(wave0), wid = __builtin_amdgcn_readfirstlane(tid >> 6), lane = tid & 63, wr = wid >> 2, wc = wid & 3, fr = lane & 15, fq = lane >> 4;
    const int lda2 = S.lda2, ldb2 = S.ldb2;
    unsigned vA0[2], vA1[2], voffB[2];
    LAS unsigned* rowtab = (LAS unsigned*)(lds + STAGE_BYTES);
#pragma unroll
    for (int i = 0; i < 2; ++i) { int R, C; stage_rc(tid * 16 + i * 8192, R, C); const int Rb = Epi::PERM ? ((R & ~31) + perm32(R & 31)) : R;
        voffB[i] = (unsigned)(Rb * ldb2 + C * 2); vA0[i] = (unsigned)(R * lda2 + C * 2); vA1[i] = vA0[i] + (unsigned)(HALF * lda2); }
    const size_t kstep = (size_t)(BK * 2);
    const size_t hstepB = (size_t)HALF * ldb2;
    const unsigned ldsw = (unsigned)wid * 1024u;
    const int aoff = lds_byte(wr * 64 + fr, fq * 8), boff = lds_byte(wc * 32 + fr, fq * 8);
#define PG8_SA(b, h) (((b) * 2 + (h)) * HTB)
#define PG8_SB(b, h) ((4 + (b) * 2 + (h)) * HTB)
#define PG8_STAGE(bufoff, gbase, voff) do { _Pragma("unroll") for (int _i = 0; _i < 2; ++_i) \
        __builtin_amdgcn_global_load_lds((const unsigned*)((const char*)(gbase) + (voff)[_i]), (LAS unsigned*)(lds + (bufoff) + ldsw + _i * 8192), 16, 0, 0); } while (0)
#define PG8_LDA(dst, b, h) do { if constexpr (FP8) { _Pragma("unroll") for (int m = 0; m < 4; ++m) { const u32x4 lo_ = *(const LAS u32x4*)(lds + PG8_SA(b, h) + aoff + m * 2048), hi_ = *(const LAS u32x4*)(lds + PG8_SA(b, h) + aoff + m * 2048 + 1024); \
        dst##8[m] = __builtin_bit_cast(i32x8, __builtin_shufflevector(lo_, hi_, 0, 1, 2, 3, 4, 5, 6, 7)); } } \
    else { _Pragma("unroll") for (int m = 0; m < 4; ++m) _Pragma("unroll") for (int k = 0; k < 2; ++k) dst[m][k] = *(const LAS bf16x8*)(lds + PG8_SA(b, h) + aoff + m * 2048 + k * 1024); } } while (0)
#define PG8_LDB(dst, b, h) do { if constexpr (FP8) { _Pragma("unroll") for (int n = 0; n < 2; ++n) { const u32x4 lo_ = *(const LAS u32x4*)(lds + PG8_SB(b, h) + boff + n * 2048), hi_ = *(const LAS u32x4*)(lds + PG8_SB(b, h) + boff + n * 2048 + 1024); \
        dst##8[n] = __builtin_bit_cast(i32x8, __builtin_shufflevector(lo_, hi_, 0, 1, 2, 3, 4, 5, 6, 7)); } } \
    else { _Pragma("unroll") for (int n = 0; n < 2; ++n) _Pragma("unroll") for (int k = 0; k < 2; ++k) dst[n][k] = *(const LAS bf16x8*)(lds + PG8_SB(b, h) + boff + n * 2048 + k * 1024); } } while (0)
#define PG8_MMA(ai, bj, At, Bt) do { __builtin_amdgcn_s_setprio(1); _Pragma("unroll") for (int m = 0; m < 4; ++m) _Pragma("unroll") for (int n = 0; n < 2; ++n) { \
        if constexpr (FP8) asm volatile("v_mfma_scale_f32_16x16x128_f8f6f4 %0, %1, %2, %0, %3, %3 op_sel_hi:[0,0,0]" : "+v"(acc[ai][bj][m][n]) : "v"(Bt##8[n]), "v"(At##8[m]), "v"(sc1)); \
        else { _Pragma("unroll") for (int k = 0; k < 2; ++k) acc[ai][bj][m][n] = __builtin_amdgcn_mfma_f32_16x16x32_bf16(Bt[n][k], At[m][k], acc[ai][bj][m][n], 0, 0, 0); } } \
        __builtin_amdgcn_s_setprio(0); } while (0)
#define PG8_WAIT_V(n) asm volatile("s_waitcnt vmcnt(" #n ")" ::: "memory")
#define PG8_WAIT_L(n) asm volatile("s_waitcnt lgkmcnt(" #n ")" ::: "memory")
#define PG8_BAR __builtin_amdgcn_s_barrier()
#define PG8_SCHED __builtin_amdgcn_sched_barrier(0)
    Unit cur, nxt; int ui = 0;
    if (!S.next(0, cur)) return;
    f32x4 acc[2][2][4][2];
#pragma unroll
    for (int a = 0; a < 2; ++a)
#pragma unroll
        for (int b = 0; b < 2; ++b)
#pragma unroll
            for (int m = 0; m < 4; ++m)
#pragma unroll
                for (int n = 0; n < 2; ++n) acc[a][b][m][n] = (f32x4){0.f, 0.f, 0.f, 0.f};
    bf16x8 At[4][2], B0[2][2], B1[2][2];
    i32x8 At8[4], B08[2], B18[2]; const int sc1 = 0x7F7F7F7F;
    const char* cA = S.a_ptr(cur); const char* cB = S.b_ptr(cur); int nt = S.ntiles(cur);
    if constexpr (GATHER) {
#pragma unroll
        for (int i = 0; i < 2; ++i) { int R, C; stage_rc(tid * 16 + i * 8192, R, C); vA0[i] = S.row_off(cur, R) + (unsigned)(C * 2); vA1[i] = S.row_off(cur, HALF + R) + (unsigned)(C * 2); }
    }
    PG8_STAGE(PG8_SB(0, 0), cB, voffB); PG8_STAGE(PG8_SB(0, 1), cB + hstepB, voffB); PG8_STAGE(PG8_SA(0, 0), cA, vA0); PG8_STAGE(PG8_SA(0, 1), cA, vA1);
    if (wr == 1) PG8_BAR;
    PG8_WAIT_V(2); PG8_BAR;
    PG8_STAGE(PG8_SB(1, 0), cB + kstep, voffB); PG8_STAGE(PG8_SA(1, 0), cA + kstep, vA0); PG8_STAGE(PG8_SB(1, 1), cB + hstepB + kstep, voffB);
    PG8_WAIT_V(6); PG8_BAR;
    for (;;) {
        const bool has_next = S.next(ui + 1, nxt);
        const char* nA = has_next ? S.a_ptr(nxt) : cA; const char* nB = has_next ? S.b_ptr(nxt) : cB;
        for (int t = 0; t < nt; t += 2) {
            const bool last = (t == nt - 2);
            const char* a1 = cA + (size_t)(t + 1) * kstep;
            const char* a2 = last ? nA : cA + (size_t)(t + 2) * kstep; const char* b2 = last ? nB : cB + (size_t)(t + 2) * kstep;
            const char* a3 = a2 + kstep; const char* b3 = b2 + kstep;
            if constexpr (GATHER) { if (last && has_next) { if (tid < 256) rowtab[tid] = S.row_off(nxt, tid); } }
            PG8_LDB(B0, 0, 0); PG8_LDB(B1, 0, 1); PG8_SCHED; PG8_LDA(At, 0, 0); PG8_STAGE(PG8_SA(1, 1), a1, vA1);
            PG8_WAIT_V(8); PG8_WAIT_L(0); PG8_BAR; PG8_MMA(0, 0, At, B0); PG8_MMA(0, 1, At, B1); PG8_BAR; PG8_SCHED;
            if constexpr (GATHER) { if (last && has_next) {
_Pragma("unroll") for (int i = 0; i < 2; ++i) { int R, C; stage_rc(tid * 16 + i * 8192, R, C); vA0[i] = rowtab[R] + (unsigned)(C * 2); vA1[i] = rowtab[HALF + R] + (unsigned)(C * 2); } } }
            PG8_LDA(At, 0, 1); PG8_STAGE(PG8_SB(0, 0), b2, voffB); PG8_STAGE(PG8_SB(0, 1), b2 + hstepB, voffB); PG8_STAGE(PG8_SA(0, 0), a2, vA0);
            PG8_WAIT_V(8); PG8_WAIT_L(0); PG8_BAR; PG8_MMA(1, 0, At, B0); PG8_MMA(1, 1, At, B1); PG8_BAR; PG8_SCHED;
            PG8_LDB(B0, 1, 0); PG8_LDB(B1, 1, 1); PG8_SCHED; PG8_LDA(At, 1, 0); PG8_STAGE(PG8_SA(0, 1), a2, vA1);
            PG8_WAIT_V(8); PG8_WAIT_L(0); PG8_BAR; PG8_MMA(0, 0, At, B0); PG8_MMA(0, 1, At, B1); PG8_BAR; PG8_SCHED;
            PG8_LDA(At, 1, 1); PG8_STAGE(PG8_SB(1, 0), b3, voffB); PG8_STAGE(PG8_SB(1, 1), b3 + hstepB, voffB); PG8_STAGE(PG8_SA(1, 0), a3, vA0);
            PG8_WAIT_V(8); PG8_WAIT_L(0); PG8_BAR; PG8_MMA(1, 0, At, B0); PG8_MMA(1, 1, At, B1); PG8_BAR; PG8_SCHED;
        }
        if constexpr (ALIGN_EPI) { if (wr == 0) PG8_BAR; }
        if constexpr (FP8) asm volatile("s_nop 15\n\ts_nop 15" ::: "memory");
        E(acc, cur, wr, wc, opaque_i(fr), opaque_i(fq));
        if (!has_next) break;
        if (!(Epi::CARRY && E.keep(cur))) {
#pragma unroll
            for (int a = 0; a < 2; ++a)
#pragma unroll
                for (int b = 0; b < 2; ++b)
#pragma unroll
                    for (int m = 0; m < 4; ++m)
#pragma unroll
                        for (int n = 0; n < 2; ++n) acc[a][b][m][n] = (f32x4){0.f, 0.f, 0.f, 0.f};
        }
        cur = nxt; cA = nA; cB = nB; nt = S.ntiles(cur); ++ui;
        if constexpr (ALIGN_EPI) { if (wr == 1) PG8_BAR; }
    }
    PG8_WAIT_V(0);
    if constexpr (!ALIGN_EPI) { if (wr == 0) PG8_BAR; }
    PG8_BAR;
#undef PG8_SA
#undef PG8_SB
#undef PG8_STAGE
#undef PG8_LDA
#undef PG8_LDB
#undef PG8_MMA
#undef PG8_WAIT_V
#undef PG8_WAIT_L
#undef PG8_BAR
#undef PG8_SCHED
}

struct EpiProj {
    static constexpr bool PERM = true, CARRY = false;
    bf16* P; bf16* VT; const float* bias; const unsigned long long* rs; int pn_off; float cs;
    __device__ __forceinline__ bool keep(const Unit&) const { return false; }
    __device__ __forceinline__ void operator()(f32x4 (&acc)[2][2][4][2], const Unit& u, int wr, int wc, int fr, int fq) const {
        const int pn = u.pn + pn_off; const int row0 = u.pm * BM + wr * 64 + fr, colb = pn * BM + wc * 32 + 8 * fq;
        const int kind = (pn < 2) ? 0 : (pn < 10) ? 1 : (pn < 12) ? 3 : 4;
        unsigned long long rsv[8]; f32x4 bv[2][2];
#pragma unroll
        for (int k = 0; k < 8; ++k) rsv[k] = rs[row0 + (k >> 2) * HALF + (k & 3) * 16];
#pragma unroll
        for (int bj = 0; bj < 2; ++bj) { bv[bj][0] = *(const f32x4*)(bias + colb + bj * HALF); bv[bj][1] = *(const f32x4*)(bias + colb + bj * HALF + 4); }
        __builtin_amdgcn_sched_barrier(0);
#pragma unroll
        for (int ai = 0; ai < 2; ++ai)
#pragma unroll
            for (int m = 0; m < 4; ++m) {
                const int row = row0 + ai * HALF + m * 16;
                const float sr = rs_rstd(rsv[ai * 4 + m]) * cs;
#pragma unroll
                for (int bj = 0; bj < 2; ++bj) {
                    float v[8];
                    const f32x4 bv0 = bv[bj][0], bv1 = bv[bj][1];
#pragma unroll
                    for (int i = 0; i < 4; ++i) { v[i] = acc[ai][bj][m][0][i] * sr + bv0[i]; v[4 + i] = acc[ai][bj][m][1][i] * sr + bv1[i]; }
                    if (kind == 0) {
#pragma unroll
                        for (int e = 0; e < 8; ++e) v[e] *= 0.125f;
                    } else if (kind == 3) {
#pragma unroll
                        for (int e = 0; e < 8; ++e) v[e] = gelu_tanh(v[e]);
                    } else if (kind == 4) {
#pragma unroll
                        for (int e = 0; e < 8; ++e) v[e] = fast_sigmoid(fminf(fmaxf(v[e], -30.f), 30.f));
                    }
                    if (kind == 4) {
                        u32x2 w8; w8.x = pk4_u8(v[0], v[1], v[2], v[3]); w8.y = pk4_u8(v[4], v[5], v[6], v[7]);
                        *(u32x2*)((unsigned char*)(P + (size_t)row * PPITCH + C_GATE) + (colb - C_GATE) + bj * HALF) = w8;
                    } else { u32x4 w; w.x = pk2(v[0], v[1]); w.y = pk2(v[2], v[3]); w.z = pk2(v[4], v[5]); w.w = pk2(v[6], v[7]);
                      *(u32x4*)(P + (size_t)row * PPITCH + colb + bj * HALF) = w; }
                }
            }
    }
};
struct EpiMerge {
    static constexpr bool PERM = true, CARRY = true;
    const unsigned char* G; bf16* O;
    __device__ __forceinline__ bool keep(const Unit& u) const { return u.sub < 2; }
    __device__ __forceinline__ void operator()(f32x4 (&acc)[2][2][4][2], const Unit& u, int wr, int wc, int fr, int fq) const {
        const int row0 = u.pm * BM + wr * 64 + fr, colb = u.pn * BM + wc * 32 + 8 * fq, sub = u.sub;
#pragma unroll
        for (int ai = 0; ai < 2; ++ai) {
            u32x2 gk[4][2], gn[4][2];
#pragma unroll
            for (int m = 0; m < 4; ++m)
#pragma unroll
                for (int bj = 0; bj < 2; ++bj) {
                    const unsigned char* gp = G + (size_t)(row0 + ai * HALF + m * 16) * (2 * PPITCH) + sub * D + colb + bj * HALF;
                    gk[m][bj] = *(const u32x2*)gp;
                    if (sub < 2) gn[m][bj] = *(const u32x2*)(gp + D);
                }
            __builtin_amdgcn_sched_barrier(0);
#pragma unroll
            for (int m = 0; m < 4; ++m) {
                const int row = row0 + ai * HALF + m * 16;
#pragma unroll
                for (int bj = 0; bj < 2; ++bj) {
                    const u32x2 g4 = gk[m][bj];
                    float f[8] = {ub8(g4.x, 0), ub8(g4.x, 1), ub8(g4.x, 2), ub8(g4.x, 3), ub8(g4.y, 0), ub8(g4.y, 1), ub8(g4.y, 2), ub8(g4.y, 3)};
                    if (sub < 2) {
                        const u32x2 n4 = gn[m][bj];
                        const float d[8] = {ub8(n4.x, 0), ub8(n4.x, 1), ub8(n4.x, 2), ub8(n4.x, 3), ub8(n4.y, 0), ub8(n4.y, 1), ub8(n4.y, 2), ub8(n4.y, 3)};
#pragma unroll
                        for (int e = 0; e < 8; ++e) f[e] *= __builtin_amdgcn_rcpf(d[e]);
                    } else {
#pragma unroll
                        for (int e = 0; e < 8; ++e) f[e] *= (1.0f / 256.0f);
                    }
#pragma unroll
                    for (int n = 0; n < 2; ++n)
#pragma unroll
                        for (int i = 0; i < 4; ++i) acc[ai][bj][m][n][i] *= f[n * 4 + i];
                    if (sub == 2) {
                        u32x4 w; w.x = pk2(acc[ai][bj][m][0][0], acc[ai][bj][m][0][1]); w.y = pk2(acc[ai][bj][m][0][2], acc[ai][bj][m][0][3]);
                        w.z = pk2(acc[ai][bj][m][1][0], acc[ai][bj][m][1][1]); w.w = pk2(acc[ai][bj][m][1][2], acc[ai][bj][m][1][3]);
                        *(u32x4*)(O + (size_t)row * D + colb + bj * HALF) = w;
                    }
                }
            }
        }
    }
};
struct EpiOut {
    static constexpr bool PERM = true, CARRY = false;
    bf16* hb; unsigned long long* rs; unsigned char* hb8; float cs;
    __device__ __forceinline__ bool keep(const Unit&) const { return false; }
    __device__ __forceinline__ void operator()(f32x4 (&acc)[2][2][4][2], const Unit& u, int wr, int wc, int fr, int fq) const {
        const int row0 = u.pm * BM + wr * 64 + fr, colb = u.pn * BM + wc * 32 + 8 * fq;
#pragma unroll
        for (int ai = 0; ai < 2; ++ai) {
            u32x4 hv[4][2];
#pragma unroll
            for (int m = 0; m < 4; ++m)
#pragma unroll
                for (int bj = 0; bj < 2; ++bj) hv[m][bj] = *(const u32x4*)(hb + (size_t)(row0 + ai * HALF + m * 16) * D + colb + bj * HALF);
            __builtin_amdgcn_sched_barrier(0);
#pragma unroll
            for (int m = 0; m < 4; ++m) {
                const int row = row0 + ai * HALF + m * 16; float ss = 0.f;
#pragma unroll
                for (int bj = 0; bj < 2; ++bj) {
                    bf16* hp = hb + (size_t)row * D + colb + bj * HALF;
                    const u32x4 h4 = hv[m][bj];
                    float v[8] = {bflo(h4.x), bfhi(h4.x), bflo(h4.y), bfhi(h4.y), bflo(h4.z), bfhi(h4.z), bflo(h4.w), bfhi(h4.w)};
#pragma unroll
                    for (int n = 0; n < 2; ++n)
#pragma unroll
                        for (int i = 0; i < 4; ++i) { v[n * 4 + i] += acc[ai][bj][m][n][i] * cs; ss += v[n * 4 + i] * v[n * 4 + i]; }
                    u32x4 w; w.x = pk2(v[0], v[1]); w.y = pk2(v[2], v[3]); w.z = pk2(v[4], v[5]); w.w = pk2(v[6], v[7]);
                    *(u32x4*)hp = w;
                    if (hb8) { u32x2 w8; w8.x = pk4_fp8(v[0], v[1], v[2], v[3]); w8.y = pk4_fp8(v[4], v[5], v[6], v[7]); *(u32x2*)(hb8 + (size_t)row * D + colb + bj * HALF) = w8; }
                }
                ss += __shfl_xor(ss, 16); ss += __shfl_xor(ss, 32);
                if (fq == 0) atomicAdd(rs + row, (unsigned long long)(ss * RS_SCALE));
            }
        }
    }
};
struct EpiGU {
    static constexpr bool PERM = true, CARRY = false;
    unsigned char* Hd; int ldh; const unsigned long long* rs; const float* srow; bool moe; float cs;
    __device__ __forceinline__ bool keep(const Unit&) const { return false; }
    __device__ __forceinline__ void operator()(f32x4 (&acc)[2][2][4][2], const Unit& u, int wr, int wc, int fr, int fq) const {
        const int lrow0 = wr * 64 + fr, hcol = u.pn * HALF + wc * 32 + 8 * fq;
        float srv[8];
#pragma unroll
        for (int k = 0; k < 8; ++k) { const int lrow = lrow0 + (k >> 2) * HALF + (k & 3) * 16;
            if (moe) srv[k] = srow[u.sub * 16384 + (u.pm - u.aux) * 256 + lrow]; else srv[k] = rs_rstd(rs[u.pm * BM + lrow]); }
        __builtin_amdgcn_sched_barrier(0);
#pragma unroll
        for (int ai = 0; ai < 2; ++ai)
#pragma unroll
            for (int m = 0; m < 4; ++m) {
                const int lrow = lrow0 + ai * HALF + m * 16; const int row = u.pm * BM + lrow;
                const float sr = srv[ai * 4 + m] * cs;
                float o[8];
#pragma unroll
                for (int n = 0; n < 2; ++n)
#pragma unroll
                    for (int i = 0; i < 4; ++i) { const float g = acc[ai][0][m][n][i] * sr, uu = acc[ai][1][m][n][i] * sr; o[n * 4 + i] = g * fast_sigmoid(g) * uu * H8S; }
                u32x2 w; w.x = pk4_fp8(o[0], o[1], o[2], o[3]); w.y = pk4_fp8(o[4], o[5], o[6], o[7]);
                *(u32x2*)(Hd + (size_t)row * ldh + hcol) = w;
            }
    }
};
struct EpiMoeDown {
    static constexpr bool PERM = true, CARRY = false;
    bf16* Y; const float* wslot;
    __device__ __forceinline__ bool keep(const Unit&) const { return false; }
    __device__ __forceinline__ void operator()(f32x4 (&acc)[2][2][4][2], const Unit& u, int wr, int wc, int fr, int fq) const {
        const int lrow0 = wr * 64 + fr, colb = u.pn * BM + wc * 32 + 8 * fq;
        float wtv[8];
#pragma unroll
        for (int k = 0; k < 8; ++k) wtv[k] = wslot[u.sub * 16384 + (u.pm - u.aux) * 256 + lrow0 + (k >> 2) * HALF + (k & 3) * 16];
        __builtin_amdgcn_sched_barrier(0);
#pragma unroll
        for (int ai = 0; ai < 2; ++ai)
#pragma unroll
            for (int m = 0; m < 4; ++m) {
                const int lrow = lrow0 + ai * HALF + m * 16; const int row = u.pm * BM + lrow;
                const float wt = wtv[ai * 4 + m] * (1.0f / (W8S * H8S));
#pragma unroll
                for (int bj = 0; bj < 2; ++bj) {
                    const f32x4 v0 = acc[ai][bj][m][0] * wt, v1 = acc[ai][bj][m][1] * wt;
                    u32x4 w; w.x = pk2(v0[0], v0[1]); w.y = pk2(v0[2], v0[3]); w.z = pk2(v1[0], v1[1]); w.w = pk2(v1[2], v1[3]);
                    *(u32x4*)(Y + (size_t)row * D + colb + bj * HALF) = w;
                }
            }
    }
};
}

#define XB_TMO      128
#define XB_XCNT(j)  (256  + 64 * (j))
#define XB_XSUB(j)  (1280 + 64 * (j))
#define XB_XGEN(j)  (2304 + 64 * (j))
#define XB_TOP      3328
#define XB_TOPGEN   3392
#define XCD_BAR_WORDS 3456
#define XB_SPIN_CAP (1u << 18)
__device__ __forceinline__ unsigned xb_ld(unsigned* p)              { return __hip_atomic_load(p, __ATOMIC_RELAXED, __HIP_MEMORY_SCOPE_AGENT); }
__device__ __forceinline__ unsigned xb_add(unsigned* p, unsigned v) { return __hip_atomic_fetch_add(p, v, __ATOMIC_RELAXED, __HIP_MEMORY_SCOPE_AGENT); }
__device__ __forceinline__ unsigned xb_xcc_id() { return (unsigned)__builtin_amdgcn_s_getreg((3 << 11) | 20) & 0xFu; }
#define XB_SPIN(cond, bar) do { unsigned _sp = 0; while (cond) { __builtin_amdgcn_s_sleep(1); \
    if ((++_sp & 255u) == 0u) { if (xb_ld(&(bar)[XB_TMO])) break; if (_sp > XB_SPIN_CAP) { atomicAdd(&(bar)[XB_TMO], 1u); break; } } } } while (0)
struct XcdBarrier { unsigned* bar; unsigned x; volatile LAS unsigned* st; };
__device__ __forceinline__ XcdBarrier xcd_barrier_post(unsigned* bar, volatile LAS unsigned* st, int wave0) {
    XcdBarrier b; b.bar = bar; b.x = xb_xcc_id(); b.st = st;
    if (wave0 == 0 && lane_id() == 0) (void)xb_add(&bar[XB_XCNT(b.x)], 1u);
    return b;
}
__device__ __forceinline__ void xcd_barrier_complete(unsigned* bar, unsigned x, unsigned& nloc, unsigned& nx) {
    const unsigned G = gridDim.x * gridDim.y * gridDim.z;
    unsigned sum, cnt, mine, sp = 0u;
    for (;;) {
        sum = 0u; cnt = 0u; mine = 0u;
#pragma unroll
        for (unsigned j = 0; j < 16; ++j) { const unsigned c = xb_ld(&bar[XB_XCNT(j)]); sum += c; cnt += (c > 0u) ? 1u : 0u; mine = (j == x) ? c : mine; }
        if (sum == G) break;
        __builtin_amdgcn_s_sleep(1);
        if ((++sp & 255u) == 0u) { if (xb_ld(&bar[XB_TMO])) break; if (sp > XB_SPIN_CAP) { atomicAdd(&bar[XB_TMO], 1u); break; } }
    }
    nloc = mine > 0u ? mine : 1u; nx = cnt > 0u ? cnt : 1u;
}
__device__ __forceinline__ void xcd_barrier(const XcdBarrier& b, int wave0) {
    asm volatile("s_waitcnt vmcnt(0)" ::: "memory");
    __syncthreads();
    if (wave0 == 0 && lane_id() == 0) {
        unsigned* bar = b.bar;
        __builtin_amdgcn_s_waitcnt(0);
        unsigned nloc = b.st[0], nx = b.st[1];
        if (nloc == 0u) { xcd_barrier_complete(bar, b.x, nloc, nx); b.st[0] = nloc; b.st[1] = nx; }
        const unsigned old = xb_add(&bar[XB_XSUB(b.x)], 1u);
        const unsigned gen = old / nloc;
        if (old + 1u == (gen + 1u) * nloc) {
            __builtin_amdgcn_fence(__ATOMIC_RELEASE, "agent");
            asm volatile("s_waitcnt vmcnt(0)" ::: "memory");
            const unsigned og = xb_add(&bar[XB_TOP], 1u);
            const unsigned tg = og / nx;
            if (og + 1u == (tg + 1u) * nx) xb_add(&bar[XB_TOPGEN], 1u);
            else XB_SPIN(xb_ld(&bar[XB_TOPGEN]) == tg, bar);
            __builtin_amdgcn_fence(__ATOMIC_ACQUIRE, "agent");
            xb_add(&bar[XB_XGEN(b.x)], 1u);
            asm volatile("s_waitcnt vmcnt(0)" ::: "memory");
        } else {
            XB_SPIN(xb_ld(&bar[XB_XGEN(b.x)]) == gen, bar);
            __builtin_amdgcn_fence(__ATOMIC_ACQUIRE, "agent");
            asm volatile("s_waitcnt vmcnt(0)" ::: "memory");
        }
    }
    __syncthreads();
}

struct Args {
    const float* x; const float* norm_mix_g; const float* w_in; const float* b_in; const float* na_rpb; const float* conv_w; const float* conv_b;
    const float* lru_wa; const float* lru_ba; const float* lru_wx; const float* lru_bx; const float* lru_lambda; const float* w_branch; const float* w_out;
    const float* norm_ffn_g; const float* ffn_w_gu; const float* ffn_w_down; const float* router_w; const float* moe_w_gu; const float* moe_w_down; const float* final_g;
    float* out; unsigned char* ws; int ph_lo, ph_hi, bar_region, pad;
};
struct Frame {
    LAS unsigned char* lds;
    int tid, lane, wave, vcu, G;
    unsigned* ctl;
    float* H;
    bf16 *HB, *VT, *BR, *TP, *MERGED, *PROJ, *HID, *YBUF; unsigned char* HB8;
    bf16 *WIN, *WBR, *WOUT, *WGU, *WDN, *MGU, *MDN, *WL; unsigned char* WIN8;
    float *NSP, *GW; f32x2* LSUM; unsigned long long* RS;
    int* LIST; float* SROW; float* WSLOT; int* TOKI;
};

template <int STEP> __device__ __forceinline__ u32x4 dft_table_entry(int idx);
struct TrDesc { const float* W; const float* ks; unsigned char* WT; int ldw, k0, n0, ldwt, drow0, dcol0, fp8; };
__device__ __forceinline__ void tr_load(const TrDesc& d, float (&tv)[32], float (&kv)[32], int lane) {
#pragma unroll
    for (int i = 0; i < 32; ++i) tv[i] = __builtin_nontemporal_load(d.W + (size_t)(d.k0 + 2 * i + (lane >> 5)) * d.ldw + d.n0 + (lane & 31));
    if (d.ks) {
#pragma unroll
        for (int i = 0; i < 32; ++i) kv[i] = d.ks[d.k0 + 2 * i + (lane >> 5)];
    } else {
#pragma unroll
        for (int i = 0; i < 32; ++i) kv[i] = 1.0f;
    }
}
__device__ __forceinline__ void tr_store(const TrDesc& d, const float (&tv)[32], const float (&kv)[32], LAS float* scr, int lane) {
    const float sc = d.fp8 ? W8S : 1.0f;
#pragma unroll
    for (int i = 0; i < 32; ++i) scr[(2 * i + (lane >> 5)) * 33 + (lane & 31)] = tv[i] * kv[i] * sc;
    LDS_WAIT(); asm volatile("" ::: "memory");
    const int c = lane & 7;
#pragma unroll
    for (int j = 0; j < 4; ++j) { const int n = (lane >> 3) + 8 * j; const LAS float* s = scr + (8 * c) * 33 + n;
        if (d.fp8) { u32x2 o; o.x = pk4_fp8(s[0 * 33], s[1 * 33], s[2 * 33], s[3 * 33]); o.y = pk4_fp8(s[4 * 33], s[5 * 33], s[6 * 33], s[7 * 33]);
            *(u32x2*)(d.WT + (size_t)(d.drow0 + n) * d.ldwt + d.dcol0 + d.k0 + 8 * c) = o; }
        else { u32x4 o; o.x = pk2(s[0 * 33], s[1 * 33]); o.y = pk2(s[2 * 33], s[3 * 33]); o.z = pk2(s[4 * 33], s[5 * 33]); o.w = pk2(s[6 * 33], s[7 * 33]);
            *(u32x4*)((bf16*)d.WT + (size_t)(d.drow0 + n) * d.ldwt + d.dcol0 + d.k0 + 8 * c) = o; } }
    LDS_WAIT(); asm volatile("" ::: "memory");
}
__device__ __forceinline__ int gu_row(int n0, int half) { const int isu = n0 >= half ? 1 : 0; const int hid = n0 - isu * half; return 256 * (hid >> 7) + 128 * isu + (hid & 127); }
template <int STEP> __device__ __forceinline__ u32x4 dft_table_entry(int idx);
__device__ __forceinline__ const Args& fresh_args() { const Args* p = (const Args*)__builtin_amdgcn_kernarg_segment_ptr(); asm volatile("" : "+s"(p)); return *p; }
constexpr int I_IN = 16 * 192, I_BR = 8 * 32, I_OUT = 16 * 32, I_GU = 16 * 192, I_DN = 48 * 32, I_MGU = 16 * 96, I_MDN = 24 * 32;
constexpr int N_IN = 4 * I_IN, N_BR = 8 * I_BR, N_OUT = 4 * I_OUT, N_GU = 2 * I_GU, N_DN = 2 * I_DN, N_MGU = 16 * I_MGU, N_MDN = 16 * I_MDN;
constexpr int NITEMS = N_IN + N_BR + N_OUT + N_GU + N_DN + N_MGU + N_MDN;
__device__ __forceinline__ TrDesc tr_decode(Frame& F, int it) {
    const Args& a = fresh_args(); TrDesc d; d.ks = nullptr; d.dcol0 = 0; d.fp8 = 0;
    int r = it;
    if (r < N_IN) { const int l = r / I_IN, q = r % I_IN, half = q / (I_IN / 2), q2 = q % (I_IN / 2), kb = q2 / 96, nb = q2 % 96;
        d.W = a.w_in + (size_t)l * D * INC; d.ldw = INC; d.k0 = 64 * kb; d.ks = a.norm_mix_g + l * D; d.ldwt = D; d.drow0 = 32 * nb;
        if (half == 0) { d.n0 = 32 * nb; d.WT = (unsigned char*)(F.WIN + (size_t)l * INC * D); } else { d.n0 = 3072 + 32 * nb; d.WT = F.WIN8 + (size_t)l * 3072 * D; d.fp8 = 1; }
        return d; } r -= N_IN;
    if (r < N_BR) { const int lk = r / I_BR, l = lk >> 1, k = (lk & 1) * 2, q = r % I_BR, kb = q / 32, nb = q % 32;
        d.W = a.w_branch + ((size_t)(l * 3 + k) * 512) * D; d.ldw = D; d.k0 = 64 * kb; d.n0 = 32 * nb; d.WT = (unsigned char*)(F.WBR + (size_t)l * D * BRP); d.ldwt = BRP; d.drow0 = 32 * nb; d.dcol0 = k == 0 ? 0 : 1536; return d; } r -= N_BR;
    if (r < N_OUT) { const int l = r / I_OUT, q = r % I_OUT, kb = q / 32, nb = q % 32;
        d.W = a.w_out + (size_t)l * D * D; d.ldw = D; d.k0 = 64 * kb; d.n0 = 32 * nb; d.WT = (unsigned char*)(F.WOUT + (size_t)l * D * D); d.ldwt = D; d.drow0 = 32 * nb; return d; } r -= N_OUT;
    if (r < N_GU) { const int j = r / I_GU, q = r % I_GU, kb = q / 192, nb = q % 192;
        d.W = a.ffn_w_gu + (size_t)j * D * 2 * DFF; d.ldw = 2 * DFF; d.k0 = 64 * kb; d.n0 = 32 * nb; d.ks = a.norm_ffn_g + (2 * j) * D; d.WT = (unsigned char*)(F.WGU + (size_t)j * 2 * DFF * D); d.ldwt = D; d.drow0 = gu_row(32 * nb, DFF); return d; } r -= N_GU;
    if (r < N_DN) { const int j = r / I_DN, q = r % I_DN, kb = q / 32, nb = q % 32;
        d.W = a.ffn_w_down + (size_t)j * DFF * D; d.ldw = D; d.k0 = 64 * kb; d.n0 = 32 * nb; d.WT = (unsigned char*)F.WDN + (size_t)j * D * DFF; d.ldwt = DFF; d.drow0 = 32 * nb; d.fp8 = 1; return d; } r -= N_DN;
    if (r < N_MGU) { const int je = r / I_MGU, j = je >> 3, q = r % I_MGU, kb = q / 96, nb = q % 96;
        d.W = a.moe_w_gu + (size_t)je * D * 2 * DFE; d.ldw = 2 * DFE; d.k0 = 64 * kb; d.n0 = 32 * nb; d.ks = a.norm_ffn_g + (2 * j + 1) * D; d.WT = (unsigned char*)(F.MGU + (size_t)je * 2 * DFE * D); d.ldwt = D; d.drow0 = gu_row(32 * nb, DFE); return d; } r -= N_MGU;
    { const int je = r / I_MDN, q = r % I_MDN, kb = q / 32, nb = q % 32;
        d.W = a.moe_w_down + (size_t)je * DFE * D; d.ldw = D; d.k0 = 64 * kb; d.n0 = 32 * nb; d.WT = (unsigned char*)F.MDN + (size_t)je * D * DFE; d.ldwt = DFE; d.drow0 = 32 * nb; d.fp8 = 1; return d; }
}
__device__ __forceinline__ void p0_prologue(Frame& F, const Args& a_unused) {
    LAS float* scr = (LAS float*)(F.lds + F.wave * 16384);
    const int gw = F.vcu * NWAVES + F.wave, NGW = F.G * NWAVES, lane = F.lane;
    if (gw < NITEMS) {
        TrDesc dc = tr_decode(F, gw); float tv[32], kv[32];
        tr_load(dc, tv, kv, lane);
        for (int it = gw;;) {
            const int itn = it + NGW; const bool has = itn < NITEMS;
            TrDesc dn = dc; float tn[32], kn[32];
            if (has) { dn = tr_decode(F, itn); tr_load(dn, tn, kn, lane); }
            tr_store(dc, tv, kv, scr, lane);
            if (!has) break;
            dc = dn; it = itn;
#pragma unroll
            for (int i = 0; i < 32; ++i) { tv[i] = tn[i]; kv[i] = kn[i]; }
        }
    }
    const Args& a = fresh_args();
    {
        float sv, cv; sincospif((float)lane * (1.0f / 32.0f), &sv, &cv); const float ctab = cv * 0.125f, stab = sv * 0.125f;
        for (int it = (gw & 3) ? 512 : (gw >> 2); it < 4 * 8 * 16; it += NGW) {
            const int l = it >> 7, g = (it >> 4) & 7, db = it & 15, d = db * 64 + lane;
            const float* wsrc = a.w_branch + ((size_t)(l * 3 + 1) * 512 + g * 64) * D + d;
            float w[64];
#pragma unroll
            for (int c = 0; c < 64; ++c) w[c] = wsrc[(size_t)c * D];
            bf16* dst = F.WBR + (size_t)l * D * BRP + (size_t)d * BRP + 512 + g * 64;
            for (int j = 0; j < 64; ++j) {
                float ac = 0.f, as = 0.f;
#pragma unroll
                for (int c = 0; c < 64; ++c) { const int mi = (j * c) & 63; ac += __uint_as_float((unsigned)__builtin_amdgcn_readlane((int)__float_as_uint(ctab), mi)) * w[c]; as += __uint_as_float((unsigned)__builtin_amdgcn_readlane((int)__float_as_uint(stab), mi)) * w[c]; }
                dst[j] = (bf16)(pk2(ac, 0.f) & 0xffffu); dst[512 + j] = (bf16)(pk2(as, 0.f) & 0xffffu);
            }
        }
    }
    const int gt = F.vcu * 512 + F.tid, NGT = F.G * 512;
    for (int o = gt; o < 4 * 8 * 4 * 4096; o += NGT) {
        const int in = o & 63, out = (o >> 6) & 63, mat = (o >> 12) & 3, n = (o >> 14) & 7, l = o >> 17, dir = mat >> 1;
        const float* src = (mat & 1) ? a.lru_wx : a.lru_wa;
        F.WL[o] = (bf16)(pk2(src[((((size_t)(l * 2 + dir) * 8 + n) * 64 + in) * 64) + out], 0.f) & 0xffffu);
    }
    for (int o = gt; o < 4096 + 2048; o += NGT) { u32x4* dst = (u32x4*)(F.GW) + 12288; if (o < 4096) dst[o] = dft_table_entry<0>(o); else dst[o] = dft_table_entry<1>(o - 4096); }
    for (int o = gt; o < 4 * 2 * 512; o += NGT) { const float lam = a.lru_lambda[o]; F.NSP[o] = -8.0f * log1pf(expf(-lam)); }
    for (int o = gt; o < 2 * 1024 * 8; o += NGT) { const int j = o >> 13, k = (o >> 3) & 1023; F.GW[o] = a.norm_ffn_g[(2 * j + 1) * D + k] * a.router_w[o]; }
    for (int m = gw; m < M; m += NGW) {
        const f32x4* xr = (const f32x4*)(a.x + (size_t)m * D) + lane; f32x4 v[4]; float s = 0.f;
#pragma unroll
        for (int j = 0; j < 4; ++j) { v[j] = xr[64 * j]; s += (v[j][0] * v[j][0] + v[j][1] * v[j][1]) + (v[j][2] * v[j][2] + v[j][3] * v[j][3]); }
        s = wave_sum(s);
        u32x2* o8 = (u32x2*)(F.HB + (size_t)m * D) + lane;
#pragma unroll
        for (int j = 0; j < 4; ++j) { u32x2 w; w.x = pk2(v[j][0], v[j][1]); w.y = pk2(v[j][2], v[j][3]); o8[64 * j] = w; }
        { unsigned* q8 = (unsigned*)(F.HB8 + (size_t)m * D) + lane;
#pragma unroll
          for (int j = 0; j < 4; ++j) q8[64 * j] = pk4_fp8(v[j][0], v[j][1], v[j][2], v[j][3]); }
        if (lane == 0) F.RS[m] = (unsigned long long)(s * RS_SCALE);
    }
}

__device__ __forceinline__ f32x4 mfma16(bf16x8 a, bf16x8 b, f32x4 c) { return __builtin_amdgcn_mfma_f32_16x16x32_bf16(a, b, c, 0, 0, 0); }
__device__ __forceinline__ bf16x8 tr_frag(const LAS unsigned char* p0, const LAS unsigned char* p1) {
    const s16x4 lo = __builtin_bit_cast(s16x4, __builtin_amdgcn_ds_read_tr16_b64_v4i16((LAS s16x4*)p0));
    const s16x4 hi = __builtin_bit_cast(s16x4, __builtin_amdgcn_ds_read_tr16_b64_v4i16((LAS s16x4*)p1));
    bf16x8 r; r[0] = lo[0]; r[1] = lo[1]; r[2] = lo[2]; r[3] = lo[3]; r[4] = hi[0]; r[5] = hi[1]; r[6] = hi[2]; r[7] = hi[3]; return r;
}
constexpr int AT_V1 = 65536, AT_RPB = 131072;
struct AttnK { bf16x8 q0, q1; bf16x8 kf[8][2][2]; };
__device__ __forceinline__ void attn_load_k(AttnK& K, const bf16* __restrict__ PROJ, int b, int r, int h, int j, int lane) {
    const int fr = lane & 15, rq = lane >> 4;
    const int rs = min(max(r - 4, 0), 120);
    const int cb = (j == 0) ? 0 : (j == 1) ? 8 : (j == 2) ? 24 : 32;
    const size_t tq = (size_t)b * SEQ + 64 * r + 16 * j + fr;
    const bf16* qp = PROJ + tq * PPITCH + C_Q + h * 64 + 16 * rq;
    K.q0 = *(const bf16x8*)qp; K.q1 = *(const bf16x8*)(qp + 8);
    const bf16* kbase = PROJ + ((size_t)b * SEQ + 64 * rs + cb + fr) * PPITCH + C_K + h * 64 + 16 * rq;
#pragma unroll
    for (int ir = 0; ir < 8; ++ir)
#pragma unroll
        for (int hf = 0; hf < 2; ++hf) {
            const bf16* kp = kbase + (size_t)(64 * ir + 16 * hf) * PPITCH;
            K.kf[ir][hf][0] = *(const bf16x8*)kp; K.kf[ir][hf][1] = *(const bf16x8*)(kp + 8);
        }
}
__device__ __forceinline__ void attn_compute(const AttnK& K, const LAS unsigned char* vt, const LAS float* rpb, bf16* __restrict__ BR, int b, int r, int h, int j, int lane) {
    const int fr = lane & 15, rq = lane >> 4;
    const int rs = min(max(r - 4, 0), 120);
    const int cb = (j == 0) ? 0 : (j == 1) ? 8 : (j == 2) ? 24 : 32;
    const size_t tq = (size_t)b * SEQ + 64 * r + 16 * j + fr;
    f32x4 S[8][2];
#pragma unroll
    for (int ir = 0; ir < 8; ++ir)
#pragma unroll
        for (int hf = 0; hf < 2; ++hf) {
            f32x4 s = {0.f, 0.f, 0.f, 0.f};
            s = mfma16(K.kf[ir][hf][0], K.q0, s); s = mfma16(K.kf[ir][hf][1], K.q1, s);
            S[ir][hf] = s;
        }
    const int c = 16 * j + fr, cs = min(max(c - 8, 0), 48);
    float mx = -1e30f;
#pragma unroll
    for (int ir = 0; ir < 8; ++ir) {
        const LAS float* brow = rpb + (rs + ir - r + 7) * 31;
#pragma unroll
        for (int hf = 0; hf < 2; ++hf)
#pragma unroll
            for (int i = 0; i < 4; ++i) {
                const int kc = cb + 16 * hf + 4 * rq + i; const bool valid = (kc >= cs) && (kc < cs + 16);
                const int bi = min(max(kc - c + 15, 0), 30);
                const float sv = valid ? S[ir][hf][i] + brow[bi] : -1e30f;
                S[ir][hf][i] = sv; mx = fmaxf(mx, sv);
            }
    }
    mx = fmaxf(mx, __shfl_xor(mx, 16)); mx = fmaxf(mx, __shfl_xor(mx, 32));
    float sum = 0.f;
#pragma unroll
    for (int ir = 0; ir < 8; ++ir)
#pragma unroll
        for (int hf = 0; hf < 2; ++hf)
#pragma unroll
            for (int i = 0; i < 4; ++i) { const float p = __builtin_amdgcn_exp2f((S[ir][hf][i] - mx) * 1.44269504f); S[ir][hf][i] = p; sum += p; }
    sum += __shfl_xor(sum, 16); sum += __shfl_xor(sum, 32);
    f32x4 O[4];
#pragma unroll
    for (int d = 0; d < 4; ++d) O[d] = (f32x4){0.f, 0.f, 0.f, 0.f};
    const int q4 = (lane & 15) >> 2, p4 = lane & 3;
    const LAS unsigned char* vb = vt + (cb + 4 * rq + q4) * 128 + 8 * p4;
#pragma unroll
    for (int ir = 0; ir < 8; ++ir) {
        u32x4 pw; pw.x = pk2(S[ir][0][0], S[ir][0][1]); pw.y = pk2(S[ir][0][2], S[ir][0][3]); pw.z = pk2(S[ir][1][0], S[ir][1][1]); pw.w = pk2(S[ir][1][2], S[ir][1][3]);
        const bf16x8 Bp = __builtin_bit_cast(bf16x8, pw);
#pragma unroll
        for (int d = 0; d < 4; ++d) {
            const LAS unsigned char* p0 = vb + (64 * ir) * 128 + 32 * d;
            O[d] = mfma16(tr_frag(p0, p0 + 16 * 128), Bp, O[d]);
        }
    }
    const float inv = 1.0f / sum;
#pragma unroll
    for (int d = 0; d < 4; ++d) { u32x2 w; w.x = pk2(O[d][0] * inv, O[d][1] * inv); w.y = pk2(O[d][2] * inv, O[d][3] * inv);
        *(u32x2*)(BR + tq * BRP + h * 64 + 16 * d + 4 * rq) = w; }
}
constexpr int XP = 544;
constexpr int FX_OFF = 0, FT_OFF = 128 * XP;
template <int NMT, int NNT>
__device__ __forceinline__ void dft_core(const LAS unsigned char* xl, const LAS unsigned char* tl, int wm, int cbase, int lane, f32x4 (&acc)[2][NMT][NNT]) {
#pragma unroll
    for (int p = 0; p < 2; ++p)
#pragma unroll
        for (int m = 0; m < NMT; ++m)
#pragma unroll
            for (int n = 0; n < NNT; ++n) acc[p][m][n] = (f32x4){0.f, 0.f, 0.f, 0.f};
    const int g = lane >> 4, q = (lane & 15) >> 2, p4 = lane & 3;
#pragma unroll 1
    for (int ks = 0; ks < 4; ++ks) {
        bf16x8 Bf[NNT];
#pragma unroll
        for (int n = 0; n < NNT; ++n) {
            const LAS unsigned char* p0 = xl + (32 * ks + 8 * g + q) * XP + (cbase + 16 * n + 4 * p4) * 2;
            Bf[n] = tr_frag(p0, p0 + 4 * XP);
        }
#pragma unroll
        for (int p = 0; p < 2; ++p)
#pragma unroll
            for (int m = 0; m < NMT; ++m) {
                const int tile = p * (2 * NMT) + wm * NMT + m;
                const bf16x8 Af = *(const LAS bf16x8*)(tl + ((tile * 4 + ks) * 64 + lane) * 16);
#pragma unroll
                for (int n = 0; n < NNT; ++n) acc[p][m][n] = mfma16(Af, Bf[n], acc[p][m][n]);
            }
    }
}
__device__ __forceinline__ void dft_load_x(Frame& F, const bf16* src, size_t rstride) {
    const int chunk = F.tid & 31, row0 = F.tid >> 5;
    u32x4 v[8];
#pragma unroll
    for (int it = 0; it < 8; ++it) v[it] = *(const u32x4*)(src + (size_t)(row0 + 16 * it) * rstride + chunk * 8);
#pragma unroll
    for (int it = 0; it < 8; ++it) *(LAS u32x4*)(F.lds + FX_OFF + (row0 + 16 * it) * XP + chunk * 16) = v[it];
}
template <int STEP>
__device__ __forceinline__ u32x4 dft_table_entry(int idx) {
    const int tile = idx >> 8, ks = (idx >> 6) & 3, ln = idx & 63;
    float v[8];
#pragma unroll
    for (int j = 0; j < 8; ++j) {
        const int k = 32 * ks + 8 * (ln >> 4) + j; float sv, cv;
        if (STEP == 0) { const int part = tile >> 3, prow = (tile & 7) * 16 + (ln & 15); const int mi = (prow * k) & 127; sincospif((float)mi * (1.0f / 64.0f), &sv, &cv);
            v[j] = (part == 0 ? cv : -sv) * 0.08838834764831845f; }
        else { const int part = tile >> 2, prow = (tile & 3) * 16 + (ln & 15), pin = k >> 6, n2 = k & 63; const int mi = (prow * n2) & 63; sincospif((float)mi * (1.0f / 32.0f), &sv, &cv);
            v[j] = (part == 0 ? (pin == 0 ? cv : sv) : (pin == 0 ? -sv : cv)) * 0.125f; }
    }
    u32x4 w; w.x = pk2(v[0], v[1]); w.y = pk2(v[2], v[3]); w.z = pk2(v[4], v[5]); w.w = pk2(v[6], v[7]);
    return w;
}
template <int STEP>
__device__ __forceinline__ void dft_fill_table(Frame& F) {
    constexpr int NE = (STEP == 0 ? 16 : 8) * 256;
    const u32x4* src = (const u32x4*)(F.GW) + (STEP == 0 ? 12288 : 16384);
#pragma unroll
    for (int it = 0; it < NE / 512; ++it) { const int idx = F.tid + 512 * it; *(LAS u32x4*)(F.lds + FT_OFF + idx * 16) = src[idx]; }
}
__device__ __forceinline__ void fft_a_unit(Frame& F, int unit) {
    const int b = unit >> 7, n2 = (unit >> 1) & 63, chh = unit & 1, lane = F.lane, wm = F.wave >> 2, wn = F.wave & 3, rq = lane >> 4;
    dft_load_x(F, F.PROJ + ((size_t)b * SEQ + n2) * PPITCH + C_UF + 256 * chh, (size_t)64 * PPITCH);
    LDS_WAIT(); __syncthreads();
#pragma unroll 1
    for (int cp = 0; cp < 2; ++cp) {
    f32x4 acc[2][4][2];
    dft_core<4, 2>(F.lds + FX_OFF, F.lds + FT_OFF, wm, 64 * wn + 32 * cp, lane, acc);
#pragma unroll
    for (int m = 0; m < 4; ++m)
#pragma unroll
        for (int i = 0; i < 4; ++i) {
            const int k1 = 64 * wm + 16 * m + 4 * rq + i; float sv, cv; sincospif((float)(n2 * k1) * (1.0f / 4096.0f), &sv, &cv);
            bf16* o0 = F.TP + ((((size_t)(b * 128 + k1) * 2 + 0) * 64 + n2) * 512) + 256 * chh + 64 * wn + 32 * cp + (lane & 15);
#pragma unroll
            for (int n = 0; n < 2; ++n) {
                const float tr = acc[0][m][n][i], ti = acc[1][m][n][i];
                o0[16 * n] = (bf16)(pk2(tr * cv + ti * sv, 0.f) & 0xffffu);
                o0[16 * n + 64 * 512] = (bf16)(pk2(ti * cv - tr * sv, 0.f) & 0xffffu);
            }
        }
    }
    __syncthreads();
}
__device__ __forceinline__ void fft_c_unit(Frame& F, int unit) {
    const int b = unit >> 8, k1 = (unit >> 1) & 127, chh = unit & 1, lane = F.lane, wm = F.wave >> 2, wn = F.wave & 3, rq = lane >> 4;
    dft_load_x(F, F.TP + ((size_t)(b * 128 + k1) * 128) * 512 + 256 * chh, (size_t)512);
    LDS_WAIT(); __syncthreads();
    f32x4 acc[2][2][4];
    dft_core<2, 4>(F.lds + FX_OFF, F.lds + FT_OFF, wm, 64 * wn, lane, acc);
#pragma unroll
    for (int p = 0; p < 2; ++p)
#pragma unroll
        for (int m = 0; m < 2; ++m)
#pragma unroll
            for (int i = 0; i < 4; ++i) {
                const int k2 = 32 * wm + 16 * m + 4 * rq + i;
                bf16* o0 = F.BR + ((size_t)b * SEQ + k1 + 128 * k2) * BRP + 512 + p * 512 + 256 * chh + 64 * wn + (lane & 15);
#pragma unroll
                for (int n = 0; n < 4; ++n) o0[16 * n] = (ABL & 2) ? (bf16)0 : (bf16)(pk2(acc[p][m][n][i], 0.f) & 0xffffu);
            }
    __syncthreads();
}

template <bool REV, bool FULL>
__device__ __forceinline__ void lru_scan(const f32x4 (&a)[4], const f32x4 (&bt)[4], float carry_in, f32x4 (&h)[4], float& Atot, float& Btot, int lane) {
    const int rq = lane >> 4, fr = lane & 15;
    float carry = carry_in, At = 1.f;
#pragma unroll
    for (int mm = 0; mm < 4; ++mm) {
        const int mt = REV ? 3 - mm : mm;
        float hl[4], cA[4];
        if (!REV) { hl[0] = bt[mt][0]; cA[0] = a[mt][0];
#pragma unroll
            for (int i = 1; i < 4; ++i) { hl[i] = a[mt][i] * hl[i - 1] + bt[mt][i]; cA[i] = a[mt][i] * cA[i - 1]; } }
        else { hl[3] = bt[mt][3]; cA[3] = a[mt][3];
#pragma unroll
            for (int i = 2; i >= 0; --i) { hl[i] = a[mt][i] * hl[i + 1] + bt[mt][i]; cA[i] = a[mt][i] * cA[i + 1]; } }
        float SA = REV ? cA[0] : cA[3], SB = REV ? hl[0] : hl[3];
        float pA, pB;
        if (!REV) {
            pA = __shfl_up(SA, 16); pB = __shfl_up(SB, 16); if (rq >= 1) { SB = SA * pB + SB; SA = SA * pA; }
            pA = __shfl_up(SA, 32); pB = __shfl_up(SB, 32); if (rq >= 2) { SB = SA * pB + SB; SA = SA * pA; }
        } else {
            pA = __shfl_down(SA, 16); pB = __shfl_down(SB, 16); if (rq <= 2) { SB = SA * pB + SB; SA = SA * pA; }
            pA = __shfl_down(SA, 32); pB = __shfl_down(SB, 32); if (rq <= 1) { SB = SA * pB + SB; SA = SA * pA; }
        }
        float eA, eB;
        if (!REV) { eA = __shfl_up(SA, 16); eB = __shfl_up(SB, 16); if (rq == 0) { eA = 1.f; eB = 0.f; } }
        else { eA = __shfl_down(SA, 16); eB = __shfl_down(SB, 16); if (rq == 3) { eA = 1.f; eB = 0.f; } }
        const float tA = __shfl(SA, REV ? fr : 48 + fr), tB = __shfl(SB, REV ? fr : 48 + fr);
        if (FULL) { const float hs = eA * carry + eB;
#pragma unroll
            for (int i = 0; i < 4; ++i) h[mt][i] += hl[i] + cA[i] * hs; }
        carry = tA * carry + tB; At *= tA;
        __builtin_amdgcn_sched_barrier(0);
    }
    Atot = At; Btot = carry;
}
template <int PASS>
__device__ __forceinline__ void lru_unit(Frame& F, const Args& a, int l, int b, int r) {
    const int w = F.wave, ch0 = 64 * w;
    LAS float* carry_lds = (LAS float*)(F.lds);
    if (PASS == 2) {
        const int ch = F.wave * 64 + lane_id(); float hf = 0.f, hb = 0.f;
        const f32x2* sf = F.LSUM + ((size_t)(0 * 2 + b) * 128) * 512 + ch; const f32x2* sb = F.LSUM + ((size_t)(1 * 2 + b) * 128) * 512 + ch;
        for (int r0 = 0; r0 < r; r0 += 32) {
            f32x2 sv[32];
#pragma unroll
            for (int k = 0; k < 32; ++k) sv[k] = sf[(size_t)min(r0 + k, 127) * 512];
#pragma unroll
            for (int k = 0; k < 32; ++k) if (r0 + k < r) hf = sv[k].x * hf + sv[k].y;
        }
        for (int r0 = 127; r0 > r; r0 -= 32) {
            f32x2 sv[32];
#pragma unroll
            for (int k = 0; k < 32; ++k) sv[k] = sb[(size_t)max(r0 - k, 0) * 512];
#pragma unroll
            for (int k = 0; k < 32; ++k) if (r0 - k > r) hb = sv[k].x * hb + sv[k].y;
        }
        carry_lds[ch] = hf; carry_lds[512 + ch] = hb;
        LDS_WAIT(); __syncthreads();
    }
    const int lane = lane_id(), fr = lane & 15, rq = lane >> 4;
    bf16x8 Af[4][2];
#pragma unroll
    for (int ks = 0; ks < 2; ++ks) {
        const int chA = ch0 + 32 * ks + 8 * rq;
        float cw[4][8], cbv[8];
#pragma unroll
        for (int t = 0; t < 4; ++t) { const f32x4 w0 = *(const f32x4*)(a.conv_w + ((size_t)l * 4 + t) * 512 + chA), w1 = *(const f32x4*)(a.conv_w + ((size_t)l * 4 + t) * 512 + chA + 4);
            cw[t][0] = w0[0]; cw[t][1] = w0[1]; cw[t][2] = w0[2]; cw[t][3] = w0[3]; cw[t][4] = w1[0]; cw[t][5] = w1[1]; cw[t][6] = w1[2]; cw[t][7] = w1[3]; }
        { const f32x4 b0 = *(const f32x4*)(a.conv_b + (size_t)l * 512 + chA), b1 = *(const f32x4*)(a.conv_b + (size_t)l * 512 + chA + 4);
            cbv[0] = b0[0]; cbv[1] = b0[1]; cbv[2] = b0[2]; cbv[3] = b0[3]; cbv[4] = b1[0]; cbv[5] = b1[1]; cbv[6] = b1[2]; cbv[7] = b1[3]; }
#pragma unroll
        for (int mt = 0; mt < 4; ++mt) {
            const int s = 64 * r + 16 * mt + fr;
            float c8[8];
#pragma unroll
            for (int e = 0; e < 8; ++e) c8[e] = cbv[e];
#pragma unroll
            for (int t = 0; t < 4; ++t) {
                const int sp = s + t - 2;
                if (sp >= 0 && sp < SEQ) {
                    const u32x4 uv = *(const u32x4*)(F.PROJ + ((size_t)b * SEQ + sp) * PPITCH + C_UX + chA);
                    c8[0] += cw[t][0] * bflo(uv.x); c8[1] += cw[t][1] * bfhi(uv.x); c8[2] += cw[t][2] * bflo(uv.y); c8[3] += cw[t][3] * bfhi(uv.y);
                    c8[4] += cw[t][4] * bflo(uv.z); c8[5] += cw[t][5] * bfhi(uv.z); c8[6] += cw[t][6] * bflo(uv.w); c8[7] += cw[t][7] * bfhi(uv.w);
                }
            }
            u32x4 pw; pw.x = pk2(c8[0], c8[1]); pw.y = pk2(c8[2], c8[3]); pw.z = pk2(c8[4], c8[5]); pw.w = pk2(c8[6], c8[7]);
            Af[mt][ks] = __builtin_bit_cast(bf16x8, pw);
            __builtin_amdgcn_sched_barrier(0);
        }
    }
    const bf16* WLb = F.WL + ((size_t)(l * 8 + w) * 4) * 4096;
#pragma unroll 1
    for (int nt = 0; nt < 4; ++nt) {
        const int ch = ch0 + 16 * nt + fr;
        f32x4 cD[4];
#pragma unroll
        for (int mt = 0; mt < 4; ++mt) cD[mt] = (f32x4){0.f, 0.f, 0.f, 0.f};
#pragma unroll
        for (int ks = 0; ks < 2; ++ks) {
            bf16x8 I8;
#pragma unroll
            for (int j = 0; j < 8; ++j) I8[j] = (32 * ks + 8 * rq + j == 16 * nt + fr) ? (short)0x3F80 : (short)0;
#pragma unroll
            for (int mt = 0; mt < 4; ++mt) cD[mt] = mfma16(Af[mt][ks], I8, cD[mt]);
        }
        f32x4 hsum[4];
#pragma unroll
        for (int mt = 0; mt < 4; ++mt) hsum[mt] = (f32x4){0.f, 0.f, 0.f, 0.f};
        bf16x8 Bw[2][2][2];
#pragma unroll
        for (int dir = 0; dir < 2; ++dir)
#pragma unroll
            for (int mat = 0; mat < 2; ++mat)
#pragma unroll
                for (int ks = 0; ks < 2; ++ks) Bw[dir][mat][ks] = *(const bf16x8*)(WLb + (size_t)(2 * dir + mat) * 4096 + (16 * nt + fr) * 64 + 32 * ks + 8 * rq);
        float pba[2], pbx[2], pns[2];
#pragma unroll
        for (int dir = 0; dir < 2; ++dir) { pba[dir] = -1.44269504f * a.lru_ba[(size_t)(l * 2 + dir) * 512 + ch]; pbx[dir] = -1.44269504f * a.lru_bx[(size_t)(l * 2 + dir) * 512 + ch]; pns[dir] = 1.44269504f * F.NSP[(l * 2 + dir) * 512 + ch]; }
        unsigned short ggv[4][4];
        if (PASS == 2) {
#pragma unroll
            for (int mt = 0; mt < 4; ++mt)
#pragma unroll
                for (int i = 0; i < 4; ++i) ggv[mt][i] = F.PROJ[((size_t)b * SEQ + 64 * r + 16 * mt + 4 * rq + i) * PPITCH + C_UG + ch];
        }
#pragma unroll
        for (int dir = 0; dir < 2; ++dir) {
            __builtin_amdgcn_sched_barrier(0);
            f32x4 xa[4], xx[4];
#pragma unroll
            for (int mt = 0; mt < 4; ++mt) { xa[mt] = (f32x4){0.f, 0.f, 0.f, 0.f}; xx[mt] = (f32x4){0.f, 0.f, 0.f, 0.f}; }
#pragma unroll
            for (int ks = 0; ks < 2; ++ks) {
#pragma unroll
                for (int mt = 0; mt < 4; ++mt) { xa[mt] = mfma16(Af[mt][ks], Bw[dir][0][ks], xa[mt]); xx[mt] = mfma16(Af[mt][ks], Bw[dir][1][ks], xx[mt]); }
            }
            const float ba = pba[dir], bx = pbx[dir], ns = pns[dir];
            f32x4 av[4], bt[4]; float igc_first = 0.f, igc_last = 0.f;
#pragma unroll
            for (int mt = 0; mt < 4; ++mt)
#pragma unroll
                for (int i = 0; i < 4; ++i) {
                    const float rg = __builtin_amdgcn_rcpf(1.0f + __builtin_amdgcn_exp2f(__builtin_fmaf(xa[mt][i], -1.44269504f, ba)));
                    const float ig = __builtin_amdgcn_rcpf(1.0f + __builtin_amdgcn_exp2f(__builtin_fmaf(xx[mt][i], -1.44269504f, bx)));
                    const float aa = __builtin_amdgcn_exp2f(ns * rg);
                    const float mult = __builtin_amdgcn_sqrtf(fmaxf(__builtin_fmaf(-aa, aa, 1.0f), 0.f));
                    const float igc = ig * cD[mt][i];
                    if (mt == 0 && i == 0) igc_first = igc;
                    if (mt == 3 && i == 3) igc_last = igc;
                    av[mt][i] = aa; bt[mt][i] = mult * igc;
                    if (i == 3) __builtin_amdgcn_sched_barrier(0);
                }
            if (dir == 0) { if (r == 0 && rq == 0) bt[0][0] = igc_first; }
            else { if (r == 127 && rq == 3) bt[3][3] = igc_last; }
            float At, Bt;
            const float cin = (PASS == 2) ? carry_lds[dir * 512 + ch] : 0.f;
            if (dir == 0) lru_scan<false, PASS == 2>(av, bt, cin, hsum, At, Bt, lane); else lru_scan<true, PASS == 2>(av, bt, cin, hsum, At, Bt, lane);
            if (PASS == 1) { if (rq == 0) { f32x2 sm; sm.x = At; sm.y = Bt; F.LSUM[((size_t)(dir * 2 + b) * 128 + r) * 512 + ch] = sm; } }

        }
        if (PASS == 2) {
#pragma unroll
            for (int mt = 0; mt < 4; ++mt)
#pragma unroll
                for (int i = 0; i < 4; ++i) {
                    const size_t tok = (size_t)b * SEQ + 64 * r + 16 * mt + 4 * rq + i;
                    const float gg = bf2f(ggv[mt][i]);
                    F.BR[tok * BRP + 1536 + ch] = (ABL & 4) ? (bf16)0 : (bf16)(pk2(hsum[mt][i] * gg, 0.f) & 0xffffu);
                }
        }
    }
    if (PASS == 2) __syncthreads();
}

__device__ __forceinline__ void moe_router(Frame& F, int jm, const unsigned long long* rs) {
    const int gw = F.vcu * NWAVES + F.wave, NGW = F.G * NWAVES, lane = F.lane;
    const float* GWj = F.GW + (size_t)jm * 1024 * 8;
    unsigned* cnt = F.ctl + CW_MOE + jm * 8 * 64;
    LAS float* gwt = (LAS float*)F.lds;
    for (int i = F.tid; i < 1024 * 8; i += 512) gwt[(i & 7) * 1024 + (i >> 3)] = GWj[i];
    LDS_WAIT(); __syncthreads();
    for (int t = gw; t < M; t += NGW) {
        const u32x2* hr = (const u32x2*)(F.HB + (size_t)t * D) + lane;
        float lg[8];
#pragma unroll
        for (int e = 0; e < 8; ++e) lg[e] = 0.f;
#pragma unroll
        for (int j = 0; j < 4; ++j) {
            const u32x2 hw = hr[64 * j]; const float hv[4] = {bflo(hw.x), bfhi(hw.x), bflo(hw.y), bfhi(hw.y)}; const int k0 = 4 * lane + 256 * j;
#pragma unroll
            for (int e = 0; e < 8; ++e) { const f32x4 g = *(const LAS f32x4*)(gwt + e * 1024 + k0); lg[e] += (hv[0] * g[0] + hv[1] * g[1]) + (hv[2] * g[2] + hv[3] * g[3]); }
        }
#pragma unroll
        for (int e = 0; e < 8; ++e) lg[e] = wave_sum(lg[e]);
        const float sr = 1.0f / sqrtf((float)rs[t] * (1.0f / (RS_SCALE * D)) + RMS_EPS);
        int e0 = 0; float v0 = lg[0];
#pragma unroll
        for (int e = 1; e < 8; ++e) if (lg[e] > v0) { v0 = lg[e]; e0 = e; }
        int e1 = -1; float v1 = -3.0e38f;
#pragma unroll
        for (int e = 0; e < 8; ++e) if (e != e0 && lg[e] > v1) { v1 = lg[e]; e1 = e; }
        const float w0 = 1.0f / (1.0f + expf((v1 - v0) * sr)), w1 = 1.0f - w0;
        if (lane == 0) {
            const int p0 = (int)atomicAdd(cnt + e0 * 64, 1u), p1 = (int)atomicAdd(cnt + e1 * 64, 1u);
            F.LIST[e0 * 16384 + p0] = t; F.LIST[e1 * 16384 + p1] = t;
            F.SROW[e0 * 16384 + p0] = sr; F.SROW[e1 * 16384 + p1] = sr;
            F.WSLOT[e0 * 16384 + p0] = w0; F.WSLOT[e1 * 16384 + p1] = w1;
            int4 ti; ti.x = e0; ti.y = p0; ti.z = e1; ti.w = p1; ((int4*)F.TOKI)[t] = ti;
        }
    }
    __syncthreads();
}
__device__ __forceinline__ void moe_sched_init(Frame& F, int jm, pg8::SchedMoe& S) {
    const unsigned* cnt = F.ctl + CW_MOE + jm * 8 * 64;
#define RFL(x) __builtin_amdgcn_readfirstlane((int)(x))
    S.cntp = cnt;
    const int c0 = RFL(cnt[0]), c1 = RFL(cnt[64]), c2 = RFL(cnt[128]), c3 = RFL(cnt[192]), c4 = RFL(cnt[256]), c5 = RFL(cnt[320]), c6 = RFL(cnt[384]), c7 = RFL(cnt[448]);
#undef RFL
    S.t1 = (c0 + 255) >> 8; S.t2 = S.t1 + ((c1 + 255) >> 8); S.t3 = S.t2 + ((c2 + 255) >> 8); S.t4 = S.t3 + ((c3 + 255) >> 8);
    S.t5 = S.t4 + ((c4 + 255) >> 8); S.t6 = S.t5 + ((c5 + 255) >> 8); S.t7 = S.t6 + ((c6 + 255) >> 8); S.t8 = S.t7 + ((c7 + 255) >> 8);
}
__device__ __forceinline__ void moe_combine(Frame& F, const Args& a, int jm, unsigned long long* rs_next, bool final_layer) {
    const int gw = F.vcu * NWAVES + F.wave, NGW = F.G * NWAVES, lane = F.lane;
    pg8::SchedMoe S; moe_sched_init(F, jm, S);
    for (int t = gw; t < M; t += NGW) {
        const int4 ti = ((const int4*)F.TOKI)[t];
        const int ta = ti.x == 0 ? 0 : ti.x == 1 ? S.t1 : ti.x == 2 ? S.t2 : ti.x == 3 ? S.t3 : ti.x == 4 ? S.t4 : ti.x == 5 ? S.t5 : ti.x == 6 ? S.t6 : S.t7;
        const int tb = ti.z == 0 ? 0 : ti.z == 1 ? S.t1 : ti.z == 2 ? S.t2 : ti.z == 3 ? S.t3 : ti.z == 4 ? S.t4 : ti.z == 5 ? S.t5 : ti.z == 6 ? S.t6 : S.t7;
        const size_t s0 = (size_t)ta * 256 + ti.y, s1 = (size_t)tb * 256 + ti.w;
        u32x2* hr = (u32x2*)(F.HB + (size_t)t * D) + lane;
        const u32x2* y0 = (const u32x2*)(F.YBUF + s0 * D) + lane; const u32x2* y1 = (const u32x2*)(F.YBUF + s1 * D) + lane;
        f32x4 v[4]; float ss = 0.f;
#pragma unroll
        for (int j = 0; j < 4; ++j) { const u32x2 a0 = y0[64 * j], a1 = y1[64 * j], hw = hr[64 * j]; f32x4 hv;
            hv[0] = bflo(hw.x) + bflo(a0.x) + bflo(a1.x); hv[1] = bfhi(hw.x) + bfhi(a0.x) + bfhi(a1.x); hv[2] = bflo(hw.y) + bflo(a0.y) + bflo(a1.y); hv[3] = bfhi(hw.y) + bfhi(a0.y) + bfhi(a1.y);
            v[j] = hv; ss += (hv[0] * hv[0] + hv[1] * hv[1]) + (hv[2] * hv[2] + hv[3] * hv[3]); }
        ss = wave_sum(ss);
        if (final_layer) {
            const float sr = 1.0f / sqrtf(ss * (1.0f / D) + RMS_EPS);
            f32x4* orow = (f32x4*)(F.H + (size_t)t * D) + lane;
#pragma unroll
            for (int j = 0; j < 4; ++j) { const f32x4 g = *((const f32x4*)a.final_g + lane + 64 * j); orow[64 * j] = v[j] * sr * g; }
        } else {
#pragma unroll
            for (int j = 0; j < 4; ++j) { u32x2 w; w.x = pk2(v[j][0], v[j][1]); w.y = pk2(v[j][2], v[j][3]); hr[64 * j] = w; }
            { unsigned* q8 = (unsigned*)(F.HB8 + (size_t)t * D) + lane;
#pragma unroll
              for (int j = 0; j < 4; ++j) q8[64 * j] = pk4_fp8(v[j][0], v[j][1], v[j][2], v[j][3]); }
            if (lane == 0) rs_next[t] = (unsigned long long)(ss * RS_SCALE);
        }
    }
}

__device__ __forceinline__ Frame mk_frame(const Args& args, LAS unsigned char* ldsp, int wave0) {
    Frame F;
    F.lds = ldsp;
    F.tid = tid_of(wave0); F.lane = F.tid & 63; F.wave = __builtin_amdgcn_readfirstlane(F.tid >> 6);
    F.G = gridDim.x; { const int bx = blockIdx.x; F.vcu = (F.G % 8 == 0) ? (bx % 8) * (F.G / 8) + bx / 8 : bx; }
    size_t zoff = 0; asm volatile("" : "+s"(zoff)); unsigned char* ws = args.ws + zoff; float* outp = args.out + zoff;
    F.ctl = (unsigned*)(ws + WS_CTL); F.H = outp;
    F.HB8 = ws + WS_HB8; F.HB = (bf16*)(ws + WS_HB); F.VT = nullptr; F.WIN8 = ws + WS_WIN8; F.BR = (bf16*)(ws + WS_BR); F.TP = (bf16*)(ws + WS_TP); F.MERGED = (bf16*)(ws + WS_MERGED);
    F.PROJ = (bf16*)(ws + WS_PROJ); F.HID = (bf16*)(ws + WS_HID); F.YBUF = (bf16*)(ws + WS_YBUF);
    F.WIN = (bf16*)(ws + WS_WIN); F.WBR = (bf16*)(ws + WS_WBR); F.WOUT = (bf16*)(ws + WS_WOUT); F.WGU = (bf16*)(ws + WS_WGU); F.WDN = (bf16*)(ws + WS_WDN);
    F.MGU = (bf16*)(ws + WS_MGU); F.MDN = (bf16*)(ws + WS_MDN); F.WL = (bf16*)(ws + WS_WL);
    F.NSP = (float*)(ws + WS_MISC); F.GW = (float*)(ws + WS_MISC + 65536); F.LSUM = (f32x2*)(ws + WS_LSUM); F.RS = (unsigned long long*)(ws + WS_RS);
    F.LIST = (int*)(ws + WS_MOEI); F.SROW = (float*)(ws + WS_MOEI + 524288); F.WSLOT = (float*)(ws + WS_MOEI + 2 * 524288); F.TOKI = (int*)(ws + WS_MOEI + 3 * 524288);
    return F;
}
__global__ void __launch_bounds__(NWAVES * 64, 2) enc_fwd(Args args) {
    extern __shared__ __attribute__((aligned(16))) unsigned char lds[];
    LAS unsigned char* const ldsp = (LAS unsigned char*)lds;
    volatile LAS unsigned* MISC = (volatile LAS unsigned*)(ldsp + MISC_OFF);
    const int wave0 = __builtin_amdgcn_readfirstlane((int)threadIdx.x >> 6);
    for (int u = wave0 * 64 + lane_id(); u < (LDS_BYTES - MISC_OFF) / 4; u += NWAVES * 64) ((LAS unsigned*)(ldsp + MISC_OFF))[u] = 0u;
    __syncthreads();
    XcdBarrier bar = xcd_barrier_post((unsigned*)(args.ws + WS_CTL) + CW_BAR + args.bar_region * XCD_BAR_WORDS, MISC + 8, wave0);
    const int lo = args.ph_lo, hi = args.ph_hi;
#ifndef PHASE_MASK
#define PHASE_MASK 0xFFFF
#endif
#define PM(k) (((PHASE_MASK) >> (k)) & 1)
#define IN(k) (lo <= (k) && (k) < hi)
#define SEAM(k) do { if (IN(k) && IN((k) + 1)) xcd_barrier(bar, wave0); } while (0)
#define RETID() Frame F = mk_frame(args, ldsp, wave0)

    if (PM(0) && IN(0)) { RETID(); p0_prologue(F, args); }
    SEAM(0);
#pragma unroll 1
    for (int l = 0; l < DEPTH; ++l) {
        const int pb = 1 + 9 * l;
        if (PM(1) && IN(pb + 0)) {
            RETID();
            { pg8::SchedPlain S; S.A = (const char*)F.HB; S.B = (const char*)(F.WIN + (size_t)l * INC * D); S.lda2 = D * 2; S.ldb2 = D * 2; S.nt = D / 64; S.nM = M / 256; S.nN = 12; S.G = F.G; S.c = (int)blockIdx.x;
              pg8::EpiProj E; E.P = F.PROJ; E.VT = F.VT; E.bias = args.b_in + (size_t)l * INC; E.rs = F.RS + (size_t)(2 * l) * M; E.pn_off = 0; E.cs = 1.0f;
              pg8::gemm_phase<pg8::EpiProj, pg8::SchedPlain, true, false>(F.lds, S, E, wave0); }
        }
        if (PM(1) && IN(pb + 0)) {
            RETID();
            { pg8::SchedPlain S; S.A = (const char*)F.HB8; S.B = (const char*)(F.WIN8 + (size_t)l * 3072 * D); S.lda2 = D; S.ldb2 = D; S.nt = D / 128; S.nM = M / 256; S.nN = 12; S.G = F.G; S.c = (int)blockIdx.x;
              pg8::EpiProj E; E.P = F.PROJ; E.VT = F.VT; E.bias = args.b_in + (size_t)l * INC; E.rs = F.RS + (size_t)(2 * l) * M; E.pn_off = 12; E.cs = 1.0f / W8S;
              pg8::gemm_phase<pg8::EpiProj, pg8::SchedPlain, true, false, true>(F.lds, S, E, wave0); }
        }
        SEAM(pb + 0);
        if (PM(2) && IN(pb + 1)) {
            RETID();
#ifndef P2M
#define P2M 7
#endif
            if (P2M & 1) {
            dft_fill_table<0>(F);
            LDS_WAIT(); __syncthreads();
            for (int u = F.vcu; u < 256; u += F.G) fft_a_unit(F, u);
            __syncthreads(); }
            if (P2M & 2) {
            for (int u = F.vcu; u < 256; u += F.G) { const int b = u >> 7, r = u & 127, rs = min(max(r - 4, 0), 120);
#pragma unroll 1
                for (int hp = 0; hp < 4; ++hp) {
                    const int h = 2 * hp + (F.wave >> 2), j = F.wave & 3;
                    AttnK K; attn_load_k(K, F.PROJ, b, r, h, j, F.lane);
                    __syncthreads();
                    { const int chunk = F.tid & 15, t0 = F.tid >> 4;
                      const bf16* vsrc = F.PROJ + ((size_t)b * SEQ + 64 * rs) * PPITCH + C_V + 128 * hp + 8 * chunk;
#pragma unroll 1
                      for (int hh = 0; hh < 2; ++hh) {
                      u32x4 vv[8];
#pragma unroll
                      for (int it = 0; it < 8; ++it) vv[it] = *(const u32x4*)(vsrc + (size_t)(t0 + 32 * (8 * hh + it)) * PPITCH);
#pragma unroll
                      for (int it = 0; it < 8; ++it) *(LAS u32x4*)(F.lds + (chunk >> 3) * AT_V1 + (t0 + 32 * (8 * hh + it)) * 128 + (chunk & 7) * 16) = vv[it];
                      }
                      const float* rp = args.na_rpb + ((size_t)l * 8 + 2 * hp) * 465; LAS float* rl = (LAS float*)(F.lds + AT_RPB);
                      for (int i = F.tid; i < 2 * 465; i += 512) rl[i] = rp[i]; }
                    LDS_WAIT(); __syncthreads();
                    attn_compute(K, F.lds + (F.wave >> 2) * AT_V1, (const LAS float*)(F.lds + AT_RPB) + (F.wave >> 2) * 465, F.BR, b, r, h, j, F.lane);
                } }
            __syncthreads(); }
            if (P2M & 4) for (int u = F.vcu; u < 256; u += F.G) lru_unit<1>(F, args, l, u >> 7, u & 127);
        }
        SEAM(pb + 1);
        if (PM(3) && IN(pb + 2)) {
            RETID();
            dft_fill_table<1>(F);
            LDS_WAIT(); __syncthreads();
            for (int u = F.vcu; u < 512; u += F.G) fft_c_unit(F, u);
            __syncthreads();
            for (int u = F.vcu; u < 256; u += F.G) lru_unit<2>(F, args, l, u >> 7, u & 127);
        }
        SEAM(pb + 2);
        if (PM(4) && IN(pb + 3)) {
            RETID();
            pg8::SchedMerge S; S.A = (const char*)F.BR; S.B = (const char*)(F.WBR + (size_t)l * D * BRP); S.lda2 = BRP * 2; S.ldb2 = BRP * 2; S.nM = M / 256; S.nN = D / 256; S.G = F.G; S.c = (int)blockIdx.x;
            pg8::EpiMerge E; E.G = (const unsigned char*)(F.PROJ + C_GATE); E.O = F.MERGED;
            pg8::gemm_phase<pg8::EpiMerge, pg8::SchedMerge, true, false>(F.lds, S, E, wave0);
        }
        SEAM(pb + 3);
        if (PM(5) && IN(pb + 4)) {
            RETID();
            pg8::SchedPlain S; S.A = (const char*)F.MERGED; S.B = (const char*)(F.WOUT + (size_t)l * D * D); S.lda2 = D * 2; S.ldb2 = D * 2; S.nt = D / 64; S.nM = M / 256; S.nN = D / 256; S.G = F.G; S.c = (int)blockIdx.x;
            pg8::EpiOut E; E.hb = F.HB; E.rs = F.RS + (size_t)(2 * l + 1) * M; E.hb8 = nullptr; E.cs = 1.0f;
            pg8::gemm_phase<pg8::EpiOut, pg8::SchedPlain, true, false>(F.lds, S, E, wave0);
        }
        SEAM(pb + 4);
        if ((l & 1) == 0) {
            const int j = l >> 1;
            if (PM(6) && IN(pb + 5)) {
                RETID();
                pg8::SchedPlain S; S.A = (const char*)F.HB; S.B = (const char*)(F.WGU + (size_t)j * 2 * DFF * D); S.lda2 = D * 2; S.ldb2 = D * 2; S.nt = D / 64; S.nM = M / 256; S.nN = 2 * DFF / 256; S.G = F.G; S.c = (int)blockIdx.x;
                pg8::EpiGU E; E.Hd = (unsigned char*)F.HID; E.ldh = DFF; E.rs = F.RS + (size_t)(2 * l + 1) * M; E.srow = nullptr; E.moe = false; E.cs = 1.0f;
                pg8::gemm_phase<pg8::EpiGU, pg8::SchedPlain, true, false, false>(F.lds, S, E, wave0);
            }
            SEAM(pb + 5);
            if (PM(7) && IN(pb + 6)) {
                RETID();
                pg8::SchedPlain S; S.A = (const char*)F.HID; S.B = (const char*)F.WDN + (size_t)j * D * DFF; S.lda2 = DFF; S.ldb2 = DFF; S.nt = DFF / 128; S.nM = M / 256; S.nN = D / 256; S.G = F.G; S.c = (int)blockIdx.x;
                pg8::EpiOut E; E.hb = F.HB; E.rs = F.RS + (size_t)(2 * l + 2) * M; E.hb8 = F.HB8; E.cs = 1.0f / (W8S * H8S);
                pg8::gemm_phase<pg8::EpiOut, pg8::SchedPlain, true, false, true>(F.lds, S, E, wave0);
            }
            SEAM(pb + 6);
        } else {
            const int jm = l >> 1;
            if (PM(8) && IN(pb + 5)) { RETID(); moe_router(F, jm, F.RS + (size_t)(2 * l + 1) * M); }
            SEAM(pb + 5);
            if (PM(9) && IN(pb + 6)) {
                RETID();
                pg8::SchedMoe S; moe_sched_init(F, jm, S);
                S.A = (const char*)F.HB; S.B = (const char*)(F.MGU + (size_t)(jm * 8) * 2 * DFE * D); S.list = F.LIST; S.lda2 = D * 2; S.ldb2 = D * 2; S.nt = D / 64; S.nN = 2 * DFE / 256; S.G = F.G; S.c = (int)blockIdx.x;
                S.bstride = (size_t)2 * DFE * D * 2; S.gather = true;
                pg8::EpiGU E; E.Hd = (unsigned char*)F.HID; E.ldh = DFE; E.rs = nullptr; E.srow = F.SROW; E.moe = true; E.cs = 1.0f;
                pg8::gemm_phase<pg8::EpiGU, pg8::SchedMoe, true, true, false>(F.lds, S, E, wave0);
            }
            SEAM(pb + 6);
            if (PM(10) && IN(pb + 7)) {
                RETID();
                pg8::SchedMoe S; moe_sched_init(F, jm, S);
                S.A = (const char*)F.HID; S.B = (const char*)F.MDN + (size_t)(jm * 8) * D * DFE; S.list = F.LIST; S.lda2 = DFE; S.ldb2 = DFE; S.nt = DFE / 128; S.nN = D / 256; S.G = F.G; S.c = (int)blockIdx.x;
                S.bstride = (size_t)D * DFE; S.gather = false;
                pg8::EpiMoeDown E; E.Y = F.YBUF; E.wslot = F.WSLOT;
                pg8::gemm_phase<pg8::EpiMoeDown, pg8::SchedMoe, true, false, true>(F.lds, S, E, wave0);
            }
            SEAM(pb + 7);
            if (PM(11) && IN(pb + 8)) { RETID(); moe_combine(F, args, jm, F.RS + (size_t)((2 * l + 2) & 7) * M, l == DEPTH - 1); }
            SEAM(pb + 8);
        }
    }
#undef IN
#undef SEAM
}

#ifndef ABL
#define ABL 0
#endif
#ifndef MK_PER_PHASE
#define MK_PER_PHASE 0
#endif
extern "C" void kernel_launch(void* const* d_in, const int* in_sizes, int n_in, void* d_out, int out_size, void* d_ws, size_t ws_size, hipStream_t stream) {
    static int grid = 0;
    if (grid == 0) {
        if (n_in != 21 || out_size != M * D || ws_size < WS_END) { fprintf(stderr, "kernel_launch: unexpected shapes (n_in %d out %d ws %zu)\n", n_in, out_size, ws_size); grid = -1; return; }
        int dev = 0, cus = 0, per_cu = 0;
        if (hipGetDevice(&dev) != hipSuccess || hipDeviceGetAttribute(&cus, hipDeviceAttributeMultiprocessorCount, dev) != hipSuccess) { grid = -1; return; }
        if (hipFuncSetAttribute((const void*)enc_fwd, hipFuncAttributeMaxDynamicSharedMemorySize, LDS_BYTES) != hipSuccess) { fprintf(stderr, "kernel_launch: hipFuncSetAttribute failed\n"); grid = -1; return; }
        if (hipOccupancyMaxActiveBlocksPerMultiprocessor(&per_cu, (const void*)enc_fwd, NWAVES * 64, LDS_BYTES) != hipSuccess || per_cu < 1)
            fprintf(stderr, "kernel_launch: note: occupancy query reports %d workgroups per CU\n", per_cu);
        (void)hipGetLastError();
        grid = cus;
    }
    if (grid < 0) return;
    (void)hipMemsetAsync((char*)d_ws + WS_CTL, 0, CTL_ZERO_BYTES, stream);
    (void)hipMemsetAsync((char*)d_ws + WS_RS, 0, 1 * MiB, stream);
    Args a{};
    a.x = (const float*)d_in[0]; a.norm_mix_g = (const float*)d_in[1]; a.w_in = (const float*)d_in[2]; a.b_in = (const float*)d_in[3]; a.na_rpb = (const float*)d_in[4];
    a.conv_w = (const float*)d_in[5]; a.conv_b = (const float*)d_in[6]; a.lru_wa = (const float*)d_in[7]; a.lru_ba = (const float*)d_in[8]; a.lru_wx = (const float*)d_in[9];
    a.lru_bx = (const float*)d_in[10]; a.lru_lambda = (const float*)d_in[11]; a.w_branch = (const float*)d_in[12]; a.w_out = (const float*)d_in[13]; a.norm_ffn_g = (const float*)d_in[14];
    a.ffn_w_gu = (const float*)d_in[15]; a.ffn_w_down = (const float*)d_in[16]; a.router_w = (const float*)d_in[17]; a.moe_w_gu = (const float*)d_in[18]; a.moe_w_down = (const float*)d_in[19];
    a.final_g = (const float*)d_in[20];
    a.out = (float*)d_out; a.ws = (unsigned char*)d_ws;
    constexpr int NPH = 1 + 9 * DEPTH;
#ifndef PROBE_LO
#define PROBE_LO -1
#define PROBE_HI -1
#endif
    if (PROBE_LO >= 0) {
        a.ph_lo = 0; a.ph_hi = PROBE_HI; a.bar_region = 0; hipLaunchKernelGGL(enc_fwd, dim3(grid), dim3(NWAVES * 64), LDS_BYTES, stream, a);
        a.ph_lo = PROBE_LO; a.ph_hi = PROBE_HI; a.bar_region = 1; hipLaunchKernelGGL(enc_fwd, dim3(grid), dim3(NWAVES * 64), LDS_BYTES, stream, a);
        a.ph_lo = PROBE_HI; a.ph_hi = NPH; a.bar_region = 2; hipLaunchKernelGGL(enc_fwd, dim3(grid), dim3(NWAVES * 64), LDS_BYTES, stream, a);
    } else {
        a.ph_lo = 0; a.ph_hi = NPH; a.bar_region = 0;
        hipLaunchKernelGGL(enc_fwd, dim3(grid), dim3(NWAVES * 64), LDS_BYTES, stream, a);
    }
    const hipError_t le = hipPeekAtLastError();
    if (le != hipSuccess) fprintf(stderr, "kernel_launch: launch failed: %s\n", hipGetErrorName(le));
}
```

```cpp
#include <hip/hip_runtime.h>
#include <cstdio>
#include <cstdint>

#ifndef ABL
#define ABL 0
#endif
#define LAS __attribute__((address_space(3)))
#define GAS __attribute__((address_space(1)))
typedef unsigned short bf16;
typedef short bf16x8 __attribute__((ext_vector_type(8)));
typedef short s16x4 __attribute__((ext_vector_type(4)));
typedef float f32x4 __attribute__((ext_vector_type(4)));
typedef float f32x2 __attribute__((ext_vector_type(2)));
typedef unsigned u32x4 __attribute__((ext_vector_type(4)));
typedef unsigned u32x2 __attribute__((ext_vector_type(2)));
typedef __bf16 bf16x2_t __attribute__((ext_vector_type(2)));
typedef GAS unsigned gu32;
#define RLX_AGENT __ATOMIC_RELAXED, __HIP_MEMORY_SCOPE_AGENT
#define LDS_WAIT() asm volatile("s_waitcnt lgkmcnt(0)" ::: "memory")
#define VM_WAIT() asm volatile("s_waitcnt vmcnt(0)" ::: "memory")

constexpr int NB = 2, SEQ = 8192, M = NB * SEQ, D = 1024, DEPTH = 4;
constexpr int INC = 6144;
constexpr int PPITCH = 6208;
constexpr int VTP = 8256;
constexpr int C_Q = 0, C_K = 512, C_V = 1024, C_UF = 1536, C_UX = 2048, C_UG = 2560, C_GATE = 3072;
constexpr int BRP = 2112;
constexpr int DFF = 3072, DFE = 1536, NEXP = 8;
constexpr float RMS_EPS = 1e-6f;
constexpr int NWAVES = 8;

constexpr size_t MiB = 1u << 20;
constexpr size_t WS_CTL = 0, CTL_ZERO_BYTES = 1 * MiB;
constexpr size_t WS_WIN = 1 * MiB;
constexpr size_t WS_WBR = 714 * MiB;
constexpr size_t WS_WOUT = 65 * MiB;
constexpr size_t WS_WGU = 73 * MiB;
constexpr size_t WS_WDN = 97 * MiB;
constexpr size_t WS_MGU = 109 * MiB;
constexpr size_t WS_MDN = 205 * MiB;
constexpr size_t WS_WL = 253 * MiB;
constexpr size_t WS_MISC = 254 * MiB;
constexpr size_t WS_LSUM = 255 * MiB;
constexpr size_t WS_MOEI = 257 * MiB;
constexpr size_t WS_HB = 259 * MiB;
constexpr size_t WS_HB8 = 291 * MiB;
constexpr size_t WS_WIN8 = 630 * MiB;
constexpr size_t WS_BR = 647 * MiB;
constexpr size_t WS_TP = 371 * MiB;
constexpr size_t WS_MERGED = 403 * MiB;
constexpr size_t WS_PROJ = 435 * MiB;
constexpr size_t WS_HID = 435 * MiB;
constexpr size_t WS_YBUF = 537 * MiB;
constexpr size_t WS_RS = 629 * MiB;
constexpr size_t WS_END = 731 * MiB;
constexpr int CW_BAR = 4096;
constexpr int CW_MOE = 16384;

constexpr int LDS_BYTES = 147456;
constexpr int SCR_BYTES = 139264;
constexpr int MISC_OFF = SCR_BYTES;

__device__ __forceinline__ unsigned pk2(float lo, float hi) { f32x2 v = {lo, hi}; bf16x2_t b = __builtin_convertvector(v, bf16x2_t); return __builtin_bit_cast(unsigned, b); }
__device__ __forceinline__ int opaque_i(int v) { asm volatile("" : "+v"(v)); return v; }
__device__ __forceinline__ int lane_id() { int l; asm volatile("v_mbcnt_lo_u32_b32 %0, -1, 0\n\tv_mbcnt_hi_u32_b32 %0, -1, %0" : "=&v"(l)); return l; }
__device__ __forceinline__ int tid_of(int wave0) { int w = wave0; asm volatile("" : "+s"(w)); return opaque_i(w * 64 + lane_id()); }
__device__ __forceinline__ float bf2f(unsigned short x) { return __uint_as_float((unsigned)x << 16); }
__device__ __forceinline__ unsigned pk4_u8(float a, float b, float c, float d) {
    unsigned r = 0; r = __builtin_amdgcn_cvt_pk_u8_f32(__builtin_fmaf(a, 256.f, -0.5f), 0, r); r = __builtin_amdgcn_cvt_pk_u8_f32(__builtin_fmaf(b, 256.f, -0.5f), 1, r);
    r = __builtin_amdgcn_cvt_pk_u8_f32(__builtin_fmaf(c, 256.f, -0.5f), 2, r); r = __builtin_amdgcn_cvt_pk_u8_f32(__builtin_fmaf(d, 256.f, -0.5f), 3, r); return r; }
__device__ __forceinline__ u32x4 pair16(u32x2 a, u32x2 b) {
    const auto rx = __builtin_amdgcn_permlane16_swap(a.x, b.x, false, false); const auto ry = __builtin_amdgcn_permlane16_swap(a.y, b.y, false, false);
    u32x4 r; r.x = rx[0]; r.y = ry[0]; r.z = rx[1]; r.w = ry[1]; return r;
}
__device__ __forceinline__ float ub8(unsigned x, int j) { return (float)((x >> (8 * j)) & 0xffu) + 0.5f; }
__device__ __forceinline__ float bflo(unsigned x) { return __uint_as_float(x << 16); }
__device__ __forceinline__ float bfhi(unsigned x) { return __uint_as_float(x & 0xffff0000u); }
__device__ __forceinline__ float wave_sum(float v) {
#pragma unroll
    for (int o = 1; o < 64; o <<= 1) v += __shfl_xor(v, o);
    return v;
}
constexpr float RS_SCALE = 16777216.0f;
constexpr float W8S = 64.0f, H8S = 8.0f;
typedef int i32x8 __attribute__((ext_vector_type(8)));
__device__ __forceinline__ float sat8(float x) { return __builtin_amdgcn_fmed3f(x, -448.0f, 448.0f); }
__device__ __forceinline__ unsigned pk4_fp8(float a, float b, float c, float d) { int r = 0; a = sat8(a); b = sat8(b); c = sat8(c); d = sat8(d); r = __builtin_amdgcn_cvt_pk_fp8_f32(a, b, r, false); r = __builtin_amdgcn_cvt_pk_fp8_f32(c, d, r, true); return (unsigned)r; }
__device__ __forceinline__ float rs_rstd(unsigned long long v) { return __builtin_amdgcn_rsqf((float)v * (1.0f / (RS_SCALE * D)) + RMS_EPS); }
__device__ __forceinline__ float fast_sigmoid(float x) { return __builtin_amdgcn_rcpf(1.0f + __builtin_amdgcn_exp2f(-1.44269504f * x)); }
__device__ __forceinline__ float gelu_tanh(float x) { const float z = 0.7978845608f * (x + 0.044715f * x * x * x); return x * fast_sigmoid(2.0f * z); }

namespace pg8 {
constexpr int BM = 256, BK = 64, HALF = 128, HTB = HALF * BK * 2, STAGE_BYTES = 8 * HTB, NXCD = 8, WGM = 8;
__host__ __device__ __forceinline__ int lds_byte(int r, int c) { const int st = (r >> 4) * 2 + (c >> 5), rr = r & 15, cc = c & 31, ob = rr * 64 + cc * 2; return st * 1024 + (ob ^ (((ob >> 9) & 1) << 5)); }
__host__ __device__ __forceinline__ void stage_rc(int b, int& R, int& C) { const int st = b / 1024, sb = b % 1024, swz = sb ^ (((sb >> 9) & 1) << 5); R = (st >> 1) * 16 + swz / 64; C = (st & 1) * 32 + (swz % 64) / 2; }
__host__ __device__ __forceinline__ int perm32(int rho) { const int n = rho >> 4, i = rho & 15; return 8 * (i >> 2) + 4 * n + (i & 3); }

struct Unit { int pm, pn, sub, aux; };
__device__ __forceinline__ bool tile_of(long L, int nM, int nN, int& pm, int& pn) {
    const int nwg = nM * nN; if (L >= nwg) return false;
    int wgid = (int)L; { const int q = nwg / NXCD, r = nwg % NXCD, xcd = wgid % NXCD, off = wgid / NXCD; wgid = (xcd < r ? xcd * (q + 1) : r * (q + 1) + (xcd - r) * q) + off; }
    const int nig = WGM * nN, gid = wgid / nig, fm = gid * WGM, gsz = (nM - fm) < WGM ? (nM - fm) : WGM;
    pm = fm + ((wgid % nig) % gsz); pn = (wgid % nig) / gsz; return true;
}
struct SchedPlain {
    const char* A; const char* B; int lda2, ldb2, nt, nM, nN, G, c;
    __device__ __forceinline__ bool next(int i, Unit& u) const { u.sub = 0; u.aux = 0; return tile_of((long)i * G + c, nM, nN, u.pm, u.pn); }
    __device__ __forceinline__ const char* a_ptr(const Unit& u) const { return A + (size_t)u.pm * 256 * lda2; }
    __device__ __forceinline__ const char* b_ptr(const Unit& u) const { return B + (size_t)u.pn * 256 * ldb2; }
    __device__ __forceinline__ int ntiles(const Unit&) const { return nt; }
    __device__ __forceinline__ unsigned row_off(const Unit&, int) const { return 0u; }
};
struct SchedMerge {
    const char* A; const char* B; int lda2, ldb2, nM, nN, G, c;
    __device__ __forceinline__ bool next(int i, Unit& u) const { u.sub = i % 3; u.aux = 0; return tile_of((long)(i / 3) * G + c, nM, nN, u.pm, u.pn); }
    __device__ __forceinline__ int koff(const Unit& u) const { return u.sub == 0 ? 0 : (u.sub == 1 ? 512 : 1536); }
    __device__ __forceinline__ const char* a_ptr(const Unit& u) const { return A + (size_t)u.pm * 256 * lda2 + koff(u) * 2; }
    __device__ __forceinline__ const char* b_ptr(const Unit& u) const { return B + (size_t)u.pn * 256 * ldb2 + koff(u) * 2; }
    __device__ __forceinline__ int ntiles(const Unit& u) const { return u.sub == 1 ? 16 : 8; }
    __device__ __forceinline__ unsigned row_off(const Unit&, int) const { return 0u; }
};
struct SchedMoe {
    const char* A; const char* B; const int* list; int lda2, ldb2, nt, nN, G, c; size_t bstride; bool gather;
    int t1, t2, t3, t4, t5, t6, t7, t8;
    const unsigned* cntp;
    __device__ __forceinline__ bool next(int i, Unit& u) const {
        if (!tile_of((long)i * G + c, t8, nN, u.pm, u.pn)) return false;
        const int pm = u.pm; int e = 0, a = 0;
        if (pm >= t1) { e = 1; a = t1; } if (pm >= t2) { e = 2; a = t2; } if (pm >= t3) { e = 3; a = t3; } if (pm >= t4) { e = 4; a = t4; }
        if (pm >= t5) { e = 5; a = t5; } if (pm >= t6) { e = 6; a = t6; } if (pm >= t7) { e = 7; a = t7; }
        u.sub = e; u.aux = a; return true;
    }
    __device__ __forceinline__ int cnt_of(int e) const { return __builtin_amdgcn_readfirstlane((int)cntp[e * 64]); }
    __device__ __forceinline__ const char* a_ptr(const Unit& u) const { return gather ? A : A + (size_t)u.pm * 256 * lda2; }
    __device__ __forceinline__ const char* b_ptr(const Unit& u) const { return B + (size_t)u.sub * bstride + (size_t)u.pn * 256 * ldb2; }
    __device__ __forceinline__ int ntiles(const Unit&) const { return nt; }
    __device__ __forceinline__ unsigned row_off(const Unit& u, int lrow) const {
        const int pos = (u.pm - u.aux) * 256 + lrow; const int cn = cnt_of(u.sub);
        const int tok = list[u.sub * 16384 + (pos < cn ? pos : 0)];
        return (unsigned)tok * (unsigned)lda2;
    }
};

template <class Epi, class Sched, bool ALIGN_EPI, bool GATHER, bool FP8 = false>
__device__ __forceinline__ void gemm_phase(LAS unsigned char* lds, const Sched& S, const Epi& E, int wave0) {
    const int tid = tid_of(wave0), wid = __builtin_amdgcn_readfirstlane(tid >> 6), lane = tid & 63, wr = wid >> 2, wc = wid & 3, fr = lane & 15, fq = lane >> 4;
    const int lda2 = S.lda2, ldb2 = S.ldb2;
    unsigned vA0[2], vA1[2], voffB[2];
    LAS unsigned* rowtab = (LAS unsigned*)(lds + STAGE_BYTES);
#pragma unroll
    for (int i = 0; i < 2; ++i) { int R, C; stage_rc(tid * 16 + i * 8192, R, C); const int Rb = Epi::PERM ? ((R & ~31) + perm32(R & 31)) : R;
        voffB[i] = (unsigned)(Rb * ldb2 + C * 2); vA0[i] = (unsigned)(R * lda2 + C * 2); vA1[i] = vA0[i] + (unsigned)(HALF * lda2); }
    const size_t kstep = (size_t)(BK * 2);
    const size_t hstepB = (size_t)HALF * ldb2;
    const unsigned ldsw = (unsigned)wid * 1024u;
    const int aoff = lds_byte(wr * 64 + fr, fq * 8), boff = lds_byte(wc * 32 + fr, fq * 8);
#define PG8_SA(b, h) (((b) * 2 + (h)) * HTB)
#define PG8_SB(b, h) ((4 + (b) * 2 + (h)) * HTB)
#define PG8_STAGE(bufoff, gbase, voff) do { _Pragma("unroll") for (int _i = 0; _i < 2; ++_i) \
        __builtin_amdgcn_global_load_lds((const unsigned*)((const char*)(gbase) + (voff)[_i]), (LAS unsigned*)(lds + (bufoff) + ldsw + _i * 8192), 16, 0, 0); } while (0)
#define PG8_LDA(dst, b, h) do { if constexpr (FP8) { _Pragma("unroll") for (int m = 0; m < 4; ++m) { const u32x4 lo_ = *(const LAS u32x4*)(lds + PG8_SA(b, h) + aoff + m * 2048), hi_ = *(const LAS u32x4*)(lds + PG8_SA(b, h) + aoff + m * 2048 + 1024); \
        dst##8[m] = __builtin_bit_cast(i32x8, __builtin_shufflevector(lo_, hi_, 0, 1, 2, 3, 4, 5, 6, 7)); } } \
    else { _Pragma("unroll") for (int m = 0; m < 4; ++m) _Pragma("unroll") for (int k = 0; k < 2; ++k) dst[m][k] = *(const LAS bf16x8*)(lds + PG8_SA(b, h) + aoff + m * 2048 + k * 1024); } } while (0)
#define PG8_LDB(dst, b, h) do { if constexpr (FP8) { _Pragma("unroll") for (int n = 0; n < 2; ++n) { const u32x4 lo_ = *(const LAS u32x4*)(lds + PG8_SB(b, h) + boff + n * 2048), hi_ = *(const LAS u32x4*)(lds + PG8_SB(b, h) + boff + n * 2048 + 1024); \
        dst##8[n] = __builtin_bit_cast(i32x8, __builtin_shufflevector(lo_, hi_, 0, 1, 2, 3, 4, 5, 6, 7)); } } \
    else { _Pragma("unroll") for (int n = 0; n < 2; ++n) _Pragma("unroll") for (int k = 0; k < 2; ++k) dst[n][k] = *(const LAS bf16x8*)(lds + PG8_SB(b, h) + boff + n * 2048 + k * 1024); } } while (0)
#define PG8_MMA(ai, bj, At, Bt) do { __builtin_amdgcn_s_setprio(1); _Pragma("unroll") for (int m = 0; m < 4; ++m) _Pragma("unroll") for (int n = 0; n < 2; ++n) { \
        if constexpr (FP8) asm volatile("v_mfma_scale_f32_16x16x128_f8f6f4 %0, %1, %2, %0, %3, %3 op_sel_hi:[0,0,0]" : "+v"(acc[ai][bj][m][n]) : "v"(Bt##8[n]), "v"(At##8[m]), "v"(sc1)); \
        else { _Pragma("unroll") for (int k = 0; k < 2; ++k) acc[ai][bj][m][n] = __builtin_amdgcn_mfma_f32_16x16x32_bf16(Bt[n][k], At[m][k], acc[ai][bj][m][n], 0, 0, 0); } } \
        __builtin_amdgcn_s_setprio(0); } while (0)
#define PG8_WAIT_V(n) asm volatile("s_waitcnt vmcnt(" #n ")" ::: "memory")
#define PG8_WAIT_L(n) asm volatile("s_waitcnt lgkmcnt(" #n ")" ::: "memory")
#define PG8_BAR __builtin_amdgcn_s_barrier()
#define PG8_SCHED __builtin_amdgcn_sched_barrier(0)
    Unit cur, nxt; int ui = 0;
    if (!S.next(0, cur)) return;
    f32x4 acc[2][2][4][2];
#pragma unroll
    for (int a = 0; a < 2; ++a)
#pragma unroll
        for (int b = 0; b < 2; ++b)
#pragma unroll
            for (int m = 0; m < 4; ++m)
#pragma unroll
                for (int n = 0; n < 2; ++n) acc[a][b][m][n] = (f32x4){0.f, 0.f, 0.f, 0.f};
    bf16x8 At[4][2], B0[2][2], B1[2][2];
    i32x8 At8[4], B08[2], B18[2]; const int sc1 = 0x7F7F7F7F;
    const char* cA = S.a_ptr(cur); const char* cB = S.b_ptr(cur); int nt = S.ntiles(cur);
    if constexpr (GATHER) {
#pragma unroll
        for (int i = 0; i < 2; ++i) { int R, C; stage_rc(tid * 16 + i * 8192, R, C); vA0[i] = S.row_off(cur, R) + (unsigned)(C * 2); vA1[i] = S.row_off(cur, HALF + R) + (unsigned)(C * 2); }
    }
    PG8_STAGE(PG8_SB(0, 0), cB, voffB); PG8_STAGE(PG8_SB(0, 1), cB + hstepB, voffB); PG8_STAGE(PG8_SA(0, 0), cA, vA0); PG8_STAGE(PG8_SA(0, 1), cA, vA1);
    if (wr == 1) PG8_BAR;
    PG8_WAIT_V(2); PG8_BAR;
    PG8_STAGE(PG8_SB(1, 0), cB + kstep, voffB); PG8_STAGE(PG8_SA(1, 0), cA + kstep, vA0); PG8_STAGE(PG8_SB(1, 1), cB + hstepB + kstep, voffB);
    PG8_WAIT_V(6); PG8_BAR;
    for (;;) {
        const bool has_next = S.next(ui + 1, nxt);
        const char* nA = has_next ? S.a_ptr(nxt) : cA; const char* nB = has_next ? S.b_ptr(nxt) : cB;
        for (int t = 0; t < nt; t += 2) {
            const bool last = (t == nt - 2);
            const char* a1 = cA + (size_t)(t + 1) * kstep;
            const char* a2 = last ? nA : cA + (size_t)(t + 2) * kstep; const char* b2 = last ? nB : cB + (size_t)(t + 2) * kstep;
            const char* a3 = a2 + kstep; const char* b3 = b2 + kstep;
            if constexpr (GATHER) { if (last && has_next) { if (tid < 256) rowtab[tid] = S.row_off(nxt, tid); } }
            PG8_LDB(B0, 0, 0); PG8_LDB(B1, 0, 1); PG8_SCHED; PG8_LDA(At, 0, 0); PG8_STAGE(PG8_SA(1, 1), a1, vA1);
            PG8_WAIT_V(8); PG8_WAIT_L(0); PG8_BAR; PG8_MMA(0, 0, At, B0); PG8_MMA(0, 1, At, B1); PG8_BAR; PG8_SCHED;
            if constexpr (GATHER) { if (last && has_next) {
_Pragma("unroll") for (int i = 0; i < 2; ++i) { int R, C; stage_rc(tid * 16 + i * 8192, R, C); vA0[i] = rowtab[R] + (unsigned)(C * 2); vA1[i] = rowtab[HALF + R] + (unsigned)(C * 2); } } }
            PG8_LDA(At, 0, 1); PG8_STAGE(PG8_SB(0, 0), b2, voffB); PG8_STAGE(PG8_SB(0, 1), b2 + hstepB, voffB); PG8_STAGE(PG8_SA(0, 0), a2, vA0);
            PG8_WAIT_V(8); PG8_WAIT_L(0); PG8_BAR; PG8_MMA(1, 0, At, B0); PG8_MMA(1, 1, At, B1); PG8_BAR; PG8_SCHED;
            PG8_LDB(B0, 1, 0); PG8_LDB(B1, 1, 1); PG8_SCHED; PG8_LDA(At, 1, 0); PG8_STAGE(PG8_SA(0, 1), a2, vA1);
            PG8_WAIT_V(8); PG8_WAIT_L(0); PG8_BAR; PG8_MMA(0, 0, At, B0); PG8_MMA(0, 1, At, B1); PG8_BAR; PG8_SCHED;
            PG8_LDA(At, 1, 1); PG8_STAGE(PG8_SB(1, 0), b3, voffB); PG8_STAGE(PG8_SB(1, 1), b3 + hstepB, voffB); PG8_STAGE(PG8_SA(1, 0), a3, vA0);
            PG8_WAIT_V(8); PG8_WAIT_L(0); PG8_BAR; PG8_MMA(1, 0, At, B0); PG8_MMA(1, 1, At, B1); PG8_BAR; PG8_SCHED;
        }
        if constexpr (ALIGN_EPI) { if (wr == 0) PG8_BAR; }
        if constexpr (FP8) asm volatile("s_nop 15\n\ts_nop 15" ::: "memory");
        E(acc, cur, wr, wc, opaque_i(fr), opaque_i(fq));
        if (!has_next) break;
        if (!(Epi::CARRY && E.keep(cur))) {
#pragma unroll
            for (int a = 0; a < 2; ++a)
#pragma unroll
                for (int b = 0; b < 2; ++b)
#pragma unroll
                    for (int m = 0; m < 4; ++m)
#pragma unroll
                        for (int n = 0; n < 2; ++n) acc[a][b][m][n] = (f32x4){0.f, 0.f, 0.f, 0.f};
        }
        cur = nxt; cA = nA; cB = nB; nt = S.ntiles(cur); ++ui;
        if constexpr (ALIGN_EPI) { if (wr == 1) PG8_BAR; }
    }
    PG8_WAIT_V(0);
    if constexpr (!ALIGN_EPI) { if (wr == 0) PG8_BAR; }
    PG8_BAR;
#undef PG8_SA
#undef PG8_SB
#undef PG8_STAGE
#undef PG8_LDA
#undef PG8_LDB
#undef PG8_MMA
#undef PG8_WAIT_V
#undef PG8_WAIT_L
#undef PG8_BAR
#undef PG8_SCHED
}

template <bool GATES>
struct EpiProj {
    static constexpr bool PERM = true, CARRY = false;
    bf16* P; bf16* VT; const float* bias; const unsigned long long* rs; int pn_off; float cs;
    __device__ __forceinline__ bool keep(const Unit&) const { return false; }
    __device__ __forceinline__ void operator()(f32x4 (&acc)[2][2][4][2], const Unit& u, int wr, int wc, int fr, int fq) const {
        const int pn = u.pn + pn_off; const int row0 = u.pm * BM + wr * 64 + fr, colb = pn * BM + wc * 32 + 8 * fq;
        const int kind = GATES ? 4 : (pn < 2) ? 0 : (pn < 10) ? 1 : 3;
        unsigned long long rsv[8]; f32x4 bv[2][2];
#pragma unroll
        for (int k = 0; k < 8; ++k) rsv[k] = rs[row0 + (k >> 2) * HALF + (k & 3) * 16];
#pragma unroll
        for (int bj = 0; bj < 2; ++bj) { bv[bj][0] = *(const f32x4*)(bias + colb + bj * HALF); bv[bj][1] = *(const f32x4*)(bias + colb + bj * HALF + 4); }
        __builtin_amdgcn_sched_barrier(0);
        if constexpr (GATES) {
            unsigned char* gp = (unsigned char*)(P + (size_t)(row0 + (fq & 1) * 16) * PPITCH + C_GATE) + (pn * BM - C_GATE) + wc * 32 + 8 * (fq & ~1);
#pragma unroll
            for (int ai = 0; ai < 2; ++ai)
#pragma unroll
                for (int mp = 0; mp < 2; ++mp)
#pragma unroll
                    for (int bj = 0; bj < 2; ++bj) {
                        u32x2 w8[2];
#pragma unroll
                        for (int h = 0; h < 2; ++h) {
                            const int m = mp * 2 + h; const float sr = rs_rstd(rsv[ai * 4 + m]) * cs;
                            float v[8];
                            const f32x4 bv0 = bv[bj][0], bv1 = bv[bj][1];
#pragma unroll
                            for (int i = 0; i < 4; ++i) { v[i] = acc[ai][bj][m][0][i] * sr + bv0[i]; v[4 + i] = acc[ai][bj][m][1][i] * sr + bv1[i]; }
#pragma unroll
                            for (int e = 0; e < 8; ++e) v[e] = fast_sigmoid(fminf(fmaxf(v[e], -30.f), 30.f));
                            w8[h].x = pk4_u8(v[0], v[1], v[2], v[3]); w8[h].y = pk4_u8(v[4], v[5], v[6], v[7]);
                        }
                        *(u32x4*)(gp + (size_t)(ai * HALF + mp * 32) * (2 * PPITCH) + bj * HALF) = pair16(w8[0], w8[1]);
                    }
        } else {
#pragma unroll
        for (int ai = 0; ai < 2; ++ai)
#pragma unroll
            for (int m = 0; m < 4; ++m) {
                const int row = row0 + ai * HALF + m * 16;
                const float sr = rs_rstd(rsv[ai * 4 + m]) * cs;
#pragma unroll
                for (int bj = 0; bj < 2; ++bj) {
                    float v[8];
                    const f32x4 bv0 = bv[bj][0], bv1 = bv[bj][1];
#pragma unroll
                    for (int i = 0; i < 4; ++i) { v[i] = acc[ai][bj][m][0][i] * sr + bv0[i]; v[4 + i] = acc[ai][bj][m][1][i] * sr + bv1[i]; }
                    if (kind == 0) {
#pragma unroll
                        for (int e = 0; e < 8; ++e) v[e] *= 0.125f;
                    } else if (kind == 3) {
#pragma unroll
                        for (int e = 0; e < 8; ++e) v[e] = gelu_tanh(v[e]);
                    }
                    { u32x4 w; w.x = pk2(v[0], v[1]); w.y = pk2(v[2], v[3]); w.z = pk2(v[4], v[5]); w.w = pk2(v[6], v[7]);
                      *(u32x4*)(P + (size_t)row * PPITCH + colb + bj * HALF) = w; }
                }
            }
        }
    }
};
struct EpiMerge {
    static constexpr bool PERM = true, CARRY = true;
    const unsigned char* G; bf16* O;
    __device__ __forceinline__ bool keep(const Unit& u) const { return u.sub < 2; }
    __device__ __forceinline__ void operator()(f32x4 (&acc)[2][2][4][2], const Unit& u, int wr, int wc, int fr, int fq) const {
        const int row0 = u.pm * BM + wr * 64 + fr, colb = u.pn * BM + wc * 32 + 8 * fq, sub = u.sub;
#pragma unroll
        for (int ai = 0; ai < 2; ++ai) {
            u32x2 gk[4][2], gn[4][2];
#pragma unroll
            for (int m = 0; m < 4; ++m)
#pragma unroll
                for (int bj = 0; bj < 2; ++bj) {
                    const unsigned char* gp = G + (size_t)(row0 + ai * HALF + m * 16) * (2 * PPITCH) + sub * D + colb + bj * HALF;
                    gk[m][bj] = *(const u32x2*)gp;
                    if (sub < 2) gn[m][bj] = *(const u32x2*)(gp + D);
                }
            __builtin_amdgcn_sched_barrier(0);
#pragma unroll
            for (int m = 0; m < 4; ++m) {
                const int row = row0 + ai * HALF + m * 16;
#pragma unroll
                for (int bj = 0; bj < 2; ++bj) {
                    const u32x2 g4 = gk[m][bj];
                    float f[8] = {ub8(g4.x, 0), ub8(g4.x, 1), ub8(g4.x, 2), ub8(g4.x, 3), ub8(g4.y, 0), ub8(g4.y, 1), ub8(g4.y, 2), ub8(g4.y, 3)};
                    if (sub < 2) {
                        const u32x2 n4 = gn[m][bj];
                        const float d[8] = {ub8(n4.x, 0), ub8(n4.x, 1), ub8(n4.x, 2), ub8(n4.x, 3), ub8(n4.y, 0), ub8(n4.y, 1), ub8(n4.y, 2), ub8(n4.y, 3)};
#pragma unroll
                        for (int e = 0; e < 8; ++e) f[e] *= __builtin_amdgcn_rcpf(d[e]);
                    } else {
#pragma unroll
                        for (int e = 0; e < 8; ++e) f[e] *= (1.0f / 256.0f);
                    }
#pragma unroll
                    for (int n = 0; n < 2; ++n)
#pragma unroll
                        for (int i = 0; i < 4; ++i) acc[ai][bj][m][n][i] *= f[n * 4 + i];
                    if (sub == 2) {
                        u32x4 w; w.x = pk2(acc[ai][bj][m][0][0], acc[ai][bj][m][0][1]); w.y = pk2(acc[ai][bj][m][0][2], acc[ai][bj][m][0][3]);
                        w.z = pk2(acc[ai][bj][m][1][0], acc[ai][bj][m][1][1]); w.w = pk2(acc[ai][bj][m][1][2], acc[ai][bj][m][1][3]);
                        *(u32x4*)(O + (size_t)row * D + colb + bj * HALF) = w;
                    }
                }
            }
        }
    }
};
struct EpiOut {
    static constexpr bool PERM = true, CARRY = false;
    bf16* hb; unsigned long long* rs; unsigned char* hb8; float cs;
    __device__ __forceinline__ bool keep(const Unit&) const { return false; }
    __device__ __forceinline__ void operator()(f32x4 (&acc)[2][2][4][2], const Unit& u, int wr, int wc, int fr, int fq) const {
        const int row0 = u.pm * BM + wr * 64 + fr, colb = u.pn * BM + wc * 32 + 8 * fq;
#pragma unroll
        for (int ai = 0; ai < 2; ++ai) {
            u32x4 hv[4][2];
#pragma unroll
            for (int m = 0; m < 4; ++m)
#pragma unroll
                for (int bj = 0; bj < 2; ++bj) hv[m][bj] = *(const u32x4*)(hb + (size_t)(row0 + ai * HALF + m * 16) * D + colb + bj * HALF);
            __builtin_amdgcn_sched_barrier(0);
            float ssm[4]; u32x2 w8[4][2];
#pragma unroll
            for (int m = 0; m < 4; ++m) {
                const int row = row0 + ai * HALF + m * 16; float ss = 0.f;
#pragma unroll
                for (int bj = 0; bj < 2; ++bj) {
                    bf16* hp = hb + (size_t)row * D + colb + bj * HALF;
                    const u32x4 h4 = hv[m][bj];
                    float v[8] = {bflo(h4.x), bfhi(h4.x), bflo(h4.y), bfhi(h4.y), bflo(h4.z), bfhi(h4.z), bflo(h4.w), bfhi(h4.w)};
#pragma unroll
                    for (int n = 0; n < 2; ++n)
#pragma unroll
                        for (int i = 0; i < 4; ++i) { v[n * 4 + i] += acc[ai][bj][m][n][i] * cs; ss += v[n * 4 + i] * v[n * 4 + i]; }
                    u32x4 w; w.x = pk2(v[0], v[1]); w.y = pk2(v[2], v[3]); w.z = pk2(v[4], v[5]); w.w = pk2(v[6], v[7]);
                    *(u32x4*)hp = w;
                    if (hb8) { w8[m][bj].x = pk4_fp8(v[0], v[1], v[2], v[3]); w8[m][bj].y = pk4_fp8(v[4], v[5], v[6], v[7]); }
                }
                ss += __shfl_xor(ss, 16); ss += __shfl_xor(ss, 32); ssm[m] = ss;
            }
            if (hb8) {
                unsigned char* qp = hb8 + (size_t)(row0 + ai * HALF + (fq & 1) * 16) * D + u.pn * BM + wc * 32 + 8 * (fq & ~1);
#pragma unroll
                for (int mp = 0; mp < 2; ++mp)
#pragma unroll
                    for (int bj = 0; bj < 2; ++bj) *(u32x4*)(qp + (size_t)(mp * 32) * D + bj * HALF) = pair16(w8[mp * 2][bj], w8[mp * 2 + 1][bj]);
            }
            { const float ssel = (fq == 0) ? ssm[0] : (fq == 1) ? ssm[1] : (fq == 2) ? ssm[2] : ssm[3];
              atomicAdd(rs + row0 + ai * HALF + fq * 16, (unsigned long long)(ssel * RS_SCALE)); }
        }
    }
};
struct EpiGU {
    static constexpr bool PERM = true, CARRY = false;
    unsigned char* Hd; int ldh; const unsigned long long* rs; const float* srow; bool moe; float cs;
    __device__ __forceinline__ bool keep(const Unit&) const { return false; }
    __device__ __forceinline__ void operator()(f32x4 (&acc)[2][2][4][2], const Unit& u, int wr, int wc, int fr, int fq) const {
        const int lrow0 = wr * 64 + fr, hcol = u.pn * HALF + wc * 32 + 8 * fq;
        float srv[8];
#pragma unroll
        for (int k = 0; k < 8; ++k) { const int lrow = lrow0 + (k >> 2) * HALF + (k & 3) * 16;
            if (moe) srv[k] = srow[u.sub * 16384 + (u.pm - u.aux) * 256 + lrow]; else srv[k] = rs_rstd(rs[u.pm * BM + lrow]); }
        __builtin_amdgcn_sched_barrier(0);
        unsigned char* hp = Hd + (size_t)(u.pm * BM + lrow0 + (fq & 1) * 16) * ldh + u.pn * HALF + wc * 32 + 8 * (fq & ~1);
#pragma unroll
        for (int ai = 0; ai < 2; ++ai)
#pragma unroll
            for (int mp = 0; mp < 2; ++mp) {
                u32x2 w[2];
#pragma unroll
                for (int h = 0; h < 2; ++h) {
                    const int m = mp * 2 + h; const float sr = srv[ai * 4 + m] * cs;
                    float o[8];
#pragma unroll
                    for (int n = 0; n < 2; ++n)
#pragma unroll
                        for (int i = 0; i < 4; ++i) { const float g = acc[ai][0][m][n][i] * sr, uu = acc[ai][1][m][n][i] * sr; o[n * 4 + i] = g * fast_sigmoid(g) * uu * H8S; }
                    w[h].x = pk4_fp8(o[0], o[1], o[2], o[3]); w[h].y = pk4_fp8(o[4], o[5], o[6], o[7]);
                }
                *(u32x4*)(hp + (size_t)(ai * HALF + mp * 32) * ldh) = pair16(w[0], w[1]);
            }
    }
};
struct EpiMoeDown {
    static constexpr bool PERM = true, CARRY = false;
    bf16* Y; const float* wslot;
    __device__ __forceinline__ bool keep(const Unit&) const { return false; }
    __device__ __forceinline__ void operator()(f32x4 (&acc)[2][2][4][2], const Unit& u, int wr, int wc, int fr, int fq) const {
        const int lrow0 = wr * 64 + fr, colb = u.pn * BM + wc * 32 + 8 * fq;
        float wtv[8];
#pragma unroll
        for (int k = 0; k < 8; ++k) wtv[k] = wslot[u.sub * 16384 + (u.pm - u.aux) * 256 + lrow0 + (k >> 2) * HALF + (k & 3) * 16];
        __builtin_amdgcn_sched_barrier(0);
#pragma unroll
        for (int ai = 0; ai < 2; ++ai)
#pragma unroll
            for (int m = 0; m < 4; ++m) {
                const int lrow = lrow0 + ai * HALF + m * 16; const int row = u.pm * BM + lrow;
                const float wt = wtv[ai * 4 + m] * (1.0f / (W8S * H8S));
#pragma unroll
                for (int bj = 0; bj < 2; ++bj) {
                    const f32x4 v0 = acc[ai][bj][m][0] * wt, v1 = acc[ai][bj][m][1] * wt;
                    u32x4 w; w.x = pk2(v0[0], v0[1]); w.y = pk2(v0[2], v0[3]); w.z = pk2(v1[0], v1[1]); w.w = pk2(v1[2], v1[3]);
                    *(u32x4*)(Y + (size_t)row * D + colb + bj * HALF) = w;
                }
            }
    }
};
}

#define XB_TMO      128
#define XB_XCNT(j)  (256  + 64 * (j))
#define XB_XSUB(j)  (1280 + 64 * (j))
#define XB_XGEN(j)  (2304 + 64 * (j))
#define XB_TOP      3328
#define XB_TOPGEN   3392
#define XCD_BAR_WORDS 3456
#define XB_SPIN_CAP (1u << 18)
__device__ __forceinline__ unsigned xb_ld(unsigned* p)              { return __hip_atomic_load(p, __ATOMIC_RELAXED, __HIP_MEMORY_SCOPE_AGENT); }
__device__ __forceinline__ unsigned xb_add(unsigned* p, unsigned v) { return __hip_atomic_fetch_add(p, v, __ATOMIC_RELAXED, __HIP_MEMORY_SCOPE_AGENT); }
__device__ __forceinline__ unsigned xb_xcc_id() { return (unsigned)__builtin_amdgcn_s_getreg((3 << 11) | 20) & 0xFu; }
#define XB_SPIN(cond, bar) do { unsigned _sp = 0; while (cond) { __builtin_amdgcn_s_sleep(1); \
    if ((++_sp & 255u) == 0u) { if (xb_ld(&(bar)[XB_TMO])) break; if (_sp > XB_SPIN_CAP) { atomicAdd(&(bar)[XB_TMO], 1u); break; } } } } while (0)
struct XcdBarrier { unsigned* bar; unsigned x; volatile LAS unsigned* st; };
__device__ __forceinline__ XcdBarrier xcd_barrier_post(unsigned* bar, volatile LAS unsigned* st, int wave0) {
    XcdBarrier b; b.bar = bar; b.x = xb_xcc_id(); b.st = st;
    if (wave0 == 0 && lane_id() == 0) (void)xb_add(&bar[XB_XCNT(b.x)], 1u);
    return b;
}
__device__ __forceinline__ void xcd_barrier_complete(unsigned* bar, unsigned x, unsigned& nloc, unsigned& nx) {
    const unsigned G = gridDim.x * gridDim.y * gridDim.z;
    unsigned sum, cnt, mine, sp = 0u;
    for (;;) {
        sum = 0u; cnt = 0u; mine = 0u;
#pragma unroll
        for (unsigned j = 0; j < 16; ++j) { const unsigned c = xb_ld(&bar[XB_XCNT(j)]); sum += c; cnt += (c > 0u) ? 1u : 0u; mine = (j == x) ? c : mine; }
        if (sum == G) break;
        __builtin_amdgcn_s_sleep(1);
        if ((++sp & 255u) == 0u) { if (xb_ld(&bar[XB_TMO])) break; if (sp > XB_SPIN_CAP) { atomicAdd(&bar[XB_TMO], 1u); break; } }
    }
    nloc = mine > 0u ? mine : 1u; nx = cnt > 0u ? cnt : 1u;
}
__device__ __forceinline__ void xcd_barrier(const XcdBarrier& b, int wave0) {
    asm volatile("s_waitcnt vmcnt(0)" ::: "memory");
    __syncthreads();
    if (wave0 == 0 && lane_id() == 0) {
        unsigned* bar = b.bar;
        __builtin_amdgcn_s_waitcnt(0);
        unsigned nloc = b.st[0], nx = b.st[1];
        if (nloc == 0u) { xcd_barrier_complete(bar, b.x, nloc, nx); b.st[0] = nloc; b.st[1] = nx; }
        const unsigned old = xb_add(&bar[XB_XSUB(b.x)], 1u);
        const unsigned gen = old / nloc;
        if (old + 1u == (gen + 1u) * nloc) {
            __builtin_amdgcn_fence(__ATOMIC_RELEASE, "agent");
            asm volatile("s_waitcnt vmcnt(0)" ::: "memory");
            const unsigned og = xb_add(&bar[XB_TOP], 1u);
            const unsigned tg = og / nx;
            if (og + 1u == (tg + 1u) * nx) xb_add(&bar[XB_TOPGEN], 1u);
            else XB_SPIN(xb_ld(&bar[XB_TOPGEN]) == tg, bar);
            __builtin_amdgcn_fence(__ATOMIC_ACQUIRE, "agent");
            xb_add(&bar[XB_XGEN(b.x)], 1u);
            asm volatile("s_waitcnt vmcnt(0)" ::: "memory");
        } else {
            XB_SPIN(xb_ld(&bar[XB_XGEN(b.x)]) == gen, bar);
            __builtin_amdgcn_fence(__ATOMIC_ACQUIRE, "agent");
            asm volatile("s_waitcnt vmcnt(0)" ::: "memory");
        }
    }
    __syncthreads();
}

struct Args {
    const float* x; const float* norm_mix_g; const float* w_in; const float* b_in; const float* na_rpb; const float* conv_w; const float* conv_b;
    const float* lru_wa; const float* lru_ba; const float* lru_wx; const float* lru_bx; const float* lru_lambda; const float* w_branch; const float* w_out;
    const float* norm_ffn_g; const float* ffn_w_gu; const float* ffn_w_down; const float* router_w; const float* moe_w_gu; const float* moe_w_down; const float* final_g;
    float* out; unsigned char* ws; int ph_lo, ph_hi, bar_region, pad;
};
struct Frame {
    LAS unsigned char* lds;
    int tid, lane, wave, vcu, G;
    unsigned* ctl;
    float* H;
    bf16 *HB, *VT, *BR, *TP, *MERGED, *PROJ, *HID, *YBUF; unsigned char* HB8;
    bf16 *WIN, *WBR, *WOUT, *WGU, *WDN, *MGU, *MDN, *WL; unsigned char* WIN8;
    float *NSP, *GW; f32x2* LSUM; unsigned long long* RS;
    int* LIST; float* SROW; float* WSLOT; int* TOKI;
};

template <int STEP> __device__ __forceinline__ u32x4 dft_table_entry(int idx);
struct TrDesc { const float* W; const float* ks; unsigned char* WT; int ldw, k0, n0, ldwt, drow0, dcol0, fp8; };
__device__ __forceinline__ void tr_load(const TrDesc& d, float (&tv)[32], float (&kv)[32], int lane) {
#pragma unroll
    for (int i = 0; i < 32; ++i) tv[i] = __builtin_nontemporal_load(d.W + (size_t)(d.k0 + 2 * i + (lane >> 5)) * d.ldw + d.n0 + (lane & 31));
    if (d.ks) {
#pragma unroll
        for (int i = 0; i < 32; ++i) kv[i] = d.ks[d.k0 + 2 * i + (lane >> 5)];
    } else {
#pragma unroll
        for (int i = 0; i < 32; ++i) kv[i] = 1.0f;
    }
}
__device__ __forceinline__ void tr_store(const TrDesc& d, const float (&tv)[32], const float (&kv)[32], LAS float* scr, int lane) {
    const float sc = d.fp8 ? W8S : 1.0f;
#pragma unroll
    for (int i = 0; i < 32; ++i) scr[(2 * i + (lane >> 5)) * 33 + (lane & 31)] = tv[i] * kv[i] * sc;
    LDS_WAIT(); asm volatile("" ::: "memory");
    const int c = lane & 7;
#pragma unroll
    for (int j = 0; j < 4; ++j) { const int n = (lane >> 3) + 8 * j; const LAS float* s = scr + (8 * c) * 33 + n;
        if (d.fp8) { u32x2 o; o.x = pk4_fp8(s[0 * 33], s[1 * 33], s[2 * 33], s[3 * 33]); o.y = pk4_fp8(s[4 * 33], s[5 * 33], s[6 * 33], s[7 * 33]);
            *(u32x2*)(d.WT + (size_t)(d.drow0 + n) * d.ldwt + d.dcol0 + d.k0 + 8 * c) = o; }
        else { u32x4 o; o.x = pk2(s[0 * 33], s[1 * 33]); o.y = pk2(s[2 * 33], s[3 * 33]); o.z = pk2(s[4 * 33], s[5 * 33]); o.w = pk2(s[6 * 33], s[7 * 33]);
            *(u32x4*)((bf16*)d.WT + (size_t)(d.drow0 + n) * d.ldwt + d.dcol0 + d.k0 + 8 * c) = o; } }
    LDS_WAIT(); asm volatile("" ::: "memory");
}
__device__ __forceinline__ int gu_row(int n0, int half) { const int isu = n0 >= half ? 1 : 0; const int hid = n0 - isu * half; return 256 * (hid >> 7) + 128 * isu + (hid & 127); }
template <int STEP> __device__ __forceinline__ u32x4 dft_table_entry(int idx);
__device__ __forceinline__ const Args& fresh_args() { const Args* p = (const Args*)__builtin_amdgcn_kernarg_segment_ptr(); asm volatile("" : "+s"(p)); return *p; }
constexpr int I_IN = 16 * 192, I_BR = 8 * 32, I_OUT = 16 * 32, I_GU = 16 * 192, I_DN = 48 * 32, I_MGU = 16 * 96, I_MDN = 24 * 32;
constexpr int N_IN = 4 * I_IN, N_BR = 8 * I_BR, N_OUT = 4 * I_OUT, N_GU = 2 * I_GU, N_DN = 2 * I_DN, N_MGU = 16 * I_MGU, N_MDN = 16 * I_MDN;
constexpr int NITEMS = N_IN + N_BR + N_OUT + N_GU + N_DN + N_MGU + N_MDN;
__device__ __forceinline__ TrDesc tr_decode(Frame& F, int it) {
    const Args& a = fresh_args(); TrDesc d; d.ks = nullptr; d.dcol0 = 0; d.fp8 = 0;
    int r = it;
    if (r < N_IN) { const int l = r / I_IN, q = r % I_IN, half = q / (I_IN / 2), q2 = q % (I_IN / 2), kb = q2 / 96, nb = q2 % 96;
        d.W = a.w_in + (size_t)l * D * INC; d.ldw = INC; d.k0 = 64 * kb; d.ks = a.norm_mix_g + l * D; d.ldwt = D; d.drow0 = 32 * nb;
        if (half == 0) { d.n0 = 32 * nb; d.WT = (unsigned char*)(F.WIN + (size_t)l * INC * D); } else { d.n0 = 3072 + 32 * nb; d.WT = F.WIN8 + (size_t)l * 3072 * D; d.fp8 = 1; }
        return d; } r -= N_IN;
    if (r < N_BR) { const int lk = r / I_BR, l = lk >> 1, k = (lk & 1) * 2, q = r % I_BR, kb = q / 32, nb = q % 32;
        d.W = a.w_branch + ((size_t)(l * 3 + k) * 512) * D; d.ldw = D; d.k0 = 64 * kb; d.n0 = 32 * nb; d.WT = (unsigned char*)(F.WBR + (size_t)l * D * BRP); d.ldwt = BRP; d.drow0 = 32 * nb; d.dcol0 = k == 0 ? 0 : 1536; return d; } r -= N_BR;
    if (r < N_OUT) { const int l = r / I_OUT, q = r % I_OUT, kb = q / 32, nb = q % 32;
        d.W = a.w_out + (size_t)l * D * D; d.ldw = D; d.k0 = 64 * kb; d.n0 = 32 * nb; d.WT = (unsigned char*)(F.WOUT + (size_t)l * D * D); d.ldwt = D; d.drow0 = 32 * nb; return d; } r -= N_OUT;
    if (r < N_GU) { const int j = r / I_GU, q = r % I_GU, kb = q / 192, nb = q % 192;
        d.W = a.ffn_w_gu + (size_t)j * D * 2 * DFF; d.ldw = 2 * DFF; d.k0 = 64 * kb; d.n0 = 32 * nb; d.ks = a.norm_ffn_g + (2 * j) * D; d.WT = (unsigned char*)(F.WGU + (size_t)j * 2 * DFF * D); d.ldwt = D; d.drow0 = gu_row(32 * nb, DFF); return d; } r -= N_GU;
    if (r < N_DN) { const int j = r / I_DN, q = r % I_DN, kb = q / 32, nb = q % 32;
        d.W = a.ffn_w_down + (size_t)j * DFF * D; d.ldw = D; d.k0 = 64 * kb; d.n0 = 32 * nb; d.WT = (unsigned char*)F.WDN + (size_t)j * D * DFF; d.ldwt = DFF; d.drow0 = 32 * nb; d.fp8 = 1; return d; } r -= N_DN;
    if (r < N_MGU) { const int je = r / I_MGU, j = je >> 3, q = r % I_MGU, kb = q / 96, nb = q % 96;
        d.W = a.moe_w_gu + (size_t)je * D * 2 * DFE; d.ldw = 2 * DFE; d.k0 = 64 * kb; d.n0 = 32 * nb; d.ks = a.norm_ffn_g + (2 * j + 1) * D; d.WT = (unsigned char*)(F.MGU + (size_t)je * 2 * DFE * D); d.ldwt = D; d.drow0 = gu_row(32 * nb, DFE); return d; } r -= N_MGU;
    { const int je = r / I_MDN, q = r % I_MDN, kb = q / 32, nb = q % 32;
        d.W = a.moe_w_down + (size_t)je * DFE * D; d.ldw = D; d.k0 = 64 * kb; d.n0 = 32 * nb; d.WT = (unsigned char*)F.MDN + (size_t)je * D * DFE; d.ldwt = DFE; d.drow0 = 32 * nb; d.fp8 = 1; return d; }
}
__device__ __forceinline__ void p0_prologue(Frame& F, const Args& a_unused) {
    LAS float* scr = (LAS float*)(F.lds + F.wave * 16384);
    const int gw = F.vcu * NWAVES + F.wave, NGW = F.G * NWAVES, lane = F.lane;
    if (gw < NITEMS) {
        TrDesc dc = tr_decode(F, gw); float tv[32], kv[32];
        tr_load(dc, tv, kv, lane);
        for (int it = gw;;) {
            const int itn = it + NGW; const bool has = itn < NITEMS;
            TrDesc dn = dc; float tn[32], kn[32];
            if (has) { dn = tr_decode(F, itn); tr_load(dn, tn, kn, lane); }
            tr_store(dc, tv, kv, scr, lane);
            if (!has) break;
            dc = dn; it = itn;
#pragma unroll
            for (int i = 0; i < 32; ++i) { tv[i] = tn[i]; kv[i] = kn[i]; }
        }
    }
    const Args& a = fresh_args();
    {
        float sv, cv; sincospif((float)lane * (1.0f / 32.0f), &sv, &cv); const float ctab = cv * 0.125f, stab = sv * 0.125f;
        for (int it = (gw & 3) ? 512 : (gw >> 2); it < 4 * 8 * 16; it += NGW) {
            const int l = it >> 7, g = (it >> 4) & 7, db = it & 15, d = db * 64 + lane;
            const float* wsrc = a.w_branch + ((size_t)(l * 3 + 1) * 512 + g * 64) * D + d;
            float w[64];
#pragma unroll
            for (int c = 0; c < 64; ++c) w[c] = wsrc[(size_t)c * D];
            bf16* dst = F.WBR + (size_t)l * D * BRP + (size_t)d * BRP + 512 + g * 64;
            for (int j = 0; j < 64; ++j) {
                float ac = 0.f, as = 0.f;
#pragma unroll
                for (int c = 0; c < 64; ++c) { const int mi = (j * c) & 63; ac += __uint_as_float((unsigned)__builtin_amdgcn_readlane((int)__float_as_uint(ctab), mi)) * w[c]; as += __uint_as_float((unsigned)__builtin_amdgcn_readlane((int)__float_as_uint(stab), mi)) * w[c]; }
                dst[j] = (bf16)(pk2(ac, 0.f) & 0xffffu); dst[512 + j] = (bf16)(pk2(as, 0.f) & 0xffffu);
            }
        }
    }
    const int gt = F.vcu * 512 + F.tid, NGT = F.G * 512;
    for (int o = gt; o < 4 * 8 * 4 * 4096; o += NGT) {
        const int in = o & 63, out = (o >> 6) & 63, mat = (o >> 12) & 3, n = (o >> 14) & 7, l = o >> 17, dir = mat >> 1;
        const float* src = (mat & 1) ? a.lru_wx : a.lru_wa;
        F.WL[o] = (bf16)(pk2(src[((((size_t)(l * 2 + dir) * 8 + n) * 64 + in) * 64) + out], 0.f) & 0xffffu);
    }
    for (int o = gt; o < 4096 + 2048; o += NGT) { u32x4* dst = (u32x4*)(F.GW) + 12288; if (o < 4096) dst[o] = dft_table_entry<0>(o); else dst[o] = dft_table_entry<1>(o - 4096); }
    for (int o = gt; o < 4 * 2 * 512; o += NGT) { const float lam = a.lru_lambda[o]; F.NSP[o] = -8.0f * log1pf(expf(-lam)); }
    for (int o = gt; o < 2 * 1024 * 8; o += NGT) { const int j = o >> 13, k = (o >> 3) & 1023; F.GW[o] = a.norm_ffn_g[(2 * j + 1) * D + k] * a.router_w[o]; }
    for (int m = gw; m < M; m += NGW) {
        const f32x4* xr = (const f32x4*)(a.x + (size_t)m * D) + lane; f32x4 v[4]; float s = 0.f;
#pragma unroll
        for (int j = 0; j < 4; ++j) { v[j] = xr[64 * j]; s += (v[j][0] * v[j][0] + v[j][1] * v[j][1]) + (v[j][2] * v[j][2] + v[j][3] * v[j][3]); }
        s = wave_sum(s);
        u32x2* o8 = (u32x2*)(F.HB + (size_t)m * D) + lane;
#pragma unroll
        for (int j = 0; j < 4; ++j) { u32x2 w; w.x = pk2(v[j][0], v[j][1]); w.y = pk2(v[j][2], v[j][3]); o8[64 * j] = w; }
        { unsigned* q8 = (unsigned*)(F.HB8 + (size_t)m * D) + lane;
#pragma unroll
          for (int j = 0; j < 4; ++j) q8[64 * j] = pk4_fp8(v[j][0], v[j][1], v[j][2], v[j][3]); }
        if (lane == 0) F.RS[m] = (unsigned long long)(s * RS_SCALE);
    }
}

__device__ __forceinline__ f32x4 mfma16(bf16x8 a, bf16x8 b, f32x4 c) { return __builtin_amdgcn_mfma_f32_16x16x32_bf16(a, b, c, 0, 0, 0); }
__device__ __forceinline__ bf16x8 tr_frag(const LAS unsigned char* p0, const LAS unsigned char* p1) {
    const s16x4 lo = __builtin_bit_cast(s16x4, __builtin_amdgcn_ds_read_tr16_b64_v4i16((LAS s16x4*)p0));
    const s16x4 hi = __builtin_bit_cast(s16x4, __builtin_amdgcn_ds_read_tr16_b64_v4i16((LAS s16x4*)p1));
    bf16x8 r; r[0] = lo[0]; r[1] = lo[1]; r[2] = lo[2]; r[3] = lo[3]; r[4] = hi[0]; r[5] = hi[1]; r[6] = hi[2]; r[7] = hi[3]; return r;
}
constexpr int AT_V1 = 65536, AT_RPB = 131072;
struct AttnK { bf16x8 q0, q1; bf16x8 kf[8][2][2]; };
__device__ __forceinline__ void attn_load_k(AttnK& K, const bf16* __restrict__ PROJ, int b, int r, int h, int j, int lane) {
    const int fr = lane & 15, rq = lane >> 4;
    const int rs = min(max(r - 4, 0), 120);
    const int cb = (j == 0) ? 0 : (j == 1) ? 8 : (j == 2) ? 24 : 32;
    const size_t tq = (size_t)b * SEQ + 64 * r + 16 * j + fr;
    const bf16* qp = PROJ + tq * PPITCH + C_Q + h * 64 + 16 * rq;
    K.q0 = *(const bf16x8*)qp; K.q1 = *(const bf16x8*)(qp + 8);
    const bf16* kbase = PROJ + ((size_t)b * SEQ + 64 * rs + cb + fr) * PPITCH + C_K + h * 64 + 16 * rq;
#pragma unroll
    for (int ir = 0; ir < 8; ++ir)
#pragma unroll
        for (int hf = 0; hf < 2; ++hf) {
            const bf16* kp = kbase + (size_t)(64 * ir + 16 * hf) * PPITCH;
            K.kf[ir][hf][0] = *(const bf16x8*)kp; K.kf[ir][hf][1] = *(const bf16x8*)(kp + 8);
        }
}
__device__ __forceinline__ void attn_compute(const AttnK& K, const LAS unsigned char* vt, const LAS float* rpb, bf16* __restrict__ BR, int b, int r, int h, int j, int lane) {
    const int fr = lane & 15, rq = lane >> 4;
    const int rs = min(max(r - 4, 0), 120);
    const int cb = (j == 0) ? 0 : (j == 1) ? 8 : (j == 2) ? 24 : 32;
    const size_t tq = (size_t)b * SEQ + 64 * r + 16 * j + fr;
    f32x4 S[8][2];
#pragma unroll
    for (int ir = 0; ir < 8; ++ir)
#pragma unroll
        for (int hf = 0; hf < 2; ++hf) {
            f32x4 s = {0.f, 0.f, 0.f, 0.f};
            s = mfma16(K.kf[ir][hf][0], K.q0, s); s = mfma16(K.kf[ir][hf][1], K.q1, s);
            S[ir][hf] = s;
        }
    const int c = 16 * j + fr, cs = min(max(c - 8, 0), 48);
    float mx = -1e30f;
#pragma unroll
    for (int ir = 0; ir < 8; ++ir) {
        const LAS float* brow = rpb + (rs + ir - r + 7) * 31;
#pragma unroll
        for (int hf = 0; hf < 2; ++hf)
#pragma unroll
            for (int i = 0; i < 4; ++i) {
                const int kc = cb + 16 * hf + 4 * rq + i; const bool valid = (kc >= cs) && (kc < cs + 16);
                const int bi = min(max(kc - c + 15, 0), 30);
                const float sv = valid ? S[ir][hf][i] + brow[bi] : -1e30f;
                S[ir][hf][i] = sv; mx = fmaxf(mx, sv);
            }
    }
    mx = fmaxf(mx, __shfl_xor(mx, 16)); mx = fmaxf(mx, __shfl_xor(mx, 32));
    float sum = 0.f;
#pragma unroll
    for (int ir = 0; ir < 8; ++ir)
#pragma unroll
        for (int hf = 0; hf < 2; ++hf)
#pragma unroll
            for (int i = 0; i < 4; ++i) { const float p = __builtin_amdgcn_exp2f((S[ir][hf][i] - mx) * 1.44269504f); S[ir][hf][i] = p; sum += p; }
    sum += __shfl_xor(sum, 16); sum += __shfl_xor(sum, 32);
    f32x4 O[4];
#pragma unroll
    for (int d = 0; d < 4; ++d) O[d] = (f32x4){0.f, 0.f, 0.f, 0.f};
    const int q4 = (lane & 15) >> 2, p4 = lane & 3;
    const LAS unsigned char* vb = vt + (cb + 4 * rq + q4) * 128 + 8 * p4;
#pragma unroll
    for (int ir = 0; ir < 8; ++ir) {
        u32x4 pw; pw.x = pk2(S[ir][0][0], S[ir][0][1]); pw.y = pk2(S[ir][0][2], S[ir][0][3]); pw.z = pk2(S[ir][1][0], S[ir][1][1]); pw.w = pk2(S[ir][1][2], S[ir][1][3]);
        const bf16x8 Bp = __builtin_bit_cast(bf16x8, pw);
#pragma unroll
        for (int d = 0; d < 4; ++d) {
            const LAS unsigned char* p0 = vb + (64 * ir) * 128 + 32 * d;
            O[d] = mfma16(tr_frag(p0, p0 + 16 * 128), Bp, O[d]);
        }
    }
    const float inv = 1.0f / sum;
#pragma unroll
    for (int d = 0; d < 4; ++d) { u32x2 w; w.x = pk2(O[d][0] * inv, O[d][1] * inv); w.y = pk2(O[d][2] * inv, O[d][3] * inv);
        *(u32x2*)(BR + tq * BRP + h * 64 + 16 * d + 4 * rq) = w; }
}
constexpr int XP = 544;
constexpr int FX_OFF = 0, FT_OFF = 128 * XP;
template <int NMT, int NNT>
__device__ __forceinline__ void dft_core(const LAS unsigned char* xl, const LAS unsigned char* tl, int wm, int cbase, int lane, f32x4 (&acc)[2][NMT][NNT]) {
#pragma unroll
    for (int p = 0; p < 2; ++p)
#pragma unroll
        for (int m = 0; m < NMT; ++m)
#pragma unroll
            for (int n = 0; n < NNT; ++n) acc[p][m][n] = (f32x4){0.f, 0.f, 0.f, 0.f};
    const int g = lane >> 4, q = (lane & 15) >> 2, p4 = lane & 3;
#pragma unroll 1
    for (int ks = 0; ks < 4; ++ks) {
        bf16x8 Bf[NNT];
#pragma unroll
        for (int n = 0; n < NNT; ++n) {
            const LAS unsigned char* p0 = xl + (32 * ks + 8 * g + q) * XP + (cbase + 16 * n + 4 * p4) * 2;
            Bf[n] = tr_frag(p0, p0 + 4 * XP);
        }
#pragma unroll
        for (int p = 0; p < 2; ++p)
#pragma unroll
            for (int m = 0; m < NMT; ++m) {
                const int tile = p * (2 * NMT) + wm * NMT + m;
                const bf16x8 Af = *(const LAS bf16x8*)(tl + ((tile * 4 + ks) * 64 + lane) * 16);
#pragma unroll
                for (int n = 0; n < NNT; ++n) acc[p][m][n] = mfma16(Af, Bf[n], acc[p][m][n]);
            }
    }
}
__device__ __forceinline__ void dft_load_x(Frame& F, const bf16* src, size_t rstride) {
    const int chunk = F.tid & 31, row0 = F.tid >> 5;
    u32x4 v[8];
#pragma unroll
    for (int it = 0; it < 8; ++it) v[it] = *(const u32x4*)(src + (size_t)(row0 + 16 * it) * rstride + chunk * 8);
#pragma unroll
    for (int it = 0; it < 8; ++it) *(LAS u32x4*)(F.lds + FX_OFF + (row0 + 16 * it) * XP + chunk * 16) = v[it];
}
template <int STEP>
__device__ __forceinline__ u32x4 dft_table_entry(int idx) {
    const int tile = idx >> 8, ks = (idx >> 6) & 3, ln = idx & 63;
    float v[8];
#pragma unroll
    for (int j = 0; j < 8; ++j) {
        const int k = 32 * ks + 8 * (ln >> 4) + j; float sv, cv;
        if (STEP == 0) { const int part = tile >> 3, prow = (tile & 7) * 16 + (ln & 15); const int mi = (prow * k) & 127; sincospif((float)mi * (1.0f / 64.0f), &sv, &cv);
            v[j] = (part == 0 ? cv : -sv) * 0.08838834764831845f; }
        else { const int part = tile >> 2, prow = (tile & 3) * 16 + (ln & 15), pin = k >> 6, n2 = k & 63; const int mi = (prow * n2) & 63; sincospif((float)mi * (1.0f / 32.0f), &sv, &cv);
            v[j] = (part == 0 ? (pin == 0 ? cv : sv) : (pin == 0 ? -sv : cv)) * 0.125f; }
    }
    u32x4 w; w.x = pk2(v[0], v[1]); w.y = pk2(v[2], v[3]); w.z = pk2(v[4], v[5]); w.w = pk2(v[6], v[7]);
    return w;
}
template <int STEP>
__device__ __forceinline__ void dft_fill_table(Frame& F) {
    constexpr int NE = (STEP == 0 ? 16 : 8) * 256;
    const u32x4* src = (const u32x4*)(F.GW) + (STEP == 0 ? 12288 : 16384);
#pragma unroll
    for (int it = 0; it < NE / 512; ++it) { const int idx = F.tid + 512 * it; *(LAS u32x4*)(F.lds + FT_OFF + idx * 16) = src[idx]; }
}
__device__ __forceinline__ void fft_a_unit(Frame& F, int unit) {
    const int b = unit >> 7, n2 = (unit >> 1) & 63, chh = unit & 1, lane = F.lane, wm = F.wave >> 2, wn = F.wave & 3, rq = lane >> 4;
    dft_load_x(F, F.PROJ + ((size_t)b * SEQ + n2) * PPITCH + C_UF + 256 * chh, (size_t)64 * PPITCH);
    LDS_WAIT(); __syncthreads();
#pragma unroll 1
    for (int cp = 0; cp < 2; ++cp) {
    f32x4 acc[2][4][2];
    dft_core<4, 2>(F.lds + FX_OFF, F.lds + FT_OFF, wm, 64 * wn + 32 * cp, lane, acc);
#pragma unroll
    for (int m = 0; m < 4; ++m)
#pragma unroll
        for (int i = 0; i < 4; ++i) {
            const int k1 = 64 * wm + 16 * m + 4 * rq + i; float sv, cv; sincospif((float)(n2 * k1) * (1.0f / 4096.0f), &sv, &cv);
            bf16* o0 = F.TP + ((((size_t)(b * 128 + k1) * 2 + 0) * 64 + n2) * 512) + 256 * chh + 64 * wn + 32 * cp + (lane & 15);
#pragma unroll
            for (int n = 0; n < 2; ++n) {
                const float tr = acc[0][m][n][i], ti = acc[1][m][n][i];
                o0[16 * n] = (bf16)(pk2(tr * cv + ti * sv, 0.f) & 0xffffu);
                o0[16 * n + 64 * 512] = (bf16)(pk2(ti * cv - tr * sv, 0.f) & 0xffffu);
            }
        }
    }
    __syncthreads();
}
__device__ __forceinline__ void fft_c_unit(Frame& F, int unit) {
    const int b = unit >> 8, k1 = (unit >> 1) & 127, chh = unit & 1, lane = F.lane, wm = F.wave >> 2, wn = F.wave & 3, rq = lane >> 4;
    dft_load_x(F, F.TP + ((size_t)(b * 128 + k1) * 128) * 512 + 256 * chh, (size_t)512);
    LDS_WAIT(); __syncthreads();
    f32x4 acc[2][2][4];
    dft_core<2, 4>(F.lds + FX_OFF, F.lds + FT_OFF, wm, 64 * wn, lane, acc);
#pragma unroll
    for (int p = 0; p < 2; ++p)
#pragma unroll
        for (int m = 0; m < 2; ++m)
#pragma unroll
            for (int i = 0; i < 4; ++i) {
                const int k2 = 32 * wm + 16 * m + 4 * rq + i;
                bf16* o0 = F.BR + ((size_t)b * SEQ + k1 + 128 * k2) * BRP + 512 + p * 512 + 256 * chh + 64 * wn + (lane & 15);
#pragma unroll
                for (int n = 0; n < 4; ++n) o0[16 * n] = (ABL & 2) ? (bf16)0 : (bf16)(pk2(acc[p][m][n][i], 0.f) & 0xffffu);
            }
    __syncthreads();
}

template <bool REV, bool FULL>
__device__ __forceinline__ void lru_scan(const f32x4 (&a)[4], const f32x4 (&bt)[4], float carry_in, f32x4 (&h)[4], float& Atot, float& Btot, int lane) {
    const int rq = lane >> 4, fr = lane & 15;
    float carry = carry_in, At = 1.f;
#pragma unroll
    for (int mm = 0; mm < 4; ++mm) {
        const int mt = REV ? 3 - mm : mm;
        float hl[4], cA[4];
        if (!REV) { hl[0] = bt[mt][0]; cA[0] = a[mt][0];
#pragma unroll
            for (int i = 1; i < 4; ++i) { hl[i] = a[mt][i] * hl[i - 1] + bt[mt][i]; cA[i] = a[mt][i] * cA[i - 1]; } }
        else { hl[3] = bt[mt][3]; cA[3] = a[mt][3];
#pragma unroll
            for (int i = 2; i >= 0; --i) { hl[i] = a[mt][i] * hl[i + 1] + bt[mt][i]; cA[i] = a[mt][i] * cA[i + 1]; } }
        float SA = REV ? cA[0] : cA[3], SB = REV ? hl[0] : hl[3];
        float pA, pB;
        if (!REV) {
            pA = __shfl_up(SA, 16); pB = __shfl_up(SB, 16); if (rq >= 1) { SB = SA * pB + SB; SA = SA * pA; }
            pA = __shfl_up(SA, 32); pB = __shfl_up(SB, 32); if (rq >= 2) { SB = SA * pB + SB; SA = SA * pA; }
        } else {
            pA = __shfl_down(SA, 16); pB = __shfl_down(SB, 16); if (rq <= 2) { SB = SA * pB + SB; SA = SA * pA; }
            pA = __shfl_down(SA, 32); pB = __shfl_down(SB, 32); if (rq <= 1) { SB = SA * pB + SB; SA = SA * pA; }
        }
        float eA, eB;
        if (!REV) { eA = __shfl_up(SA, 16); eB = __shfl_up(SB, 16); if (rq == 0) { eA = 1.f; eB = 0.f; } }
        else { eA = __shfl_down(SA, 16); eB = __shfl_down(SB, 16); if (rq == 3) { eA = 1.f; eB = 0.f; } }
        const float tA = __shfl(SA, REV ? fr : 48 + fr), tB = __shfl(SB, REV ? fr : 48 + fr);
        if (FULL) { const float hs = eA * carry + eB;
#pragma unroll
            for (int i = 0; i < 4; ++i) h[mt][i] += hl[i] + cA[i] * hs; }
        carry = tA * carry + tB; At *= tA;
        __builtin_amdgcn_sched_barrier(0);
    }
    Atot = At; Btot = carry;
}
template <int PASS>
__device__ __forceinline__ void lru_unit(Frame& F, const Args& a, int l, int b, int r) {
    const int w = F.wave, ch0 = 64 * w;
    LAS float* carry_lds = (LAS float*)(F.lds);
    if (PASS == 2) {
        const int ch = F.wave * 64 + lane_id(); float hf = 0.f, hb = 0.f;
        const f32x2* sf = F.LSUM + ((size_t)(0 * 2 + b) * 128) * 512 + ch; const f32x2* sb = F.LSUM + ((size_t)(1 * 2 + b) * 128) * 512 + ch;
        for (int r0 = 0; r0 < r; r0 += 32) {
            f32x2 sv[32];
#pragma unroll
            for (int k = 0; k < 32; ++k) sv[k] = sf[(size_t)min(r0 + k, 127) * 512];
#pragma unroll
            for (int k = 0; k < 32; ++k) if (r0 + k < r) hf = sv[k].x * hf + sv[k].y;
        }
        for (int r0 = 127; r0 > r; r0 -= 32) {
            f32x2 sv[32];
#pragma unroll
            for (int k = 0; k < 32; ++k) sv[k] = sb[(size_t)max(r0 - k, 0) * 512];
#pragma unroll
            for (int k = 0; k < 32; ++k) if (r0 - k > r) hb = sv[k].x * hb + sv[k].y;
        }
        carry_lds[ch] = hf; carry_lds[512 + ch] = hb;
        LDS_WAIT(); __syncthreads();
    }
    const int lane = lane_id(), fr = lane & 15, rq = lane >> 4;
    bf16x8 Af[4][2];
#pragma unroll
    for (int ks = 0; ks < 2; ++ks) {
        const int chA = ch0 + 32 * ks + 8 * rq;
        float cw[4][8], cbv[8];
#pragma unroll
        for (int t = 0; t < 4; ++t) { const f32x4 w0 = *(const f32x4*)(a.conv_w + ((size_t)l * 4 + t) * 512 + chA), w1 = *(const f32x4*)(a.conv_w + ((size_t)l * 4 + t) * 512 + chA + 4);
            cw[t][0] = w0[0]; cw[t][1] = w0[1]; cw[t][2] = w0[2]; cw[t][3] = w0[3]; cw[t][4] = w1[0]; cw[t][5] = w1[1]; cw[t][6] = w1[2]; cw[t][7] = w1[3]; }
        { const f32x4 b0 = *(const f32x4*)(a.conv_b + (size_t)l * 512 + chA), b1 = *(const f32x4*)(a.conv_b + (size_t)l * 512 + chA + 4);
            cbv[0] = b0[0]; cbv[1] = b0[1]; cbv[2] = b0[2]; cbv[3] = b0[3]; cbv[4] = b1[0]; cbv[5] = b1[1]; cbv[6] = b1[2]; cbv[7] = b1[3]; }
#pragma unroll
        for (int mt = 0; mt < 4; ++mt) {
            const int s = 64 * r + 16 * mt + fr;
            float c8[8];
#pragma unroll
            for (int e = 0; e < 8; ++e) c8[e] = cbv[e];
#pragma unroll
            for (int t = 0; t < 4; ++t) {
                const int sp = s + t - 2;
                if (sp >= 0 && sp < SEQ) {
                    const u32x4 uv = *(const u32x4*)(F.PROJ + ((size_t)b * SEQ + sp) * PPITCH + C_UX + chA);
                    c8[0] += cw[t][0] * bflo(uv.x); c8[1] += cw[t][1] * bfhi(uv.x); c8[2] += cw[t][2] * bflo(uv.y); c8[3] += cw[t][3] * bfhi(uv.y);
                    c8[4] += cw[t][4] * bflo(uv.z); c8[5] += cw[t][5] * bfhi(uv.z); c8[6] += cw[t][6] * bflo(uv.w); c8[7] += cw[t][7] * bfhi(uv.w);
                }
            }
            u32x4 pw; pw.x = pk2(c8[0], c8[1]); pw.y = pk2(c8[2], c8[3]); pw.z = pk2(c8[4], c8[5]); pw.w = pk2(c8[6], c8[7]);
            Af[mt][ks] = __builtin_bit_cast(bf16x8, pw);
            __builtin_amdgcn_sched_barrier(0);
        }
    }
    const bf16* WLb = F.WL + ((size_t)(l * 8 + w) * 4) * 4096;
#pragma unroll 1
    for (int nt = 0; nt < 4; ++nt) {
        const int ch = ch0 + 16 * nt + fr;
        f32x4 cD[4];
#pragma unroll
        for (int mt = 0; mt < 4; ++mt) cD[mt] = (f32x4){0.f, 0.f, 0.f, 0.f};
#pragma unroll
        for (int ks = 0; ks < 2; ++ks) {
            bf16x8 I8;
#pragma unroll
            for (int j = 0; j < 8; ++j) I8[j] = (32 * ks + 8 * rq + j == 16 * nt + fr) ? (short)0x3F80 : (short)0;
#pragma unroll
            for (int mt = 0; mt < 4; ++mt) cD[mt] = mfma16(Af[mt][ks], I8, cD[mt]);
        }
        f32x4 hsum[4];
#pragma unroll
        for (int mt = 0; mt < 4; ++mt) hsum[mt] = (f32x4){0.f, 0.f, 0.f, 0.f};
        bf16x8 Bw[2][2][2];
#pragma unroll
        for (int dir = 0; dir < 2; ++dir)
#pragma unroll
            for (int mat = 0; mat < 2; ++mat)
#pragma unroll
                for (int ks = 0; ks < 2; ++ks) Bw[dir][mat][ks] = *(const bf16x8*)(WLb + (size_t)(2 * dir + mat) * 4096 + (16 * nt + fr) * 64 + 32 * ks + 8 * rq);
        float pba[2], pbx[2], pns[2];
#pragma unroll
        for (int dir = 0; dir < 2; ++dir) { pba[dir] = -1.44269504f * a.lru_ba[(size_t)(l * 2 + dir) * 512 + ch]; pbx[dir] = -1.44269504f * a.lru_bx[(size_t)(l * 2 + dir) * 512 + ch]; pns[dir] = 1.44269504f * F.NSP[(l * 2 + dir) * 512 + ch]; }
        unsigned short ggv[4][4];
        if (PASS == 2) {
#pragma unroll
            for (int mt = 0; mt < 4; ++mt)
#pragma unroll
                for (int i = 0; i < 4; ++i) ggv[mt][i] = F.PROJ[((size_t)b * SEQ + 64 * r + 16 * mt + 4 * rq + i) * PPITCH + C_UG + ch];
        }
#pragma unroll
        for (int dir = 0; dir < 2; ++dir) {
            __builtin_amdgcn_sched_barrier(0);
            f32x4 xa[4], xx[4];
#pragma unroll
            for (int mt = 0; mt < 4; ++mt) { xa[mt] = (f32x4){0.f, 0.f, 0.f, 0.f}; xx[mt] = (f32x4){0.f, 0.f, 0.f, 0.f}; }
#pragma unroll
            for (int ks = 0; ks < 2; ++ks) {
#pragma unroll
                for (int mt = 0; mt < 4; ++mt) { xa[mt] = mfma16(Af[mt][ks], Bw[dir][0][ks], xa[mt]); xx[mt] = mfma16(Af[mt][ks], Bw[dir][1][ks], xx[mt]); }
            }
            const float ba = pba[dir], bx = pbx[dir], ns = pns[dir];
            f32x4 av[4], bt[4]; float igc_first = 0.f, igc_last = 0.f;
#pragma unroll
            for (int mt = 0; mt < 4; ++mt)
#pragma unroll
                for (int i = 0; i < 4; ++i) {
                    const float rg = __builtin_amdgcn_rcpf(1.0f + __builtin_amdgcn_exp2f(__builtin_fmaf(xa[mt][i], -1.44269504f, ba)));
                    const float ig = __builtin_amdgcn_rcpf(1.0f + __builtin_amdgcn_exp2f(__builtin_fmaf(xx[mt][i], -1.44269504f, bx)));
                    const float aa = __builtin_amdgcn_exp2f(ns * rg);
                    const float mult = __builtin_amdgcn_sqrtf(fmaxf(__builtin_fmaf(-aa, aa, 1.0f), 0.f));
                    const float igc = ig * cD[mt][i];
                    if (mt == 0 && i == 0) igc_first = igc;
                    if (mt == 3 && i == 3) igc_last = igc;
                    av[mt][i] = aa; bt[mt][i] = mult * igc;
                    if (i == 3) __builtin_amdgcn_sched_barrier(0);
                }
            if (dir == 0) { if (r == 0 && rq == 0) bt[0][0] = igc_first; }
            else { if (r == 127 && rq == 3) bt[3][3] = igc_last; }
            float At, Bt;
            const float cin = (PASS == 2) ? carry_lds[dir * 512 + ch] : 0.f;
            if (dir == 0) lru_scan<false, PASS == 2>(av, bt, cin, hsum, At, Bt, lane); else lru_scan<true, PASS == 2>(av, bt, cin, hsum, At, Bt, lane);
            if (PASS == 1) { if (rq == 0) { f32x2 sm; sm.x = At; sm.y = Bt; F.LSUM[((size_t)(dir * 2 + b) * 128 + r) * 512 + ch] = sm; } }

        }
        if (PASS == 2) {
#pragma unroll
            for (int mt = 0; mt < 4; ++mt)
#pragma unroll
                for (int i = 0; i < 4; ++i) {
                    const size_t tok = (size_t)b * SEQ + 64 * r + 16 * mt + 4 * rq + i;
                    const float gg = bf2f(ggv[mt][i]);
                    F.BR[tok * BRP + 1536 + ch] = (ABL & 4) ? (bf16)0 : (bf16)(pk2(hsum[mt][i] * gg, 0.f) & 0xffffu);
                }
        }
    }
    if (PASS == 2) __syncthreads();
}

__device__ __forceinline__ void moe_router(Frame& F, int jm, const unsigned long long* rs) {
    const int gw = F.vcu * NWAVES + F.wave, NGW = F.G * NWAVES, lane = F.lane;
    const float* GWj = F.GW + (size_t)jm * 1024 * 8;
    unsigned* cnt = F.ctl + CW_MOE + jm * 8 * 64;
    LAS float* gwt = (LAS float*)F.lds;
    for (int i = F.tid; i < 1024 * 8; i += 512) gwt[(i & 7) * 1024 + (i >> 3)] = GWj[i];
    LDS_WAIT(); __syncthreads();
    for (int t = gw; t < M; t += NGW) {
        const u32x2* hr = (const u32x2*)(F.HB + (size_t)t * D) + lane;
        float lg[8];
#pragma unroll
        for (int e = 0; e < 8; ++e) lg[e] = 0.f;
#pragma unroll
        for (int j = 0; j < 4; ++j) {
            const u32x2 hw = hr[64 * j]; const float hv[4] = {bflo(hw.x), bfhi(hw.x), bflo(hw.y), bfhi(hw.y)}; const int k0 = 4 * lane + 256 * j;
#pragma unroll
            for (int e = 0; e < 8; ++e) { const f32x4 g = *(const LAS f32x4*)(gwt + e * 1024 + k0); lg[e] += (hv[0] * g[0] + hv[1] * g[1]) + (hv[2] * g[2] + hv[3] * g[3]); }
        }
#pragma unroll
        for (int e = 0; e < 8; ++e) lg[e] = wave_sum(lg[e]);
        const float sr = 1.0f / sqrtf((float)rs[t] * (1.0f / (RS_SCALE * D)) + RMS_EPS);
        int e0 = 0; float v0 = lg[0];
#pragma unroll
        for (int e = 1; e < 8; ++e) if (lg[e] > v0) { v0 = lg[e]; e0 = e; }
        int e1 = -1; float v1 = -3.0e38f;
#pragma unroll
        for (int e = 0; e < 8; ++e) if (e != e0 && lg[e] > v1) { v1 = lg[e]; e1 = e; }
        const float w0 = 1.0f / (1.0f + expf((v1 - v0) * sr)), w1 = 1.0f - w0;
        if (lane == 0) {
            const int p0 = (int)atomicAdd(cnt + e0 * 64, 1u), p1 = (int)atomicAdd(cnt + e1 * 64, 1u);
            F.LIST[e0 * 16384 + p0] = t; F.LIST[e1 * 16384 + p1] = t;
            F.SROW[e0 * 16384 + p0] = sr; F.SROW[e1 * 16384 + p1] = sr;
            F.WSLOT[e0 * 16384 + p0] = w0; F.WSLOT[e1 * 16384 + p1] = w1;
            int4 ti; ti.x = e0; ti.y = p0; ti.z = e1; ti.w = p1; ((int4*)F.TOKI)[t] = ti;
        }
    }
    __syncthreads();
}
__device__ __forceinline__ void moe_sched_init(Frame& F, int jm, pg8::SchedMoe& S) {
    const unsigned* cnt = F.ctl + CW_MOE + jm * 8 * 64;
#define RFL(x) __builtin_amdgcn_readfirstlane((int)(x))
    S.cntp = cnt;
    const int c0 = RFL(cnt[0]), c1 = RFL(cnt[64]), c2 = RFL(cnt[128]), c3 = RFL(cnt[192]), c4 = RFL(cnt[256]), c5 = RFL(cnt[320]), c6 = RFL(cnt[384]), c7 = RFL(cnt[448]);
#undef RFL
    S.t1 = (c0 + 255) >> 8; S.t2 = S.t1 + ((c1 + 255) >> 8); S.t3 = S.t2 + ((c2 + 255) >> 8); S.t4 = S.t3 + ((c3 + 255) >> 8);
    S.t5 = S.t4 + ((c4 + 255) >> 8); S.t6 = S.t5 + ((c5 + 255) >> 8); S.t7 = S.t6 + ((c6 + 255) >> 8); S.t8 = S.t7 + ((c7 + 255) >> 8);
}
__device__ __forceinline__ void moe_combine(Frame& F, const Args& a, int jm, unsigned long long* rs_next, bool final_layer) {
    const int gw = F.vcu * NWAVES + F.wave, NGW = F.G * NWAVES, lane = F.lane;
    pg8::SchedMoe S; moe_sched_init(F, jm, S);
    for (int t = gw; t < M; t += NGW) {
        const int4 ti = ((const int4*)F.TOKI)[t];
        const int ta = ti.x == 0 ? 0 : ti.x == 1 ? S.t1 : ti.x == 2 ? S.t2 : ti.x == 3 ? S.t3 : ti.x == 4 ? S.t4 : ti.x == 5 ? S.t5 : ti.x == 6 ? S.t6 : S.t7;
        const int tb = ti.z == 0 ? 0 : ti.z == 1 ? S.t1 : ti.z == 2 ? S.t2 : ti.z == 3 ? S.t3 : ti.z == 4 ? S.t4 : ti.z == 5 ? S.t5 : ti.z == 6 ? S.t6 : S.t7;
        const size_t s0 = (size_t)ta * 256 + ti.y, s1 = (size_t)tb * 256 + ti.w;
        u32x2* hr = (u32x2*)(F.HB + (size_t)t * D) + lane;
        const u32x2* y0 = (const u32x2*)(F.YBUF + s0 * D) + lane; const u32x2* y1 = (const u32x2*)(F.YBUF + s1 * D) + lane;
        f32x4 v[4]; float ss = 0.f;
#pragma unroll
        for (int j = 0; j < 4; ++j) { const u32x2 a0 = y0[64 * j], a1 = y1[64 * j], hw = hr[64 * j]; f32x4 hv;
            hv[0] = bflo(hw.x) + bflo(a0.x) + bflo(a1.x); hv[1] = bfhi(hw.x) + bfhi(a0.x) + bfhi(a1.x); hv[2] = bflo(hw.y) + bflo(a0.y) + bflo(a1.y); hv[3] = bfhi(hw.y) + bfhi(a0.y) + bfhi(a1.y);
            v[j] = hv; ss += (hv[0] * hv[0] + hv[1] * hv[1]) + (hv[2] * hv[2] + hv[3] * hv[3]); }
        ss = wave_sum(ss);
        if (final_layer) {
            const float sr = 1.0f / sqrtf(ss * (1.0f / D) + RMS_EPS);
            f32x4* orow = (f32x4*)(F.H + (size_t)t * D) + lane;
#pragma unroll
            for (int j = 0; j < 4; ++j) { const f32x4 g = *((const f32x4*)a.final_g + lane + 64 * j); orow[64 * j] = v[j] * sr * g; }
        } else {
#pragma unroll
            for (int j = 0; j < 4; ++j) { u32x2 w; w.x = pk2(v[j][0], v[j][1]); w.y = pk2(v[j][2], v[j][3]); hr[64 * j] = w; }
            { unsigned* q8 = (unsigned*)(F.HB8 + (size_t)t * D) + lane;
#pragma unroll
              for (int j = 0; j < 4; ++j) q8[64 * j] = pk4_fp8(v[j][0], v[j][1], v[j][2], v[j][3]); }
            if (lane == 0) rs_next[t] = (unsigned long long)(ss * RS_SCALE);
        }
    }
}

__device__ __forceinline__ Frame mk_frame(const Args& args, LAS unsigned char* ldsp, int wave0) {
    Frame F;
    F.lds = ldsp;
    F.tid = tid_of(wave0); F.lane = F.tid & 63; F.wave = __builtin_amdgcn_readfirstlane(F.tid >> 6);
    F.G = gridDim.x; { const int bx = blockIdx.x; F.vcu = (F.G % 8 == 0) ? (bx % 8) * (F.G / 8) + bx / 8 : bx; }
    size_t zoff = 0; asm volatile("" : "+s"(zoff)); unsigned char* ws = args.ws + zoff; float* outp = args.out + zoff;
    F.ctl = (unsigned*)(ws + WS_CTL); F.H = outp;
    F.HB8 = ws + WS_HB8; F.HB = (bf16*)(ws + WS_HB); F.VT = nullptr; F.WIN8 = ws + WS_WIN8; F.BR = (bf16*)(ws + WS_BR); F.TP = (bf16*)(ws + WS_TP); F.MERGED = (bf16*)(ws + WS_MERGED);
    F.PROJ = (bf16*)(ws + WS_PROJ); F.HID = (bf16*)(ws + WS_HID); F.YBUF = (bf16*)(ws + WS_YBUF);
    F.WIN = (bf16*)(ws + WS_WIN); F.WBR = (bf16*)(ws + WS_WBR); F.WOUT = (bf16*)(ws + WS_WOUT); F.WGU = (bf16*)(ws + WS_WGU); F.WDN = (bf16*)(ws + WS_WDN);
    F.MGU = (bf16*)(ws + WS_MGU); F.MDN = (bf16*)(ws + WS_MDN); F.WL = (bf16*)(ws + WS_WL);
    F.NSP = (float*)(ws + WS_MISC); F.GW = (float*)(ws + WS_MISC + 65536); F.LSUM = (f32x2*)(ws + WS_LSUM); F.RS = (unsigned long long*)(ws + WS_RS);
    F.LIST = (int*)(ws + WS_MOEI); F.SROW = (float*)(ws + WS_MOEI + 524288); F.WSLOT = (float*)(ws + WS_MOEI + 2 * 524288); F.TOKI = (int*)(ws + WS_MOEI + 3 * 524288);
    return F;
}
__global__ void __launch_bounds__(NWAVES * 64, 2) enc_fwd(Args args) {
    extern __shared__ __attribute__((aligned(16))) unsigned char lds[];
    LAS unsigned char* const ldsp = (LAS unsigned char*)lds;
    volatile LAS unsigned* MISC = (volatile LAS unsigned*)(ldsp + MISC_OFF);
    const int wave0 = __builtin_amdgcn_readfirstlane((int)threadIdx.x >> 6);
    for (int u = wave0 * 64 + lane_id(); u < (LDS_BYTES - MISC_OFF) / 4; u += NWAVES * 64) ((LAS unsigned*)(ldsp + MISC_OFF))[u] = 0u;
    __syncthreads();
    XcdBarrier bar = xcd_barrier_post((unsigned*)(args.ws + WS_CTL) + CW_BAR + args.bar_region * XCD_BAR_WORDS, MISC + 8, wave0);
    const int lo = args.ph_lo, hi = args.ph_hi;
#ifndef PHASE_MASK
#define PHASE_MASK 0xFFFF
#endif
#define PM(k) (((PHASE_MASK) >> (k)) & 1)
#define IN(k) (lo <= (k) && (k) < hi)
#define SEAM(k) do { if (IN(k) && IN((k) + 1)) xcd_barrier(bar, wave0); } while (0)
#define RETID() Frame F = mk_frame(args, ldsp, wave0)

    if (PM(0) && IN(0)) { RETID(); p0_prologue(F, args); }
    SEAM(0);
#pragma unroll 1
    for (int l = 0; l < DEPTH; ++l) {
        const int pb = 1 + 9 * l;
        if (PM(1) && IN(pb + 0)) {
            RETID();
            { pg8::SchedPlain S; S.A = (const char*)F.HB; S.B = (const char*)(F.WIN + (size_t)l * INC * D); S.lda2 = D * 2; S.ldb2 = D * 2; S.nt = D / 64; S.nM = M / 256; S.nN = 12; S.G = F.G; S.c = (int)blockIdx.x;
              pg8::EpiProj<false> E; E.P = F.PROJ; E.VT = F.VT; E.bias = args.b_in + (size_t)l * INC; E.rs = F.RS + (size_t)(2 * l) * M; E.pn_off = 0; E.cs = 1.0f;
              pg8::gemm_phase<pg8::EpiProj<false>, pg8::SchedPlain, true, false>(F.lds, S, E, wave0); }
        }
        if (PM(1) && IN(pb + 0)) {
            RETID();
            { pg8::SchedPlain S; S.A = (const char*)F.HB8; S.B = (const char*)(F.WIN8 + (size_t)l * 3072 * D); S.lda2 = D; S.ldb2 = D; S.nt = D / 128; S.nM = M / 256; S.nN = 12; S.G = F.G; S.c = (int)blockIdx.x;
              pg8::EpiProj<true> E; E.P = F.PROJ; E.VT = F.VT; E.bias = args.b_in + (size_t)l * INC; E.rs = F.RS + (size_t)(2 * l) * M; E.pn_off = 12; E.cs = 1.0f / W8S;
              pg8::gemm_phase<pg8::EpiProj<true>, pg8::SchedPlain, true, false, true>(F.lds, S, E, wave0); }
        }
        SEAM(pb + 0);
        if (PM(2) && IN(pb + 1)) {
            RETID();
#ifndef P2M
#define P2M 7
#endif
            if (P2M & 1) {
            dft_fill_table<0>(F);
            LDS_WAIT(); __syncthreads();
            for (int u = F.vcu; u < 256; u += F.G) fft_a_unit(F, u);
            __syncthreads(); }
            if (P2M & 2) {
            for (int u = F.vcu; u < 256; u += F.G) { const int b = u >> 7, r = u & 127, rs = min(max(r - 4, 0), 120);
#pragma unroll 1
                for (int hp = 0; hp < 4; ++hp) {
                    const int h = 2 * hp + (F.wave >> 2), j = F.wave & 3;
                    AttnK K; attn_load_k(K, F.PROJ, b, r, h, j, F.lane);
                    __syncthreads();
                    { const int chunk = F.tid & 15, t0 = F.tid >> 4;
                      const bf16* vsrc = F.PROJ + ((size_t)b * SEQ + 64 * rs) * PPITCH + C_V + 128 * hp + 8 * chunk;
#pragma unroll 1
                      for (int hh = 0; hh < 2; ++hh) {
                      u32x4 vv[8];
#pragma unroll
                      for (int it = 0; it < 8; ++it) vv[it] = *(const u32x4*)(vsrc + (size_t)(t0 + 32 * (8 * hh + it)) * PPITCH);
#pragma unroll
                      for (int it = 0; it < 8; ++it) *(LAS u32x4*)(F.lds + (chunk >> 3) * AT_V1 + (t0 + 32 * (8 * hh + it)) * 128 + (chunk & 7) * 16) = vv[it];
                      }
                      const float* rp = args.na_rpb + ((size_t)l * 8 + 2 * hp) * 465; LAS float* rl = (LAS float*)(F.lds + AT_RPB);
                      for (int i = F.tid; i < 2 * 465; i += 512) rl[i] = rp[i]; }
                    LDS_WAIT(); __syncthreads();
                    attn_compute(K, F.lds + (F.wave >> 2) * AT_V1, (const LAS float*)(F.lds + AT_RPB) + (F.wave >> 2) * 465, F.BR, b, r, h, j, F.lane);
                } }
            __syncthreads(); }
            if (P2M & 4) for (int u = F.vcu; u < 256; u += F.G) lru_unit<1>(F, args, l, u >> 7, u & 127);
        }
        SEAM(pb + 1);
        if (PM(3) && IN(pb + 2)) {
            RETID();
            dft_fill_table<1>(F);
            LDS_WAIT(); __syncthreads();
            for (int u = F.vcu; u < 512; u += F.G) fft_c_unit(F, u);
            __syncthreads();
            for (int u = F.vcu; u < 256; u += F.G) lru_unit<2>(F, args, l, u >> 7, u & 127);
        }
        SEAM(pb + 2);
        if (PM(4) && IN(pb + 3)) {
            RETID();
            pg8::SchedMerge S; S.A = (const char*)F.BR; S.B = (const char*)(F.WBR + (size_t)l * D * BRP); S.lda2 = BRP * 2; S.ldb2 = BRP * 2; S.nM = M / 256; S.nN = D / 256; S.G = F.G; S.c = (int)blockIdx.x;
            pg8::EpiMerge E; E.G = (const unsigned char*)(F.PROJ + C_GATE); E.O = F.MERGED;
            pg8::gemm_phase<pg8::EpiMerge, pg8::SchedMerge, true, false>(F.lds, S, E, wave0);
        }
        SEAM(pb + 3);
        if (PM(5) && IN(pb + 4)) {
            RETID();
            pg8::SchedPlain S; S.A = (const char*)F.MERGED; S.B = (const char*)(F.WOUT + (size_t)l * D * D); S.lda2 = D * 2; S.ldb2 = D * 2; S.nt = D / 64; S.nM = M / 256; S.nN = D / 256; S.G = F.G; S.c = (int)blockIdx.x;
            pg8::EpiOut E; E.hb = F.HB; E.rs = F.RS + (size_t)(2 * l + 1) * M; E.hb8 = nullptr; E.cs = 1.0f;
            pg8::gemm_phase<pg8::EpiOut, pg8::SchedPlain, true, false>(F.lds, S, E, wave0);
        }
        SEAM(pb + 4);
        if ((l & 1) == 0) {
            const int j = l >> 1;
            if (PM(6) && IN(pb + 5)) {
                RETID();
                pg8::SchedPlain S; S.A = (const char*)F.HB; S.B = (const char*)(F.WGU + (size_t)j * 2 * DFF * D); S.lda2 = D * 2; S.ldb2 = D * 2; S.nt = D / 64; S.nM = M / 256; S.nN = 2 * DFF / 256; S.G = F.G; S.c = (int)blockIdx.x;
                pg8::EpiGU E; E.Hd = (unsigned char*)F.HID; E.ldh = DFF; E.rs = F.RS + (size_t)(2 * l + 1) * M; E.srow = nullptr; E.moe = false; E.cs = 1.0f;
                pg8::gemm_phase<pg8::EpiGU, pg8::SchedPlain, true, false, false>(F.lds, S, E, wave0);
            }
            SEAM(pb + 5);
            if (PM(7) && IN(pb + 6)) {
                RETID();
                pg8::SchedPlain S; S.A = (const char*)F.HID; S.B = (const char*)F.WDN + (size_t)j * D * DFF; S.lda2 = DFF; S.ldb2 = DFF; S.nt = DFF / 128; S.nM = M / 256; S.nN = D / 256; S.G = F.G; S.c = (int)blockIdx.x;
                pg8::EpiOut E; E.hb = F.HB; E.rs = F.RS + (size_t)(2 * l + 2) * M; E.hb8 = F.HB8; E.cs = 1.0f / (W8S * H8S);
                pg8::gemm_phase<pg8::EpiOut, pg8::SchedPlain, true, false, true>(F.lds, S, E, wave0);
            }
            SEAM(pb + 6);
        } else {
            const int jm = l >> 1;
            if (PM(8) && IN(pb + 5)) { RETID(); moe_router(F, jm, F.RS + (size_t)(2 * l + 1) * M); }
            SEAM(pb + 5);
            if (PM(9) && IN(pb + 6)) {
                RETID();
                pg8::SchedMoe S; moe_sched_init(F, jm, S);
                S.A = (const char*)F.HB; S.B = (const char*)(F.MGU + (size_t)(jm * 8) * 2 * DFE * D); S.list = F.LIST; S.lda2 = D * 2; S.ldb2 = D * 2; S.nt = D / 64; S.nN = 2 * DFE / 256; S.G = F.G; S.c = (int)blockIdx.x;
                S.bstride = (size_t)2 * DFE * D * 2; S.gather = true;
                pg8::EpiGU E; E.Hd = (unsigned char*)F.HID; E.ldh = DFE; E.rs = nullptr; E.srow = F.SROW; E.moe = true; E.cs = 1.0f;
                pg8::gemm_phase<pg8::EpiGU, pg8::SchedMoe, true, true, false>(F.lds, S, E, wave0);
            }
            SEAM(pb + 6);
            if (PM(10) && IN(pb + 7)) {
                RETID();
                pg8::SchedMoe S; moe_sched_init(F, jm, S);
                S.A = (const char*)F.HID; S.B = (const char*)F.MDN + (size_t)(jm * 8) * D * DFE; S.list = F.LIST; S.lda2 = DFE; S.ldb2 = DFE; S.nt = DFE / 128; S.nN = D / 256; S.G = F.G; S.c = (int)blockIdx.x;
                S.bstride = (size_t)D * DFE; S.gather = false;
                pg8::EpiMoeDown E; E.Y = F.YBUF; E.wslot = F.WSLOT;
                pg8::gemm_phase<pg8::EpiMoeDown, pg8::SchedMoe, true, false, true>(F.lds, S, E, wave0);
            }
            SEAM(pb + 7);
            if (PM(11) && IN(pb + 8)) { RETID(); moe_combine(F, args, jm, F.RS + (size_t)((2 * l + 2) & 7) * M, l == DEPTH - 1); }
            SEAM(pb + 8);
        }
    }
#undef IN
#undef SEAM
}

#ifndef ABL
#define ABL 0
#endif
#ifndef MK_PER_PHASE
#define MK_PER_PHASE 0
#endif
extern "C" void kernel_launch(void* const* d_in, const int* in_sizes, int n_in, void* d_out, int out_size, void* d_ws, size_t ws_size, hipStream_t stream) {
    static int grid = 0;
    if (grid == 0) {
        if (n_in != 21 || out_size != M * D || ws_size < WS_END) { fprintf(stderr, "kernel_launch: unexpected shapes (n_in %d out %d ws %zu)\n", n_in, out_size, ws_size); grid = -1; return; }
        int dev = 0, cus = 0, per_cu = 0;
        if (hipGetDevice(&dev) != hipSuccess || hipDeviceGetAttribute(&cus, hipDeviceAttributeMultiprocessorCount, dev) != hipSuccess) { grid = -1; return; }
        if (hipFuncSetAttribute((const void*)enc_fwd, hipFuncAttributeMaxDynamicSharedMemorySize, LDS_BYTES) != hipSuccess) { fprintf(stderr, "kernel_launch: hipFuncSetAttribute failed\n"); grid = -1; return; }
        if (hipOccupancyMaxActiveBlocksPerMultiprocessor(&per_cu, (const void*)enc_fwd, NWAVES * 64, LDS_BYTES) != hipSuccess || per_cu < 1)
            fprintf(stderr, "kernel_launch: note: occupancy query reports %d workgroups per CU\n", per_cu);
        (void)hipGetLastError();
        grid = cus;
    }
    if (grid < 0) return;
    (void)hipMemsetAsync((char*)d_ws + WS_CTL, 0, CTL_ZERO_BYTES, stream);
    (void)hipMemsetAsync((char*)d_ws + WS_RS, 0, 1 * MiB, stream);
    Args a{};
    a.x = (const float*)d_in[0]; a.norm_mix_g = (const float*)d_in[1]; a.w_in = (const float*)d_in[2]; a.b_in = (const float*)d_in[3]; a.na_rpb = (const float*)d_in[4];
    a.conv_w = (const float*)d_in[5]; a.conv_b = (const float*)d_in[6]; a.lru_wa = (const float*)d_in[7]; a.lru_ba = (const float*)d_in[8]; a.lru_wx = (const float*)d_in[9];
    a.lru_bx = (const float*)d_in[10]; a.lru_lambda = (const float*)d_in[11]; a.w_branch = (const float*)d_in[12]; a.w_out = (const float*)d_in[13]; a.norm_ffn_g = (const float*)d_in[14];
    a.ffn_w_gu = (const float*)d_in[15]; a.ffn_w_down = (const float*)d_in[16]; a.router_w = (const float*)d_in[17]; a.moe_w_gu = (const float*)d_in[18]; a.moe_w_down = (const float*)d_in[19];
    a.final_g = (const float*)d_in[20];
    a.out = (float*)d_out; a.ws = (unsigned char*)d_ws;
    constexpr int NPH = 1 + 9 * DEPTH;
#ifndef PROBE_LO
#define PROBE_LO -1
#define PROBE_HI -1
#endif
    if (PROBE_LO >= 0) {
        a.ph_lo = 0; a.ph_hi = PROBE_HI; a.bar_region = 0; hipLaunchKernelGGL(enc_fwd, dim3(grid), dim3(NWAVES * 64), LDS_BYTES, stream, a);
        a.ph_lo = PROBE_LO; a.ph_hi = PROBE_HI; a.bar_region = 1; hipLaunchKernelGGL(enc_fwd, dim3(grid), dim3(NWAVES * 64), LDS_BYTES, stream, a);
        a.ph_lo = PROBE_HI; a.ph_hi = NPH; a.bar_region = 2; hipLaunchKernelGGL(enc_fwd, dim3(grid), dim3(NWAVES * 64), LDS_BYTES, stream, a);
    } else {
        a.ph_lo = 0; a.ph_hi = NPH; a.bar_region = 0;
        hipLaunchKernelGGL(enc_fwd, dim3(grid), dim3(NWAVES * 64), LDS_BYTES, stream, a);
    }
    const hipError_t le = hipPeekAtLastError();
    if (le != hipSuccess) fprintf(stderr, "kernel_launch: launch failed: %s\n", hipGetErrorName(le));
}
```

```cpp
#include <hip/hip_runtime.h>
#include <cstdio>
#include <cstdint>

#ifndef ABL
#define ABL 0
#endif
#define LAS __attribute__((address_space(3)))
#define GAS __attribute__((address_space(1)))
typedef unsigned short bf16;
typedef short bf16x8 __attribute__((ext_vector_type(8)));
typedef short s16x4 __attribute__((ext_vector_type(4)));
typedef float f32x4 __attribute__((ext_vector_type(4)));
typedef float f32x2 __attribute__((ext_vector_type(2)));
typedef unsigned u32x4 __attribute__((ext_vector_type(4)));
typedef unsigned u32x2 __attribute__((ext_vector_type(2)));
typedef __bf16 bf16x2_t __attribute__((ext_vector_type(2)));
typedef GAS unsigned gu32;
#define RLX_AGENT __ATOMIC_RELAXED, __HIP_MEMORY_SCOPE_AGENT
#define LDS_WAIT() asm volatile("s_waitcnt lgkmcnt(0)" ::: "memory")
#define VM_WAIT() asm volatile("s_waitcnt vmcnt(0)" ::: "memory")

constexpr int NB = 2, SEQ = 8192, M = NB * SEQ, D = 1024, DEPTH = 4;
constexpr int INC = 6144;
constexpr int PPITCH = 6208;
constexpr int VTP = 8256;
constexpr int C_Q = 0, C_K = 512, C_V = 1024, C_UF = 1536, C_UX = 2048, C_UG = 2560, C_GATE = 3072;
constexpr int BRP = 2112;
constexpr int DFF = 3072, DFE = 1536, NEXP = 8;
constexpr float RMS_EPS = 1e-6f;
constexpr int NWAVES = 8;

constexpr size_t MiB = 1u << 20;
constexpr size_t WS_CTL = 0, CTL_ZERO_BYTES = 1 * MiB;
constexpr size_t WS_WIN = 1 * MiB;
constexpr size_t WS_WBR = 714 * MiB;
constexpr size_t WS_WOUT = 65 * MiB;
constexpr size_t WS_WGU = 73 * MiB;
constexpr size_t WS_WDN = 97 * MiB;
constexpr size_t WS_MGU = 109 * MiB;
constexpr size_t WS_MDN = 205 * MiB;
constexpr size_t WS_WL = 253 * MiB;
constexpr size_t WS_MISC = 254 * MiB;
constexpr size_t WS_LSUM = 255 * MiB;
constexpr size_t WS_MOEI = 257 * MiB;
constexpr size_t WS_HB = 259 * MiB;
constexpr size_t WS_HB8 = 291 * MiB;
constexpr size_t WS_WIN8 = 630 * MiB;
constexpr size_t WS_BR = 647 * MiB;
constexpr size_t WS_TP = 371 * MiB;
constexpr size_t WS_MERGED = 403 * MiB;
constexpr size_t WS_PROJ = 435 * MiB;
constexpr size_t WS_HID = 435 * MiB;
constexpr size_t WS_YBUF = 537 * MiB;
constexpr size_t WS_RS = 629 * MiB;
constexpr size_t WS_LSTH = 731 * MiB;
constexpr size_t WS_LSTP = WS_MERGED;
constexpr size_t WS_END = 747 * MiB;
constexpr int CW_BAR = 4096;
constexpr int CW_MOE = 16384;

constexpr int LDS_BYTES = 147456;
constexpr int SCR_BYTES = 139264;
constexpr int MISC_OFF = SCR_BYTES;

__device__ __forceinline__ unsigned pk2(float lo, float hi) { f32x2 v = {lo, hi}; bf16x2_t b = __builtin_convertvector(v, bf16x2_t); return __builtin_bit_cast(unsigned, b); }
__device__ __forceinline__ int opaque_i(int v) { asm volatile("" : "+v"(v)); return v; }
__device__ __forceinline__ int lane_id() { int l; asm volatile("v_mbcnt_lo_u32_b32 %0, -1, 0\n\tv_mbcnt_hi_u32_b32 %0, -1, %0" : "=&v"(l)); return l; }
__device__ __forceinline__ int tid_of(int wave0) { int w = wave0; asm volatile("" : "+s"(w)); return opaque_i(w * 64 + lane_id()); }
__device__ __forceinline__ float bf2f(unsigned short x) { return __uint_as_float((unsigned)x << 16); }
__device__ __forceinline__ unsigned pk4_u8(float a, float b, float c, float d) {
    unsigned r = 0; r = __builtin_amdgcn_cvt_pk_u8_f32(__builtin_fmaf(a, 256.f, -0.5f), 0, r); r = __builtin_amdgcn_cvt_pk_u8_f32(__builtin_fmaf(b, 256.f, -0.5f), 1, r);
    r = __builtin_amdgcn_cvt_pk_u8_f32(__builtin_fmaf(c, 256.f, -0.5f), 2, r); r = __builtin_amdgcn_cvt_pk_u8_f32(__builtin_fmaf(d, 256.f, -0.5f), 3, r); return r; }
__device__ __forceinline__ u32x4 pair16(u32x2 a, u32x2 b) {
    const auto rx = __builtin_amdgcn_permlane16_swap(a.x, b.x, false, false); const auto ry = __builtin_amdgcn_permlane16_swap(a.y, b.y, false, false);
    u32x4 r; r.x = rx[0]; r.y = ry[0]; r.z = rx[1]; r.w = ry[1]; return r;
}
__device__ __forceinline__ float ub8(unsigned x, int j) { return (float)((x >> (8 * j)) & 0xffu) + 0.5f; }
__device__ __forceinline__ float bflo(unsigned x) { return __uint_as_float(x << 16); }
__device__ __forceinline__ float bfhi(unsigned x) { return __uint_as_float(x & 0xffff0000u); }
__device__ __forceinline__ float wave_sum(float v) {
#pragma unroll
    for (int o = 1; o < 64; o <<= 1) v += __shfl_xor(v, o);
    return v;
}
constexpr float RS_SCALE = 16777216.0f;
constexpr float W8S = 64.0f, H8S = 8.0f;
typedef int i32x8 __attribute__((ext_vector_type(8)));
__device__ __forceinline__ float sat8(float x) { return __builtin_amdgcn_fmed3f(x, -448.0f, 448.0f); }
__device__ __forceinline__ unsigned pk4_fp8(float a, float b, float c, float d) { int r = 0; a = sat8(a); b = sat8(b); c = sat8(c); d = sat8(d); r = __builtin_amdgcn_cvt_pk_fp8_f32(a, b, r, false); r = __builtin_amdgcn_cvt_pk_fp8_f32(c, d, r, true); return (unsigned)r; }
__device__ __forceinline__ float rs_rstd(unsigned long long v) { return __builtin_amdgcn_rsqf((float)v * (1.0f / (RS_SCALE * D)) + RMS_EPS); }
__device__ __forceinline__ float fast_sigmoid(float x) { return __builtin_amdgcn_rcpf(1.0f + __builtin_amdgcn_exp2f(-1.44269504f * x)); }
__device__ __forceinline__ float gelu_tanh(float x) { const float z = 0.7978845608f * (x + 0.044715f * x * x * x); return x * fast_sigmoid(2.0f * z); }

namespace pg8 {
constexpr int BM = 256, BK = 64, HALF = 128, HTB = HALF * BK * 2, STAGE_BYTES = 8 * HTB, NXCD = 8, WGM = 8;
__host__ __device__ __forceinline__ int lds_byte(int r, int c) { const int st = (r >> 4) * 2 + (c >> 5), rr = r & 15, cc = c & 31, ob = rr * 64 + cc * 2; return st * 1024 + (ob ^ (((ob >> 9) & 1) << 5)); }
__host__ __device__ __forceinline__ void stage_rc(int b, int& R, int& C) { const int st = b / 1024, sb = b % 1024, swz = sb ^ (((sb >> 9) & 1) << 5); R = (st >> 1) * 16 + swz / 64; C = (st & 1) * 32 + (swz % 64) / 2; }
__host__ __device__ __forceinline__ int perm32(int rho) { const int n = rho >> 4, i = rho & 15; return 8 * (i >> 2) + 4 * n + (i & 3); }

struct Unit { int pm, pn, sub, aux; };
__device__ __forceinline__ bool tile_of(long L, int nM, int nN, int& pm, int& pn) {
    const int nwg = nM * nN; if (L >= nwg) return false;
    int wgid = (int)L; { const int q = nwg / NXCD, r = nwg % NXCD, xcd = wgid % NXCD, off = wgid / NXCD; wgid = (xcd < r ? xcd * (q + 1) : r * (q + 1) + (xcd - r) * q) + off; }
    const int nig = WGM * nN, gid = wgid / nig, fm = gid * WGM, gsz = (nM - fm) < WGM ? (nM - fm) : WGM;
    pm = fm + ((wgid % nig) % gsz); pn = (wgid % nig) / gsz; return true;
}
struct SchedPlain {
    const char* A; const char* B; int lda2, ldb2, nt, nM, nN, G, c;
    __device__ __forceinline__ bool next(int i, Unit& u) const { u.sub = 0; u.aux = 0; return tile_of((long)i * G + c, nM, nN, u.pm, u.pn); }
    __device__ __forceinline__ const char* a_ptr(const Unit& u) const { return A + (size_t)u.pm * 256 * lda2; }
    __device__ __forceinline__ const char* b_ptr(const Unit& u) const { return B + (size_t)u.pn * 256 * ldb2; }
    __device__ __forceinline__ int ntiles(const Unit&) const { return nt; }
    __device__ __forceinline__ unsigned row_off(const Unit&, int) const { return 0u; }
};
struct SchedMerge {
    const char* A; const char* B; int lda2, ldb2, nM, nN, G, c;
    __device__ __forceinline__ bool next(int i, Unit& u) const { u.sub = i % 3; u.aux = 0; return tile_of((long)(i / 3) * G + c, nM, nN, u.pm, u.pn); }
    __device__ __forceinline__ int koff(const Unit& u) const { return u.sub == 0 ? 0 : (u.sub == 1 ? 512 : 1536); }
    __device__ __forceinline__ const char* a_ptr(const Unit& u) const { return A + (size_t)u.pm * 256 * lda2 + koff(u) * 2; }
    __device__ __forceinline__ const char* b_ptr(const Unit& u) const { return B + (size_t)u.pn * 256 * ldb2 + koff(u) * 2; }
    __device__ __forceinline__ int ntiles(const Unit& u) const { return u.sub == 1 ? 16 : 8; }
    __device__ __forceinline__ unsigned row_off(const Unit&, int) const { return 0u; }
};
struct SchedMoe {
    const char* A; const char* B; const int* list; int lda2, ldb2, nt, nN, G, c; size_t bstride; bool gather;
    int t1, t2, t3, t4, t5, t6, t7, t8;
    const unsigned* cntp;
    __device__ __forceinline__ bool next(int i, Unit& u) const {
        if (!tile_of((long)i * G + c, t8, nN, u.pm, u.pn)) return false;
        const int pm = u.pm; int e = 0, a = 0;
        if (pm >= t1) { e = 1; a = t1; } if (pm >= t2) { e = 2; a = t2; } if (pm >= t3) { e = 3; a = t3; } if (pm >= t4) { e = 4; a = t4; }
        if (pm >= t5) { e = 5; a = t5; } if (pm >= t6) { e = 6; a = t6; } if (pm >= t7) { e = 7; a = t7; }
        u.sub = e; u.aux = a; return true;
    }
    __device__ __forceinline__ int cnt_of(int e) const { return __builtin_amdgcn_readfirstlane((int)cntp[e * 64]); }
    __device__ __forceinline__ const char* a_ptr(const Unit& u) const { return gather ? A : A + (size_t)u.pm * 256 * lda2; }
    __device__ __forceinline__ const char* b_ptr(const Unit& u) const { return B + (size_t)u.sub * bstride + (size_t)u.pn * 256 * ldb2; }
    __device__ __forceinline__ int ntiles(const Unit&) const { return nt; }
    __device__ __forceinline__ unsigned row_off(const Unit& u, int lrow) const {
        const int pos = (u.pm - u.aux) * 256 + lrow; const int cn = cnt_of(u.sub);
        const int tok = list[u.sub * 16384 + (pos < cn ? pos : 0)];
        return (unsigned)tok * (unsigned)lda2;
    }
};

template <class Epi, class Sched, bool ALIGN_EPI, bool GATHER, bool FP8 = false>
__device__ __forceinline__ void gemm_phase(LAS unsigned char* lds, const Sched& S, const Epi& E, int wave0) {
    const int tid = tid_of(wave0), wid = __builtin_amdgcn_readfirstlane(tid >> 6), lane = tid & 63, wr = wid >> 2, wc = wid & 3, fr = lane & 15, fq = lane >> 4;
    const int lda2 = S.lda2, ldb2 = S.ldb2;
    unsigned vA0[2], vA1[2], voffB[2];
    LAS unsigned* rowtab = (LAS unsigned*)(lds + STAGE_BYTES);
#pragma unroll
    for (int i = 0; i < 2; ++i) { int R, C; stage_rc(tid * 16 + i * 8192, R, C); const int Rb = Epi::PERM ? ((R & ~31) + perm32(R & 31)) : R;
        voffB[i] = (unsigned)(Rb * ldb2 + C * 2); vA0[i] = (unsigned)(R * lda2 + C * 2); vA1[i] = vA0[i] + (unsigned)(HALF * lda2); }
    const size_t kstep = (size_t)(BK * 2);
    const size_t hstepB = (size_t)HALF * ldb2;
    const unsigned ldsw = (unsigned)wid * 1024u;
    const int aoff = lds_byte(wr * 64 + fr, fq * 8), boff = lds_byte(wc * 32 + fr, fq * 8);
#define PG8_SA(b, h) (((b) * 2 + (h)) * HTB)
#define PG8_SB(b, h) ((4 + (b) * 2 + (h)) * HTB)
#define PG8_STAGE(bufoff, gbase, voff) do { _Pragma("unroll") for (int _i = 0; _i < 2; ++_i) \
        __builtin_amdgcn_global_load_lds((const unsigned*)((const char*)(gbase) + (voff)[_i]), (LAS unsigned*)(lds + (bufoff) + ldsw + _i * 8192), 16, 0, 0); } while (0)
#define PG8_LDA(dst, b, h) do { if constexpr (FP8) { _Pragma("unroll") for (int m = 0; m < 4; ++m) { const u32x4 lo_ = *(const LAS u32x4*)(lds + PG8_SA(b, h) + aoff + m * 2048), hi_ = *(const LAS u32x4*)(lds + PG8_SA(b, h) + aoff + m * 2048 + 1024); \
        dst##8[m] = __builtin_bit_cast(i32x8, __builtin_shufflevector(lo_, hi_, 0, 1, 2, 3, 4, 5, 6, 7)); } } \
    else { _Pragma("unroll") for (int m = 0; m < 4; ++m) _Pragma("unroll") for (int k = 0; k < 2; ++k) dst[m][k] = *(const LAS bf16x8*)(lds + PG8_SA(b, h) + aoff + m * 2048 + k * 1024); } } while (0)
#define PG8_LDB(dst, b, h) do { if constexpr (FP8) { _Pragma("unroll") for (int n = 0; n < 2; ++n) { const u32x4 lo_ = *(const LAS u32x4*)(lds + PG8_SB(b, h) + boff + n * 2048), hi_ = *(const LAS u32x4*)(lds + PG8_SB(b, h) + boff + n * 2048 + 1024); \
        dst##8[n] = __builtin_bit_cast(i32x8, __builtin_shufflevector(lo_, hi_, 0, 1, 2, 3, 4, 5, 6, 7)); } } \
    else { _Pragma("unroll") for (int n = 0; n < 2; ++n) _Pragma("unroll") for (int k = 0; k < 2; ++k) dst[n][k] = *(const LAS bf16x8*)(lds + PG8_SB(b, h) + boff + n * 2048 + k * 1024); } } while (0)
#define PG8_MMA(ai, bj, At, Bt) do { __builtin_amdgcn_s_setprio(1); _Pragma("unroll") for (int m = 0; m < 4; ++m) _Pragma("unroll") for (int n = 0; n < 2; ++n) { \
        if constexpr (FP8) asm volatile("v_mfma_scale_f32_16x16x128_f8f6f4 %0, %1, %2, %0, %3, %3 op_sel_hi:[0,0,0]" : "+v"(acc[ai][bj][m][n]) : "v"(Bt##8[n]), "v"(At##8[m]), "v"(sc1)); \
        else { _Pragma("unroll") for (int k = 0; k < 2; ++k) acc[ai][bj][m][n] = __builtin_amdgcn_mfma_f32_16x16x32_bf16(Bt[n][k], At[m][k], acc[ai][bj][m][n], 0, 0, 0); } } \
        __builtin_amdgcn_s_setprio(0); } while (0)
#define PG8_WAIT_V(n) asm volatile("s_waitcnt vmcnt(" #n ")" ::: "memory")
#define PG8_WAIT_L(n) asm volatile("s_waitcnt lgkmcnt(" #n ")" ::: "memory")
#define PG8_BAR __builtin_amdgcn_s_barrier()
#define PG8_SCHED __builtin_amdgcn_sched_barrier(0)
    Unit cur, nxt; int ui = 0;
    if (!S.next(0, cur)) return;
    f32x4 acc[2][2][4][2];
#pragma unroll
    for (int a = 0; a < 2; ++a)
#pragma unroll
        for (int b = 0; b < 2; ++b)
#pragma unroll
            for (int m = 0; m < 4; ++m)
#pragma unroll
                for (int n = 0; n < 2; ++n) acc[a][b][m][n] = (f32x4){0.f, 0.f, 0.f, 0.f};
    bf16x8 At[4][2], B0[2][2], B1[2][2];
    i32x8 At8[4], B08[2], B18[2]; const int sc1 = 0x7F7F7F7F;
    const char* cA = S.a_ptr(cur); const char* cB = S.b_ptr(cur); int nt = S.ntiles(cur);
    if constexpr (GATHER) {
#pragma unroll
        for (int i = 0; i < 2; ++i) { int R, C; stage_rc(tid * 16 + i * 8192, R, C); vA0[i] = S.row_off(cur, R) + (unsigned)(C * 2); vA1[i] = S.row_off(cur, HALF + R) + (unsigned)(C * 2); }
    }
    PG8_STAGE(PG8_SB(0, 0), cB, voffB); PG8_STAGE(PG8_SB(0, 1), cB + hstepB, voffB); PG8_STAGE(PG8_SA(0, 0), cA, vA0); PG8_STAGE(PG8_SA(0, 1), cA, vA1);
    if (wr == 1) PG8_BAR;
    PG8_WAIT_V(2); PG8_BAR;
    PG8_STAGE(PG8_SB(1, 0), cB + kstep, voffB); PG8_STAGE(PG8_SA(1, 0), cA + kstep, vA0); PG8_STAGE(PG8_SB(1, 1), cB + hstepB + kstep, voffB);
    PG8_WAIT_V(6); PG8_BAR;
    for (;;) {
        const bool has_next = S.next(ui + 1, nxt);
        const char* nA = has_next ? S.a_ptr(nxt) : cA; const char* nB = has_next ? S.b_ptr(nxt) : cB;
        for (int t = 0; t < nt; t += 2) {
            const bool last = (t == nt - 2);
            const char* a1 = cA + (size_t)(t + 1) * kstep;
            const char* a2 = last ? nA : cA + (size_t)(t + 2) * kstep; const char* b2 = last ? nB : cB + (size_t)(t + 2) * kstep;
            const char* a3 = a2 + kstep; const char* b3 = b2 + kstep;
            if constexpr (GATHER) { if (last && has_next) { if (tid < 256) rowtab[tid] = S.row_off(nxt, tid); } }
            PG8_LDB(B0, 0, 0); PG8_LDB(B1, 0, 1); PG8_SCHED; PG8_LDA(At, 0, 0); PG8_STAGE(PG8_SA(1, 1), a1, vA1);
            PG8_WAIT_V(8); PG8_WAIT_L(0); PG8_BAR; PG8_MMA(0, 0, At, B0); PG8_MMA(0, 1, At, B1); PG8_BAR; PG8_SCHED;
            if constexpr (GATHER) { if (last && has_next) {
_Pragma("unroll") for (int i = 0; i < 2; ++i) { int R, C; stage_rc(tid * 16 + i * 8192, R, C); vA0[i] = rowtab[R] + (unsigned)(C * 2); vA1[i] = rowtab[HALF + R] + (unsigned)(C * 2); } } }
            PG8_LDA(At, 0, 1); PG8_STAGE(PG8_SB(0, 0), b2, voffB); PG8_STAGE(PG8_SB(0, 1), b2 + hstepB, voffB); PG8_STAGE(PG8_SA(0, 0), a2, vA0);
            PG8_WAIT_V(8); PG8_WAIT_L(0); PG8_BAR; PG8_MMA(1, 0, At, B0); PG8_MMA(1, 1, At, B1); PG8_BAR; PG8_SCHED;
            PG8_LDB(B0, 1, 0); PG8_LDB(B1, 1, 1); PG8_SCHED; PG8_LDA(At, 1, 0); PG8_STAGE(PG8_SA(0, 1), a2, vA1);
            PG8_WAIT_V(8); PG8_WAIT_L(0); PG8_BAR; PG8_MMA(0, 0, At, B0); PG8_MMA(0, 1, At, B1); PG8_BAR; PG8_SCHED;
            PG8_LDA(At, 1, 1); PG8_STAGE(PG8_SB(1, 0), b3, voffB); PG8_STAGE(PG8_SB(1, 1), b3 + hstepB, voffB); PG8_STAGE(PG8_SA(1, 0), a3, vA0);
            PG8_WAIT_V(8); PG8_WAIT_L(0); PG8_BAR; PG8_MMA(1, 0, At, B0); PG8_MMA(1, 1, At, B1); PG8_BAR; PG8_SCHED;
        }
        if constexpr (ALIGN_EPI) { if (wr == 0) PG8_BAR; }
        if constexpr (FP8) asm volatile("s_nop 15\n\ts_nop 15" ::: "memory");
        E(acc, cur, wr, wc, opaque_i(fr), opaque_i(fq));
        if (!has_next) break;
        if (!(Epi::CARRY && E.keep(cur))) {
#pragma unroll
            for (int a = 0; a < 2; ++a)
#pragma unroll
                for (int b = 0; b < 2; ++b)
#pragma unroll
                    for (int m = 0; m < 4; ++m)
#pragma unroll
                        for (int n = 0; n < 2; ++n) acc[a][b][m][n] = (f32x4){0.f, 0.f, 0.f, 0.f};
        }
        cur = nxt; cA = nA; cB = nB; nt = S.ntiles(cur); ++ui;
        if constexpr (ALIGN_EPI) { if (wr == 1) PG8_BAR; }
    }
    PG8_WAIT_V(0);
    if constexpr (!ALIGN_EPI) { if (wr == 0) PG8_BAR; }
    PG8_BAR;
#undef PG8_SA
#undef PG8_SB
#undef PG8_STAGE
#undef PG8_LDA
#undef PG8_LDB
#undef PG8_MMA
#undef PG8_WAIT_V
#undef PG8_WAIT_L
#undef PG8_BAR
#undef PG8_SCHED
}

template <bool GATES>
struct EpiProj {
    static constexpr bool PERM = true, CARRY = false;
    bf16* P; bf16* VT; const float* bias; const unsigned long long* rs; int pn_off; float cs;
    __device__ __forceinline__ bool keep(const Unit&) const { return false; }
    __device__ __forceinline__ void operator()(f32x4 (&acc)[2][2][4][2], const Unit& u, int wr, int wc, int fr, int fq) const {
        const int pn = u.pn + pn_off; const int row0 = u.pm * BM + wr * 64 + fr, colb = pn * BM + wc * 32 + 8 * fq;
        const int kind = GATES ? 4 : (pn < 2) ? 0 : (pn < 10) ? 1 : 3;
        unsigned long long rsv[8]; f32x4 bv[2][2];
#pragma unroll
        for (int k = 0; k < 8; ++k) rsv[k] = rs[row0 + (k >> 2) * HALF + (k & 3) * 16];
#pragma unroll
        for (int bj = 0; bj < 2; ++bj) { bv[bj][0] = *(const f32x4*)(bias + colb + bj * HALF); bv[bj][1] = *(const f32x4*)(bias + colb + bj * HALF + 4); }
        __builtin_amdgcn_sched_barrier(0);
        if constexpr (GATES) {
            unsigned char* gp = (unsigned char*)(P + (size_t)(row0 + (fq & 1) * 16) * PPITCH + C_GATE) + (pn * BM - C_GATE) + wc * 32 + 8 * (fq & ~1);
#pragma unroll
            for (int ai = 0; ai < 2; ++ai)
#pragma unroll
                for (int mp = 0; mp < 2; ++mp)
#pragma unroll
                    for (int bj = 0; bj < 2; ++bj) {
                        u32x2 w8[2];
#pragma unroll
                        for (int h = 0; h < 2; ++h) {
                            const int m = mp * 2 + h; const float sr = rs_rstd(rsv[ai * 4 + m]) * cs;
                            float v[8];
                            const f32x4 bv0 = bv[bj][0], bv1 = bv[bj][1];
#pragma unroll
                            for (int i = 0; i < 4; ++i) { v[i] = acc[ai][bj][m][0][i] * sr + bv0[i]; v[4 + i] = acc[ai][bj][m][1][i] * sr + bv1[i]; }
#pragma unroll
                            for (int e = 0; e < 8; ++e) v[e] = fast_sigmoid(fminf(fmaxf(v[e], -30.f), 30.f));
                            w8[h].x = pk4_u8(v[0], v[1], v[2], v[3]); w8[h].y = pk4_u8(v[4], v[5], v[6], v[7]);
                        }
                        *(u32x4*)(gp + (size_t)(ai * HALF + mp * 32) * (2 * PPITCH) + bj * HALF) = pair16(w8[0], w8[1]);
                    }
        } else {
#pragma unroll
        for (int ai = 0; ai < 2; ++ai)
#pragma unroll
            for (int m = 0; m < 4; ++m) {
                const int row = row0 + ai * HALF + m * 16;
                const float sr = rs_rstd(rsv[ai * 4 + m]) * cs;
#pragma unroll
                for (int bj = 0; bj < 2; ++bj) {
                    float v[8];
                    const f32x4 bv0 = bv[bj][0], bv1 = bv[bj][1];
#pragma unroll
                    for (int i = 0; i < 4; ++i) { v[i] = acc[ai][bj][m][0][i] * sr + bv0[i]; v[4 + i] = acc[ai][bj][m][1][i] * sr + bv1[i]; }
                    if (kind == 0) {
#pragma unroll
                        for (int e = 0; e < 8; ++e) v[e] *= 0.125f;
                    } else if (kind == 3) {
#pragma unroll
                        for (int e = 0; e < 8; ++e) v[e] = gelu_tanh(v[e]);
                    }
                    { u32x4 w; w.x = pk2(v[0], v[1]); w.y = pk2(v[2], v[3]); w.z = pk2(v[4], v[5]); w.w = pk2(v[6], v[7]);
                      *(u32x4*)(P + (size_t)row * PPITCH + colb + bj * HALF) = w; }
                }
            }
        }
    }
};
struct EpiMerge {
    static constexpr bool PERM = true, CARRY = true;
    const unsigned char* G; bf16* O;
    __device__ __forceinline__ bool keep(const Unit& u) const { return u.sub < 2; }
    __device__ __forceinline__ void operator()(f32x4 (&acc)[2][2][4][2], const Unit& u, int wr, int wc, int fr, int fq) const {
        const int row0 = u.pm * BM + wr * 64 + fr, colb = u.pn * BM + wc * 32 + 8 * fq, sub = u.sub;
#pragma unroll
        for (int ai = 0; ai < 2; ++ai) {
            u32x2 gk[4][2], gn[4][2];
#pragma unroll
            for (int m = 0; m < 4; ++m)
#pragma unroll
                for (int bj = 0; bj < 2; ++bj) {
                    const unsigned char* gp = G + (size_t)(row0 + ai * HALF + m * 16) * (2 * PPITCH) + sub * D + colb + bj * HALF;
                    gk[m][bj] = *(const u32x2*)gp;
                    if (sub < 2) gn[m][bj] = *(const u32x2*)(gp + D);
                }
            __builtin_amdgcn_sched_barrier(0);
#pragma unroll
            for (int m = 0; m < 4; ++m) {
                const int row = row0 + ai * HALF + m * 16;
#pragma unroll
                for (int bj = 0; bj < 2; ++bj) {
                    const u32x2 g4 = gk[m][bj];
                    float f[8] = {ub8(g4.x, 0), ub8(g4.x, 1), ub8(g4.x, 2), ub8(g4.x, 3), ub8(g4.y, 0), ub8(g4.y, 1), ub8(g4.y, 2), ub8(g4.y, 3)};
                    if (sub < 2) {
                        const u32x2 n4 = gn[m][bj];
                        const float d[8] = {ub8(n4.x, 0), ub8(n4.x, 1), ub8(n4.x, 2), ub8(n4.x, 3), ub8(n4.y, 0), ub8(n4.y, 1), ub8(n4.y, 2), ub8(n4.y, 3)};
#pragma unroll
                        for (int e = 0; e < 8; ++e) f[e] *= __builtin_amdgcn_rcpf(d[e]);
                    } else {
#pragma unroll
                        for (int e = 0; e < 8; ++e) f[e] *= (1.0f / 256.0f);
                    }
#pragma unroll
                    for (int n = 0; n < 2; ++n)
#pragma unroll
                        for (int i = 0; i < 4; ++i) acc[ai][bj][m][n][i] *= f[n * 4 + i];
                    if (sub == 2) {
                        u32x4 w; w.x = pk2(acc[ai][bj][m][0][0], acc[ai][bj][m][0][1]); w.y = pk2(acc[ai][bj][m][0][2], acc[ai][bj][m][0][3]);
                        w.z = pk2(acc[ai][bj][m][1][0], acc[ai][bj][m][1][1]); w.w = pk2(acc[ai][bj][m][1][2], acc[ai][bj][m][1][3]);
                        *(u32x4*)(O + (size_t)row * D + colb + bj * HALF) = w;
                    }
                }
            }
        }
    }
};
struct EpiOut {
    static constexpr bool PERM = true, CARRY = false;
    bf16* hb; unsigned long long* rs; unsigned char* hb8; float cs;
    __device__ __forceinline__ bool keep(const Unit&) const { return false; }
    __device__ __forceinline__ void operator()(f32x4 (&acc)[2][2][4][2], const Unit& u, int wr, int wc, int fr, int fq) const {
        const int row0 = u.pm * BM + wr * 64 + fr, colb = u.pn * BM + wc * 32 + 8 * fq;
#pragma unroll
        for (int ai = 0; ai < 2; ++ai) {
            u32x4 hv[4][2];
#pragma unroll
            for (int m = 0; m < 4; ++m)
#pragma unroll
                for (int bj = 0; bj < 2; ++bj) hv[m][bj] = *(const u32x4*)(hb + (size_t)(row0 + ai * HALF + m * 16) * D + colb + bj * HALF);
            __builtin_amdgcn_sched_barrier(0);
            float ssm[4]; u32x2 w8[4][2];
#pragma unroll
            for (int m = 0; m < 4; ++m) {
                const int row = row0 + ai * HALF + m * 16; float ss = 0.f;
#pragma unroll
                for (int bj = 0; bj < 2; ++bj) {
                    bf16* hp = hb + (size_t)row * D + colb + bj * HALF;
                    const u32x4 h4 = hv[m][bj];
                    float v[8] = {bflo(h4.x), bfhi(h4.x), bflo(h4.y), bfhi(h4.y), bflo(h4.z), bfhi(h4.z), bflo(h4.w), bfhi(h4.w)};
#pragma unroll
                    for (int n = 0; n < 2; ++n)
#pragma unroll
                        for (int i = 0; i < 4; ++i) { v[n * 4 + i] += acc[ai][bj][m][n][i] * cs; ss += v[n * 4 + i] * v[n * 4 + i]; }
                    u32x4 w; w.x = pk2(v[0], v[1]); w.y = pk2(v[2], v[3]); w.z = pk2(v[4], v[5]); w.w = pk2(v[6], v[7]);
                    *(u32x4*)hp = w;
                    if (hb8) { w8[m][bj].x = pk4_fp8(v[0], v[1], v[2], v[3]); w8[m][bj].y = pk4_fp8(v[4], v[5], v[6], v[7]); }
                }
                ss += __shfl_xor(ss, 16); ss += __shfl_xor(ss, 32); ssm[m] = ss;
            }
            if (hb8) {
                unsigned char* qp = hb8 + (size_t)(row0 + ai * HALF + (fq & 1) * 16) * D + u.pn * BM + wc * 32 + 8 * (fq & ~1);
#pragma unroll
                for (int mp = 0; mp < 2; ++mp)
#pragma unroll
                    for (int bj = 0; bj < 2; ++bj) *(u32x4*)(qp + (size_t)(mp * 32) * D + bj * HALF) = pair16(w8[mp * 2][bj], w8[mp * 2 + 1][bj]);
            }
            { const float ssel = (fq == 0) ? ssm[0] : (fq == 1) ? ssm[1] : (fq == 2) ? ssm[2] : ssm[3];
              atomicAdd(rs + row0 + ai * HALF + fq * 16, (unsigned long long)(ssel * RS_SCALE)); }
        }
    }
};
struct EpiGU {
    static constexpr bool PERM = true, CARRY = false;
    unsigned char* Hd; int ldh; const unsigned long long* rs; const float* srow; bool moe; float cs;
    __device__ __forceinline__ bool keep(const Unit&) const { return false; }
    __device__ __forceinline__ void operator()(f32x4 (&acc)[2][2][4][2], const Unit& u, int wr, int wc, int fr, int fq) const {
        const int lrow0 = wr * 64 + fr, hcol = u.pn * HALF + wc * 32 + 8 * fq;
        float srv[8];
#pragma unroll
        for (int k = 0; k < 8; ++k) { const int lrow = lrow0 + (k >> 2) * HALF + (k & 3) * 16;
            if (moe) srv[k] = srow[u.sub * 16384 + (u.pm - u.aux) * 256 + lrow]; else srv[k] = rs_rstd(rs[u.pm * BM + lrow]); }
        __builtin_amdgcn_sched_barrier(0);
        unsigned char* hp = Hd + (size_t)(u.pm * BM + lrow0 + (fq & 1) * 16) * ldh + u.pn * HALF + wc * 32 + 8 * (fq & ~1);
#pragma unroll
        for (int ai = 0; ai < 2; ++ai)
#pragma unroll
            for (int mp = 0; mp < 2; ++mp) {
                u32x2 w[2];
#pragma unroll
                for (int h = 0; h < 2; ++h) {
                    const int m = mp * 2 + h; const float sr = srv[ai * 4 + m] * cs;
                    float o[8];
#pragma unroll
                    for (int n = 0; n < 2; ++n)
#pragma unroll
                        for (int i = 0; i < 4; ++i) { const float g = acc[ai][0][m][n][i] * sr, uu = acc[ai][1][m][n][i] * sr; o[n * 4 + i] = g * fast_sigmoid(g) * uu * H8S; }
                    w[h].x = pk4_fp8(o[0], o[1], o[2], o[3]); w[h].y = pk4_fp8(o[4], o[5], o[6], o[7]);
                }
                *(u32x4*)(hp + (size_t)(ai * HALF + mp * 32) * ldh) = pair16(w[0], w[1]);
            }
    }
};
struct EpiMoeDown {
    static constexpr bool PERM = true, CARRY = false;
    bf16* Y; const float* wslot;
    __device__ __forceinline__ bool keep(const Unit&) const { return false; }
    __device__ __forceinline__ void operator()(f32x4 (&acc)[2][2][4][2], const Unit& u, int wr, int wc, int fr, int fq) const {
        const int lrow0 = wr * 64 + fr, colb = u.pn * BM + wc * 32 + 8 * fq;
        float wtv[8];
#pragma unroll
        for (int k = 0; k < 8; ++k) wtv[k] = wslot[u.sub * 16384 + (u.pm - u.aux) * 256 + lrow0 + (k >> 2) * HALF + (k & 3) * 16];
        __builtin_amdgcn_sched_barrier(0);
#pragma unroll
        for (int ai = 0; ai < 2; ++ai)
#pragma unroll
            for (int m = 0; m < 4; ++m) {
                const int lrow = lrow0 + ai * HALF + m * 16; const int row = u.pm * BM + lrow;
                const float wt = wtv[ai * 4 + m] * (1.0f / (W8S * H8S));
#pragma unroll
                for (int bj = 0; bj < 2; ++bj) {
                    const f32x4 v0 = acc[ai][bj][m][0] * wt, v1 = acc[ai][bj][m][1] * wt;
                    u32x4 w; w.x = pk2(v0[0], v0[1]); w.y = pk2(v0[2], v0[3]); w.z = pk2(v1[0], v1[1]); w.w = pk2(v1[2], v1[3]);
                    *(u32x4*)(Y + (size_t)row * D + colb + bj * HALF) = w;
                }
            }
    }
};
}

#define XB_TMO      128
#define XB_XCNT(j)  (256  + 64 * (j))
#define XB_XSUB(j)  (1280 + 64 * (j))
#define XB_XGEN(j)  (2304 + 64 * (j))
#define XB_TOP      3328
#define XB_TOPGEN   3392
#define XCD_BAR_WORDS 3456
#define XB_SPIN_CAP (1u << 18)
__device__ __forceinline__ unsigned xb_ld(unsigned* p)              { return __hip_atomic_load(p, __ATOMIC_RELAXED, __HIP_MEMORY_SCOPE_AGENT); }
__device__ __forceinline__ unsigned xb_add(unsigned* p, unsigned v) { return __hip_atomic_fetch_add(p, v, __ATOMIC_RELAXED, __HIP_MEMORY_SCOPE_AGENT); }
__device__ __forceinline__ unsigned xb_xcc_id() { return (unsigned)__builtin_amdgcn_s_getreg((3 << 11) | 20) & 0xFu; }
#define XB_SPIN(cond, bar) do { unsigned _sp = 0; while (cond) { __builtin_amdgcn_s_sleep(1); \
    if ((++_sp & 255u) == 0u) { if (xb_ld(&(bar)[XB_TMO])) break; if (_sp > XB_SPIN_CAP) { atomicAdd(&(bar)[XB_TMO], 1u); break; } } } } while (0)
struct XcdBarrier { unsigned* bar; unsigned x; volatile LAS unsigned* st; };
__device__ __forceinline__ XcdBarrier xcd_barrier_post(unsigned* bar, volatile LAS unsigned* st, int wave0) {
    XcdBarrier b; b.bar = bar; b.x = xb_xcc_id(); b.st = st;
    if (wave0 == 0 && lane_id() == 0) (void)xb_add(&bar[XB_XCNT(b.x)], 1u);
    return b;
}
__device__ __forceinline__ void xcd_barrier_complete(unsigned* bar, unsigned x, unsigned& nloc, unsigned& nx) {
    const unsigned G = gridDim.x * gridDim.y * gridDim.z;
    unsigned sum, cnt, mine, sp = 0u;
    for (;;) {
        sum = 0u; cnt = 0u; mine = 0u;
#pragma unroll
        for (unsigned j = 0; j < 16; ++j) { const unsigned c = xb_ld(&bar[XB_XCNT(j)]); sum += c; cnt += (c > 0u) ? 1u : 0u; mine = (j == x) ? c : mine; }
        if (sum == G) break;
        __builtin_amdgcn_s_sleep(1);
        if ((++sp & 255u) == 0u) { if (xb_ld(&bar[XB_TMO])) break; if (sp > XB_SPIN_CAP) { atomicAdd(&bar[XB_TMO], 1u); break; } }
    }
    nloc = mine > 0u ? mine : 1u; nx = cnt > 0u ? cnt : 1u;
}
__device__ __forceinline__ void xcd_barrier(const XcdBarrier& b, int wave0) {
    asm volatile("s_waitcnt vmcnt(0)" ::: "memory");
    __syncthreads();
    if (wave0 == 0 && lane_id() == 0) {
        unsigned* bar = b.bar;
        __builtin_amdgcn_s_waitcnt(0);
        unsigned nloc = b.st[0], nx = b.st[1];
        if (nloc == 0u) { xcd_barrier_complete(bar, b.x, nloc, nx); b.st[0] = nloc; b.st[1] = nx; }
        const unsigned old = xb_add(&bar[XB_XSUB(b.x)], 1u);
        const unsigned gen = old / nloc;
        if (old + 1u == (gen + 1u) * nloc) {
            __builtin_amdgcn_fence(__ATOMIC_RELEASE, "agent");
            asm volatile("s_waitcnt vmcnt(0)" ::: "memory");
            const unsigned og = xb_add(&bar[XB_TOP], 1u);
            const unsigned tg = og / nx;
            if (og + 1u == (tg + 1u) * nx) xb_add(&bar[XB_TOPGEN], 1u);
            else XB_SPIN(xb_ld(&bar[XB_TOPGEN]) == tg, bar);
            __builtin_amdgcn_fence(__ATOMIC_ACQUIRE, "agent");
            xb_add(&bar[XB_XGEN(b.x)], 1u);
            asm volatile("s_waitcnt vmcnt(0)" ::: "memory");
        } else {
            XB_SPIN(xb_ld(&bar[XB_XGEN(b.x)]) == gen, bar);
            __builtin_amdgcn_fence(__ATOMIC_ACQUIRE, "agent");
            asm volatile("s_waitcnt vmcnt(0)" ::: "memory");
        }
    }
    __syncthreads();
}

struct Args {
    const float* x; const float* norm_mix_g; const float* w_in; const float* b_in; const float* na_rpb; const float* conv_w; const float* conv_b;
    const float* lru_wa; const float* lru_ba; const float* lru_wx; const float* lru_bx; const float* lru_lambda; const float* w_branch; const float* w_out;
    const float* norm_ffn_g; const float* ffn_w_gu; const float* ffn_w_down; const float* router_w; const float* moe_w_gu; const float* moe_w_down; const float* final_g;
    float* out; unsigned char* ws; int ph_lo, ph_hi, bar_region, pad;
};
struct Frame {
    LAS unsigned char* lds;
    int tid, lane, wave, vcu, G;
    unsigned* ctl;
    float* H;
    bf16 *HB, *VT, *BR, *TP, *MERGED, *PROJ, *HID, *YBUF; unsigned char* HB8;
    bf16 *WIN, *WBR, *WOUT, *WGU, *WDN, *MGU, *MDN, *WL; unsigned char* WIN8;
    float *NSP, *GW; f32x2* LSUM; unsigned long long* RS; u32x4 *LSTH, *LSTP;
    int* LIST; float* SROW; float* WSLOT; int* TOKI;
};

template <int STEP> __device__ __forceinline__ u32x4 dft_table_entry(int idx);
struct TrDesc { const float* W; const float* ks; unsigned char* WT; int ldw, k0, n0, ldwt, drow0, dcol0, fp8; };
__device__ __forceinline__ void tr_load(const TrDesc& d, float (&tv)[32], float (&kv)[32], int lane) {
#pragma unroll
    for (int i = 0; i < 32; ++i) tv[i] = __builtin_nontemporal_load(d.W + (size_t)(d.k0 + 2 * i + (lane >> 5)) * d.ldw + d.n0 + (lane & 31));
    if (d.ks) {
#pragma unroll
        for (int i = 0; i < 32; ++i) kv[i] = d.ks[d.k0 + 2 * i + (lane >> 5)];
    } else {
#pragma unroll
        for (int i = 0; i < 32; ++i) kv[i] = 1.0f;
    }
}
__device__ __forceinline__ void tr_store(const TrDesc& d, const float (&tv)[32], const float (&kv)[32], LAS float* scr, int lane) {
    const float sc = d.fp8 ? W8S : 1.0f;
#pragma unroll
    for (int i = 0; i < 32; ++i) scr[(2 * i + (lane >> 5)) * 33 + (lane & 31)] = tv[i] * kv[i] * sc;
    LDS_WAIT(); asm volatile("" ::: "memory");
    const int c = lane & 7;
#pragma unroll
    for (int j = 0; j < 4; ++j) { const int n = (lane >> 3) + 8 * j; const LAS float* s = scr + (8 * c) * 33 + n;
        if (d.fp8) { u32x2 o; o.x = pk4_fp8(s[0 * 33], s[1 * 33], s[2 * 33], s[3 * 33]); o.y = pk4_fp8(s[4 * 33], s[5 * 33], s[6 * 33], s[7 * 33]);
            *(u32x2*)(d.WT + (size_t)(d.drow0 + n) * d.ldwt + d.dcol0 + d.k0 + 8 * c) = o; }
        else { u32x4 o; o.x = pk2(s[0 * 33], s[1 * 33]); o.y = pk2(s[2 * 33], s[3 * 33]); o.z = pk2(s[4 * 33], s[5 * 33]); o.w = pk2(s[6 * 33], s[7 * 33]);
            *(u32x4*)((bf16*)d.WT + (size_t)(d.drow0 + n) * d.ldwt + d.dcol0 + d.k0 + 8 * c) = o; } }
    LDS_WAIT(); asm volatile("" ::: "memory");
}
__device__ __forceinline__ int gu_row(int n0, int half) { const int isu = n0 >= half ? 1 : 0; const int hid = n0 - isu * half; return 256 * (hid >> 7) + 128 * isu + (hid & 127); }
template <int STEP> __device__ __forceinline__ u32x4 dft_table_entry(int idx);
__device__ __forceinline__ const Args& fresh_args() { const Args* p = (const Args*)__builtin_amdgcn_kernarg_segment_ptr(); asm volatile("" : "+s"(p)); return *p; }
constexpr int I_IN = 16 * 192, I_BR = 8 * 32, I_OUT = 16 * 32, I_GU = 16 * 192, I_DN = 48 * 32, I_MGU = 16 * 96, I_MDN = 24 * 32;
constexpr int N_IN = 4 * I_IN, N_BR = 8 * I_BR, N_OUT = 4 * I_OUT, N_GU = 2 * I_GU, N_DN = 2 * I_DN, N_MGU = 16 * I_MGU, N_MDN = 16 * I_MDN;
constexpr int NITEMS = N_IN + N_BR + N_OUT + N_GU + N_DN + N_MGU + N_MDN;
__device__ __forceinline__ TrDesc tr_decode(Frame& F, int it) {
    const Args& a = fresh_args(); TrDesc d; d.ks = nullptr; d.dcol0 = 0; d.fp8 = 0;
    int r = it;
    if (r < N_IN) { const int l = r / I_IN, q = r % I_IN, half = q / (I_IN / 2), q2 = q % (I_IN / 2), kb = q2 / 96, nb = q2 % 96;
        d.W = a.w_in + (size_t)l * D * INC; d.ldw = INC; d.k0 = 64 * kb; d.ks = a.norm_mix_g + l * D; d.ldwt = D; d.drow0 = 32 * nb;
        if (half == 0) { d.n0 = 32 * nb; d.WT = (unsigned char*)(F.WIN + (size_t)l * INC * D); } else { d.n0 = 3072 + 32 * nb; d.WT = F.WIN8 + (size_t)l * 3072 * D; d.fp8 = 1; }
        return d; } r -= N_IN;
    if (r < N_BR) { const int lk = r / I_BR, l = lk >> 1, k = (lk & 1) * 2, q = r % I_BR, kb = q / 32, nb = q % 32;
        d.W = a.w_branch + ((size_t)(l * 3 + k) * 512) * D; d.ldw = D; d.k0 = 64 * kb; d.n0 = 32 * nb; d.WT = (unsigned char*)(F.WBR + (size_t)l * D * BRP); d.ldwt = BRP; d.drow0 = 32 * nb; d.dcol0 = k == 0 ? 0 : 1536; return d; } r -= N_BR;
    if (r < N_OUT) { const int l = r / I_OUT, q = r % I_OUT, kb = q / 32, nb = q % 32;
        d.W = a.w_out + (size_t)l * D * D; d.ldw = D; d.k0 = 64 * kb; d.n0 = 32 * nb; d.WT = (unsigned char*)(F.WOUT + (size_t)l * D * D); d.ldwt = D; d.drow0 = 32 * nb; return d; } r -= N_OUT;
    if (r < N_GU) { const int j = r / I_GU, q = r % I_GU, kb = q / 192, nb = q % 192;
        d.W = a.ffn_w_gu + (size_t)j * D * 2 * DFF; d.ldw = 2 * DFF; d.k0 = 64 * kb; d.n0 = 32 * nb; d.ks = a.norm_ffn_g + (2 * j) * D; d.WT = (unsigned char*)(F.WGU + (size_t)j * 2 * DFF * D); d.ldwt = D; d.drow0 = gu_row(32 * nb, DFF); return d; } r -= N_GU;
    if (r < N_DN) { const int j = r / I_DN, q = r % I_DN, kb = q / 32, nb = q % 32;
        d.W = a.ffn_w_down + (size_t)j * DFF * D; d.ldw = D; d.k0 = 64 * kb; d.n0 = 32 * nb; d.WT = (unsigned char*)F.WDN + (size_t)j * D * DFF; d.ldwt = DFF; d.drow0 = 32 * nb; d.fp8 = 1; return d; } r -= N_DN;
    if (r < N_MGU) { const int je = r / I_MGU, j = je >> 3, q = r % I_MGU, kb = q / 96, nb = q % 96;
        d.W = a.moe_w_gu + (size_t)je * D * 2 * DFE; d.ldw = 2 * DFE; d.k0 = 64 * kb; d.n0 = 32 * nb; d.ks = a.norm_ffn_g + (2 * j + 1) * D; d.WT = (unsigned char*)(F.MGU + (size_t)je * 2 * DFE * D); d.ldwt = D; d.drow0 = gu_row(32 * nb, DFE); return d; } r -= N_MGU;
    { const int je = r / I_MDN, q = r % I_MDN, kb = q / 32, nb = q % 32;
        d.W = a.moe_w_down + (size_t)je * DFE * D; d.ldw = D; d.k0 = 64 * kb; d.n0 = 32 * nb; d.WT = (unsigned char*)F.MDN + (size_t)je * D * DFE; d.ldwt = DFE; d.drow0 = 32 * nb; d.fp8 = 1; return d; }
}
__device__ __forceinline__ void p0_prologue(Frame& F, const Args& a_unused) {
    LAS float* scr = (LAS float*)(F.lds + F.wave * 16384);
    const int gw = F.vcu * NWAVES + F.wave, NGW = F.G * NWAVES, lane = F.lane;
    if (gw < NITEMS) {
        TrDesc dc = tr_decode(F, gw); float tv[32], kv[32];
        tr_load(dc, tv, kv, lane);
        for (int it = gw;;) {
            const int itn = it + NGW; const bool has = itn < NITEMS;
            TrDesc dn = dc; float tn[32], kn[32];
            if (has) { dn = tr_decode(F, itn); tr_load(dn, tn, kn, lane); }
            tr_store(dc, tv, kv, scr, lane);
            if (!has) break;
            dc = dn; it = itn;
#pragma unroll
            for (int i = 0; i < 32; ++i) { tv[i] = tn[i]; kv[i] = kn[i]; }
        }
    }
    const Args& a = fresh_args();
    {
        float sv, cv; sincospif((float)lane * (1.0f / 32.0f), &sv, &cv); const float ctab = cv * 0.125f, stab = sv * 0.125f;
        for (int it = (gw & 3) ? 512 : (gw >> 2); it < 4 * 8 * 16; it += NGW) {
            const int l = it >> 7, g = (it >> 4) & 7, db = it & 15, d = db * 64 + lane;
            const float* wsrc = a.w_branch + ((size_t)(l * 3 + 1) * 512 + g * 64) * D + d;
            float w[64];
#pragma unroll
            for (int c = 0; c < 64; ++c) w[c] = wsrc[(size_t)c * D];
            bf16* dst = F.WBR + (size_t)l * D * BRP + (size_t)d * BRP + 512 + g * 64;
            for (int j = 0; j < 64; ++j) {
                float ac = 0.f, as = 0.f;
#pragma unroll
                for (int c = 0; c < 64; ++c) { const int mi = (j * c) & 63; ac += __uint_as_float((unsigned)__builtin_amdgcn_readlane((int)__float_as_uint(ctab), mi)) * w[c]; as += __uint_as_float((unsigned)__builtin_amdgcn_readlane((int)__float_as_uint(stab), mi)) * w[c]; }
                dst[j] = (bf16)(pk2(ac, 0.f) & 0xffffu); dst[512 + j] = (bf16)(pk2(as, 0.f) & 0xffffu);
            }
        }
    }
    const int gt = F.vcu * 512 + F.tid, NGT = F.G * 512;
    for (int o = gt; o < 4 * 8 * 4 * 4096; o += NGT) {
        const int in = o & 63, out = (o >> 6) & 63, mat = (o >> 12) & 3, n = (o >> 14) & 7, l = o >> 17, dir = mat >> 1;
        const float* src = (mat & 1) ? a.lru_wx : a.lru_wa;
        F.WL[o] = (bf16)(pk2(src[((((size_t)(l * 2 + dir) * 8 + n) * 64 + in) * 64) + out], 0.f) & 0xffffu);
    }
    for (int o = gt; o < 4096 + 2048; o += NGT) { u32x4* dst = (u32x4*)(F.GW) + 12288; if (o < 4096) dst[o] = dft_table_entry<0>(o); else dst[o] = dft_table_entry<1>(o - 4096); }
    for (int o = gt; o < 4 * 2 * 512; o += NGT) { const float lam = a.lru_lambda[o]; F.NSP[o] = -8.0f * log1pf(expf(-lam)); }
    for (int o = gt; o < 2 * 1024 * 8; o += NGT) { const int j = o >> 13, k = (o >> 3) & 1023; F.GW[o] = a.norm_ffn_g[(2 * j + 1) * D + k] * a.router_w[o]; }
    for (int m = gw; m < M; m += NGW) {
        const f32x4* xr = (const f32x4*)(a.x + (size_t)m * D) + lane; f32x4 v[4]; float s = 0.f;
#pragma unroll
        for (int j = 0; j < 4; ++j) { v[j] = xr[64 * j]; s += (v[j][0] * v[j][0] + v[j][1] * v[j][1]) + (v[j][2] * v[j][2] + v[j][3] * v[j][3]); }
        s = wave_sum(s);
        u32x2* o8 = (u32x2*)(F.HB + (size_t)m * D) + lane;
#pragma unroll
        for (int j = 0; j < 4; ++j) { u32x2 w; w.x = pk2(v[j][0], v[j][1]); w.y = pk2(v[j][2], v[j][3]); o8[64 * j] = w; }
        { unsigned* q8 = (unsigned*)(F.HB8 + (size_t)m * D) + lane;
#pragma unroll
          for (int j = 0; j < 4; ++j) q8[64 * j] = pk4_fp8(v[j][0], v[j][1], v[j][2], v[j][3]); }
        if (lane == 0) F.RS[m] = (unsigned long long)(s * RS_SCALE);
    }
}

__device__ __forceinline__ f32x4 mfma16(bf16x8 a, bf16x8 b, f32x4 c) { return __builtin_amdgcn_mfma_f32_16x16x32_bf16(a, b, c, 0, 0, 0); }
__device__ __forceinline__ bf16x8 tr_frag(const LAS unsigned char* p0, const LAS unsigned char* p1) {
    const s16x4 lo = __builtin_bit_cast(s16x4, __builtin_amdgcn_ds_read_tr16_b64_v4i16((LAS s16x4*)p0));
    const s16x4 hi = __builtin_bit_cast(s16x4, __builtin_amdgcn_ds_read_tr16_b64_v4i16((LAS s16x4*)p1));
    bf16x8 r; r[0] = lo[0]; r[1] = lo[1]; r[2] = lo[2]; r[3] = lo[3]; r[4] = hi[0]; r[5] = hi[1]; r[6] = hi[2]; r[7] = hi[3]; return r;
}
constexpr int AT_V1 = 65536, AT_RPB = 131072;
struct AttnK { bf16x8 q0, q1; bf16x8 kf[8][2][2]; };
__device__ __forceinline__ void attn_load_k(AttnK& K, const bf16* __restrict__ PROJ, int b, int r, int h, int j, int lane) {
    const int fr = lane & 15, rq = lane >> 4;
    const int rs = min(max(r - 4, 0), 120);
    const int cb = (j == 0) ? 0 : (j == 1) ? 8 : (j == 2) ? 24 : 32;
    const size_t tq = (size_t)b * SEQ + 64 * r + 16 * j + fr;
    const bf16* qp = PROJ + tq * PPITCH + C_Q + h * 64 + 16 * rq;
    K.q0 = *(const bf16x8*)qp; K.q1 = *(const bf16x8*)(qp + 8);
    const bf16* kbase = PROJ + ((size_t)b * SEQ + 64 * rs + cb + fr) * PPITCH + C_K + h * 64 + 16 * rq;
#pragma unroll
    for (int ir = 0; ir < 8; ++ir)
#pragma unroll
        for (int hf = 0; hf < 2; ++hf) {
            const bf16* kp = kbase + (size_t)(64 * ir + 16 * hf) * PPITCH;
            K.kf[ir][hf][0] = *(const bf16x8*)kp; K.kf[ir][hf][1] = *(const bf16x8*)(kp + 8);
        }
}
__device__ __forceinline__ void attn_compute(const AttnK& K, const LAS unsigned char* vt, const LAS float* rpb, bf16* __restrict__ BR, int b, int r, int h, int j, int lane) {
    const int fr = lane & 15, rq = lane >> 4;
    const int rs = min(max(r - 4, 0), 120);
    const int cb = (j == 0) ? 0 : (j == 1) ? 8 : (j == 2) ? 24 : 32;
    const size_t tq = (size_t)b * SEQ + 64 * r + 16 * j + fr;
    f32x4 S[8][2];
#pragma unroll
    for (int ir = 0; ir < 8; ++ir)
#pragma unroll
        for (int hf = 0; hf < 2; ++hf) {
            f32x4 s = {0.f, 0.f, 0.f, 0.f};
            s = mfma16(K.kf[ir][hf][0], K.q0, s); s = mfma16(K.kf[ir][hf][1], K.q1, s);
            S[ir][hf] = s;
        }
    const int c = 16 * j + fr, cs = min(max(c - 8, 0), 48);
    float mx = -1e30f;
#pragma unroll
    for (int ir = 0; ir < 8; ++ir) {
        const LAS float* brow = rpb + (rs + ir - r + 7) * 31;
#pragma unroll
        for (int hf = 0; hf < 2; ++hf)
#pragma unroll
            for (int i = 0; i < 4; ++i) {
                const int kc = cb + 16 * hf + 4 * rq + i; const bool valid = (kc >= cs) && (kc < cs + 16);
                const int bi = min(max(kc - c + 15, 0), 30);
                const float sv = valid ? S[ir][hf][i] + brow[bi] : -1e30f;
                S[ir][hf][i] = sv; mx = fmaxf(mx, sv);
            }
    }
    mx = fmaxf(mx, __shfl_xor(mx, 16)); mx = fmaxf(mx, __shfl_xor(mx, 32));
    float sum = 0.f;
#pragma unroll
    for (int ir = 0; ir < 8; ++ir)
#pragma unroll
        for (int hf = 0; hf < 2; ++hf)
#pragma unroll
            for (int i = 0; i < 4; ++i) { const float p = __builtin_amdgcn_exp2f((S[ir][hf][i] - mx) * 1.44269504f); S[ir][hf][i] = p; sum += p; }
    sum += __shfl_xor(sum, 16); sum += __shfl_xor(sum, 32);
    f32x4 O[4];
#pragma unroll
    for (int d = 0; d < 4; ++d) O[d] = (f32x4){0.f, 0.f, 0.f, 0.f};
    const int q4 = (lane & 15) >> 2, p4 = lane & 3;
    const LAS unsigned char* vb = vt + (cb + 4 * rq + q4) * 128 + 8 * p4;
#pragma unroll
    for (int ir = 0; ir < 8; ++ir) {
        u32x4 pw; pw.x = pk2(S[ir][0][0], S[ir][0][1]); pw.y = pk2(S[ir][0][2], S[ir][0][3]); pw.z = pk2(S[ir][1][0], S[ir][1][1]); pw.w = pk2(S[ir][1][2], S[ir][1][3]);
        const bf16x8 Bp = __builtin_bit_cast(bf16x8, pw);
#pragma unroll
        for (int d = 0; d < 4; ++d) {
            const LAS unsigned char* p0 = vb + (64 * ir) * 128 + 32 * d;
            O[d] = mfma16(tr_frag(p0, p0 + 16 * 128), Bp, O[d]);
        }
    }
    const float inv = 1.0f / sum;
#pragma unroll
    for (int dp = 0; dp < 2; ++dp) { u32x2 w[2];
#pragma unroll
        for (int hh = 0; hh < 2; ++hh) { const int d = 2 * dp + hh; w[hh].x = pk2(O[d][0] * inv, O[d][1] * inv); w[hh].y = pk2(O[d][2] * inv, O[d][3] * inv); }
        *(u32x4*)(BR + tq * BRP + h * 64 + 32 * dp + 16 * (rq & 1) + 4 * (rq & ~1)) = pair16(w[0], w[1]); }
}
constexpr int XP = 544;
constexpr int FX_OFF = 0, FT_OFF = 128 * XP;
template <int NMT, int NNT>
__device__ __forceinline__ void dft_core(const LAS unsigned char* xl, const LAS unsigned char* tl, int wm, int cbase, int lane, f32x4 (&acc)[2][NMT][NNT]) {
#pragma unroll
    for (int p = 0; p < 2; ++p)
#pragma unroll
        for (int m = 0; m < NMT; ++m)
#pragma unroll
            for (int n = 0; n < NNT; ++n) acc[p][m][n] = (f32x4){0.f, 0.f, 0.f, 0.f};
    const int g = lane >> 4, q = (lane & 15) >> 2, p4 = lane & 3;
#pragma unroll 1
    for (int ks = 0; ks < 4; ++ks) {
        bf16x8 Bf[NNT];
#pragma unroll
        for (int n = 0; n < NNT; ++n) {
            const LAS unsigned char* p0 = xl + (32 * ks + 8 * g + q) * XP + (cbase + 16 * n + 4 * p4) * 2;
            Bf[n] = tr_frag(p0, p0 + 4 * XP);
        }
#pragma unroll
        for (int p = 0; p < 2; ++p)
#pragma unroll
            for (int m = 0; m < NMT; ++m) {
                const int tile = p * (2 * NMT) + wm * NMT + m;
                const bf16x8 Af = *(const LAS bf16x8*)(tl + ((tile * 4 + ks) * 64 + lane) * 16);
#pragma unroll
                for (int n = 0; n < NNT; ++n) acc[p][m][n] = mfma16(Bf[n], Af, acc[p][m][n]);
            }
    }
}
__device__ __forceinline__ void dft_load_x(Frame& F, const bf16* src, size_t rstride) {
    const int chunk = F.tid & 31, row0 = F.tid >> 5;
    u32x4 v[8];
#pragma unroll
    for (int it = 0; it < 8; ++it) v[it] = *(const u32x4*)(src + (size_t)(row0 + 16 * it) * rstride + chunk * 8);
#pragma unroll
    for (int it = 0; it < 8; ++it) *(LAS u32x4*)(F.lds + FX_OFF + (row0 + 16 * it) * XP + chunk * 16) = v[it];
}
template <int STEP>
__device__ __forceinline__ u32x4 dft_table_entry(int idx) {
    const int tile = idx >> 8, ks = (idx >> 6) & 3, ln = idx & 63;
    float v[8];
#pragma unroll
    for (int j = 0; j < 8; ++j) {
        const int k = 32 * ks + 8 * (ln >> 4) + j; float sv, cv;
        if (STEP == 0) { const int part = tile >> 3, prow = (tile & 7) * 16 + (ln & 15); const int mi = (prow * k) & 127; sincospif((float)mi * (1.0f / 64.0f), &sv, &cv);
            v[j] = (part == 0 ? cv : -sv) * 0.08838834764831845f; }
        else { const int part = tile >> 2, prow = (tile & 3) * 16 + (ln & 15), pin = k >> 6, n2 = k & 63; const int mi = (prow * n2) & 63; sincospif((float)mi * (1.0f / 32.0f), &sv, &cv);
            v[j] = (part == 0 ? (pin == 0 ? cv : sv) : (pin == 0 ? -sv : cv)) * 0.125f; }
    }
    u32x4 w; w.x = pk2(v[0], v[1]); w.y = pk2(v[2], v[3]); w.z = pk2(v[4], v[5]); w.w = pk2(v[6], v[7]);
    return w;
}
template <int STEP>
__device__ __forceinline__ void dft_fill_table(Frame& F) {
    constexpr int NE = (STEP == 0 ? 16 : 8) * 256;
    const u32x4* src = (const u32x4*)(F.GW) + (STEP == 0 ? 12288 : 16384);
#pragma unroll
    for (int it = 0; it < NE / 512; ++it) { const int idx = F.tid + 512 * it; *(LAS u32x4*)(F.lds + FT_OFF + idx * 16) = src[idx]; }
}
__device__ __forceinline__ void fft_a_unit(Frame& F, int unit) {
    const int b = unit >> 7, n2 = (unit >> 1) & 63, chh = unit & 1, lane = F.lane, wm = F.wave >> 2, wn = F.wave & 3, rq = lane >> 4;
    dft_load_x(F, F.PROJ + ((size_t)b * SEQ + n2) * PPITCH + C_UF + 256 * chh, (size_t)64 * PPITCH);
    LDS_WAIT(); __syncthreads();
#pragma unroll 1
    for (int cp = 0; cp < 2; ++cp) {
    f32x4 acc[2][4][2];
    dft_core<4, 2>(F.lds + FX_OFF, F.lds + FT_OFF, wm, 64 * wn + 32 * cp, lane, acc);
#pragma unroll
    for (int m = 0; m < 4; ++m) {
        const int k1 = 64 * wm + 16 * m + (lane & 15); float sv, cv; sincospif((float)(n2 * k1) * (1.0f / 4096.0f), &sv, &cv);
        u32x2 wre[2], wim[2];
#pragma unroll
        for (int n = 0; n < 2; ++n) {
            float re[4], im[4];
#pragma unroll
            for (int i = 0; i < 4; ++i) { const float tr = acc[0][m][n][i], ti = acc[1][m][n][i]; re[i] = tr * cv + ti * sv; im[i] = ti * cv - tr * sv; }
            wre[n].x = pk2(re[0], re[1]); wre[n].y = pk2(re[2], re[3]); wim[n].x = pk2(im[0], im[1]); wim[n].y = pk2(im[2], im[3]);
        }
        bf16* o0 = F.TP + ((((size_t)(b * 128 + k1) * 2 + 0) * 64 + n2) * 512) + 256 * chh + 64 * wn + 32 * cp + 16 * (rq & 1) + 4 * (rq & ~1);
        *(u32x4*)o0 = pair16(wre[0], wre[1]);
        *(u32x4*)(o0 + 64 * 512) = pair16(wim[0], wim[1]);
    }
    }
    __syncthreads();
}
__device__ __forceinline__ void fft_c_unit(Frame& F, int unit) {
    const int b = unit >> 8, k1 = (unit >> 1) & 127, chh = unit & 1, lane = F.lane, wm = F.wave >> 2, wn = F.wave & 3, rq = lane >> 4;
    dft_load_x(F, F.TP + ((size_t)(b * 128 + k1) * 128) * 512 + 256 * chh, (size_t)512);
    LDS_WAIT(); __syncthreads();
    f32x4 acc[2][2][4];
    dft_core<2, 4>(F.lds + FX_OFF, F.lds + FT_OFF, wm, 64 * wn, lane, acc);
#pragma unroll
    for (int p = 0; p < 2; ++p)
#pragma unroll
        for (int m = 0; m < 2; ++m) {
            const int k2 = 32 * wm + 16 * m + (lane & 15);
            bf16* o0 = F.BR + ((size_t)b * SEQ + k1 + 128 * k2) * BRP + 512 + p * 512 + 256 * chh + 64 * wn + 16 * (rq & 1) + 4 * (rq & ~1);
#pragma unroll
            for (int np = 0; np < 2; ++np) {
                u32x2 w[2];
#pragma unroll
                for (int h = 0; h < 2; ++h) { w[h].x = pk2(acc[p][m][2 * np + h][0], acc[p][m][2 * np + h][1]); w[h].y = pk2(acc[p][m][2 * np + h][2], acc[p][m][2 * np + h][3]); }
                *(u32x4*)(o0 + 32 * np) = pair16(w[0], w[1]);
            }
        }
    __syncthreads();
}

template <bool REV, bool FULL>
__device__ __forceinline__ void lru_scan(const f32x4 (&a)[4], const f32x4 (&bt)[4], float carry_in, f32x4 (&h)[4], f32x4 (&P)[4], float& Atot, float& Btot, int lane) {
    const int rq = lane >> 4, fr = lane & 15;
    float carry = carry_in, At = 1.f;
#pragma unroll
    for (int mm = 0; mm < 4; ++mm) {
        const int mt = REV ? 3 - mm : mm;
        float hl[4], cA[4];
        if (!REV) { hl[0] = bt[mt][0]; cA[0] = a[mt][0];
#pragma unroll
            for (int i = 1; i < 4; ++i) { hl[i] = a[mt][i] * hl[i - 1] + bt[mt][i]; cA[i] = a[mt][i] * cA[i - 1]; } }
        else { hl[3] = bt[mt][3]; cA[3] = a[mt][3];
#pragma unroll
            for (int i = 2; i >= 0; --i) { hl[i] = a[mt][i] * hl[i + 1] + bt[mt][i]; cA[i] = a[mt][i] * cA[i + 1]; } }
        float SA = REV ? cA[0] : cA[3], SB = REV ? hl[0] : hl[3];
        float pA, pB;
        if (!REV) {
            pA = __shfl_up(SA, 16); pB = __shfl_up(SB, 16); if (rq >= 1) { SB = SA * pB + SB; SA = SA * pA; }
            pA = __shfl_up(SA, 32); pB = __shfl_up(SB, 32); if (rq >= 2) { SB = SA * pB + SB; SA = SA * pA; }
        } else {
            pA = __shfl_down(SA, 16); pB = __shfl_down(SB, 16); if (rq <= 2) { SB = SA * pB + SB; SA = SA * pA; }
            pA = __shfl_down(SA, 32); pB = __shfl_down(SB, 32); if (rq <= 1) { SB = SA * pB + SB; SA = SA * pA; }
        }
        float eA, eB;
        if (!REV) { eA = __shfl_up(SA, 16); eB = __shfl_up(SB, 16); if (rq == 0) { eA = 1.f; eB = 0.f; } }
        else { eA = __shfl_down(SA, 16); eB = __shfl_down(SB, 16); if (rq == 3) { eA = 1.f; eB = 0.f; } }
        const float tA = __shfl(SA, REV ? fr : 48 + fr), tB = __shfl(SB, REV ? fr : 48 + fr);
        if (FULL) { const float hs = eA * carry + eB, pe = eA * At;
#pragma unroll
            for (int i = 0; i < 4; ++i) { h[mt][i] += hl[i] + cA[i] * hs; P[mt][i] = cA[i] * pe; } }
        carry = tA * carry + tB; At *= tA;
        __builtin_amdgcn_sched_barrier(0);
    }
    Atot = At; Btot = carry;
}
template <int PASS>
__device__ __forceinline__ void lru_unit(Frame& F, const Args& a, int l, int b, int r) {
    const int w = F.wave, ch0 = 64 * w;
    LAS float* carry_lds = (LAS float*)(F.lds);
    if (PASS == 2) {
        const int ch = F.wave * 64 + lane_id(); float hf = 0.f, hb = 0.f;
        const f32x2* sf = F.LSUM + ((size_t)(0 * 2 + b) * 128) * 512 + ch; const f32x2* sb = F.LSUM + ((size_t)(1 * 2 + b) * 128) * 512 + ch;
        for (int r0 = 0; r0 < r; r0 += 32) {
            f32x2 sv[32];
#pragma unroll
            for (int k = 0; k < 32; ++k) sv[k] = sf[(size_t)min(r0 + k, 127) * 512];
#pragma unroll
            for (int k = 0; k < 32; ++k) if (r0 + k < r) hf = sv[k].x * hf + sv[k].y;
        }
        for (int r0 = 127; r0 > r; r0 -= 32) {
            f32x2 sv[32];
#pragma unroll
            for (int k = 0; k < 32; ++k) sv[k] = sb[(size_t)max(r0 - k, 0) * 512];
#pragma unroll
            for (int k = 0; k < 32; ++k) if (r0 - k > r) hb = sv[k].x * hb + sv[k].y;
        }
        carry_lds[ch] = hf; carry_lds[512 + ch] = hb;
        LDS_WAIT(); __syncthreads();
    }
    const int lane = lane_id(), fr = lane & 15, rq = lane >> 4;
    if constexpr (PASS == 2) {
#pragma unroll 1
        for (int nt = 0; nt < 4; ++nt) {
            const int ch = ch0 + 16 * nt + fr;
            const size_t sb = ((size_t)((b * 128 + r) * 8 + w) * 4 + nt);
            const u32x4* ph = F.LSTH + sb * 128 + lane; const u32x4* pp = F.LSTP + sb * 256 + lane;
            u32x4 hv[2], pf[2], pb[2];
#pragma unroll
            for (int hh = 0; hh < 2; ++hh) { hv[hh] = ph[64 * hh]; pf[hh] = pp[64 * hh]; pb[hh] = pp[128 + 64 * hh]; }
            unsigned short ggv[4][4];
#pragma unroll
            for (int mt = 0; mt < 4; ++mt)
#pragma unroll
                for (int i = 0; i < 4; ++i) ggv[mt][i] = F.PROJ[((size_t)b * SEQ + 64 * r + 16 * mt + 4 * rq + i) * PPITCH + C_UG + ch];
            const float cf = carry_lds[ch], cb = carry_lds[512 + ch];
#pragma unroll
            for (int mt = 0; mt < 4; ++mt)
#pragma unroll
                for (int i = 0; i < 4; ++i) {
                    const int hh = mt >> 1, dwi = (mt & 1) * 2 + (i >> 1);
                    const unsigned hw = hv[hh][dwi], fw = pf[hh][dwi], bw = pb[hh][dwi];
                    const float hval = (i & 1) ? bfhi(hw) : bflo(hw), fval = (i & 1) ? bfhi(fw) : bflo(fw), bval = (i & 1) ? bfhi(bw) : bflo(bw);
                    const size_t tok = (size_t)b * SEQ + 64 * r + 16 * mt + 4 * rq + i;
                    F.BR[tok * BRP + 1536 + ch] = (bf16)(pk2((hval + fval * cf + bval * cb) * bf2f(ggv[mt][i]), 0.f) & 0xffffu);
                }
        }
        __syncthreads();
        return;
    }
    bf16x8 Af[4][2];
#pragma unroll
    for (int ks = 0; ks < 2; ++ks) {
        const int chA = ch0 + 32 * ks + 8 * rq;
        float cw[4][8], cbv[8];
#pragma unroll
        for (int t = 0; t < 4; ++t) { const f32x4 w0 = *(const f32x4*)(a.conv_w + ((size_t)l * 4 + t) * 512 + chA), w1 = *(const f32x4*)(a.conv_w + ((size_t)l * 4 + t) * 512 + chA + 4);
            cw[t][0] = w0[0]; cw[t][1] = w0[1]; cw[t][2] = w0[2]; cw[t][3] = w0[3]; cw[t][4] = w1[0]; cw[t][5] = w1[1]; cw[t][6] = w1[2]; cw[t][7] = w1[3]; }
        { const f32x4 b0 = *(const f32x4*)(a.conv_b + (size_t)l * 512 + chA), b1 = *(const f32x4*)(a.conv_b + (size_t)l * 512 + chA + 4);
            cbv[0] = b0[0]; cbv[1] = b0[1]; cbv[2] = b0[2]; cbv[3] = b0[3]; cbv[4] = b1[0]; cbv[5] = b1[1]; cbv[6] = b1[2]; cbv[7] = b1[3]; }
#pragma unroll
        for (int mt = 0; mt < 4; ++mt) {
            const int s = 64 * r + 16 * mt + fr;
            float c8[8];
#pragma unroll
            for (int e = 0; e < 8; ++e) c8[e] = cbv[e];
#pragma unroll
            for (int t = 0; t < 4; ++t) {
                const int sp = s + t - 2;
                if (sp >= 0 && sp < SEQ) {
                    const u32x4 uv = *(const u32x4*)(F.PROJ + ((size_t)b * SEQ + sp) * PPITCH + C_UX + chA);
                    c8[0] += cw[t][0] * bflo(uv.x); c8[1] += cw[t][1] * bfhi(uv.x); c8[2] += cw[t][2] * bflo(uv.y); c8[3] += cw[t][3] * bfhi(uv.y);
                    c8[4] += cw[t][4] * bflo(uv.z); c8[5] += cw[t][5] * bfhi(uv.z); c8[6] += cw[t][6] * bflo(uv.w); c8[7] += cw[t][7] * bfhi(uv.w);
                }
            }
            u32x4 pw; pw.x = pk2(c8[0], c8[1]); pw.y = pk2(c8[2], c8[3]); pw.z = pk2(c8[4], c8[5]); pw.w = pk2(c8[6], c8[7]);
            Af[mt][ks] = __builtin_bit_cast(bf16x8, pw);
            __builtin_amdgcn_sched_barrier(0);
        }
    }
    const bf16* WLb = F.WL + ((size_t)(l * 8 + w) * 4) * 4096;
#pragma unroll 1
    for (int nt = 0; nt < 4; ++nt) {
        const int ch = ch0 + 16 * nt + fr;
        f32x4 cD[4];
#pragma unroll
        for (int mt = 0; mt < 4; ++mt) cD[mt] = (f32x4){0.f, 0.f, 0.f, 0.f};
#pragma unroll
        for (int ks = 0; ks < 2; ++ks) {
            bf16x8 I8;
#pragma unroll
            for (int j = 0; j < 8; ++j) I8[j] = (32 * ks + 8 * rq + j == 16 * nt + fr) ? (short)0x3F80 : (short)0;
#pragma unroll
            for (int mt = 0; mt < 4; ++mt) cD[mt] = mfma16(Af[mt][ks], I8, cD[mt]);
        }
        f32x4 hsum[4];
#pragma unroll
        for (int mt = 0; mt < 4; ++mt) hsum[mt] = (f32x4){0.f, 0.f, 0.f, 0.f};
        bf16x8 Bw[2][2][2];
#pragma unroll
        for (int dir = 0; dir < 2; ++dir)
#pragma unroll
            for (int mat = 0; mat < 2; ++mat)
#pragma unroll
                for (int ks = 0; ks < 2; ++ks) Bw[dir][mat][ks] = *(const bf16x8*)(WLb + (size_t)(2 * dir + mat) * 4096 + (16 * nt + fr) * 64 + 32 * ks + 8 * rq);
        float pba[2], pbx[2], pns[2];
#pragma unroll
        for (int dir = 0; dir < 2; ++dir) { pba[dir] = -1.44269504f * a.lru_ba[(size_t)(l * 2 + dir) * 512 + ch]; pbx[dir] = -1.44269504f * a.lru_bx[(size_t)(l * 2 + dir) * 512 + ch]; pns[dir] = 1.44269504f * F.NSP[(l * 2 + dir) * 512 + ch]; }
#pragma unroll
        for (int dir = 0; dir < 2; ++dir) {
            __builtin_amdgcn_sched_barrier(0);
            f32x4 xa[4], xx[4];
#pragma unroll
            for (int mt = 0; mt < 4; ++mt) { xa[mt] = (f32x4){0.f, 0.f, 0.f, 0.f}; xx[mt] = (f32x4){0.f, 0.f, 0.f, 0.f}; }
#pragma unroll
            for (int ks = 0; ks < 2; ++ks) {
#pragma unroll
                for (int mt = 0; mt < 4; ++mt) { xa[mt] = mfma16(Af[mt][ks], Bw[dir][0][ks], xa[mt]); xx[mt] = mfma16(Af[mt][ks], Bw[dir][1][ks], xx[mt]); }
            }
            const float ba = pba[dir], bx = pbx[dir], ns = pns[dir];
            f32x4 av[4], bt[4]; float igc_first = 0.f, igc_last = 0.f;
#pragma unroll
            for (int mt = 0; mt < 4; ++mt)
#pragma unroll
                for (int i = 0; i < 4; ++i) {
                    const float rg = __builtin_amdgcn_rcpf(1.0f + __builtin_amdgcn_exp2f(__builtin_fmaf(xa[mt][i], -1.44269504f, ba)));
                    const float ig = __builtin_amdgcn_rcpf(1.0f + __builtin_amdgcn_exp2f(__builtin_fmaf(xx[mt][i], -1.44269504f, bx)));
                    const float aa = __builtin_amdgcn_exp2f(ns * rg);
                    const float mult = __builtin_amdgcn_sqrtf(fmaxf(__builtin_fmaf(-aa, aa, 1.0f), 0.f));
                    const float igc = ig * cD[mt][i];
                    if (mt == 0 && i == 0) igc_first = igc;
                    if (mt == 3 && i == 3) igc_last = igc;
                    av[mt][i] = aa; bt[mt][i] = mult * igc;
                    if (i == 3) __builtin_amdgcn_sched_barrier(0);
                }
            if (dir == 0) { if (r == 0 && rq == 0) bt[0][0] = igc_first; }
            else { if (r == 127 && rq == 3) bt[3][3] = igc_last; }
            float At, Bt; f32x4 Pd[4];
            if (dir == 0) lru_scan<false, true>(av, bt, 0.f, hsum, Pd, At, Bt, lane); else lru_scan<true, true>(av, bt, 0.f, hsum, Pd, At, Bt, lane);
            if (rq == 0) { f32x2 sm; sm.x = At; sm.y = Bt; F.LSUM[((size_t)(dir * 2 + b) * 128 + r) * 512 + ch] = sm; }
            { u32x4* pp = F.LSTP + ((size_t)((b * 128 + r) * 8 + w) * 4 + nt) * 256 + dir * 128 + lane;
#pragma unroll
              for (int hh = 0; hh < 2; ++hh) { u32x4 o; o.x = pk2(Pd[2 * hh][0], Pd[2 * hh][1]); o.y = pk2(Pd[2 * hh][2], Pd[2 * hh][3]); o.z = pk2(Pd[2 * hh + 1][0], Pd[2 * hh + 1][1]); o.w = pk2(Pd[2 * hh + 1][2], Pd[2 * hh + 1][3]); pp[64 * hh] = o; } }

        }
        { u32x4* ph = F.LSTH + ((size_t)((b * 128 + r) * 8 + w) * 4 + nt) * 128 + lane;
#pragma unroll
          for (int hh = 0; hh < 2; ++hh) { u32x4 o; o.x = pk2(hsum[2 * hh][0], hsum[2 * hh][1]); o.y = pk2(hsum[2 * hh][2], hsum[2 * hh][3]); o.z = pk2(hsum[2 * hh + 1][0], hsum[2 * hh + 1][1]); o.w = pk2(hsum[2 * hh + 1][2], hsum[2 * hh + 1][3]); ph[64 * hh] = o; } }
    }
}

__device__ __forceinline__ void moe_router(Frame& F, int jm, const unsigned long long* rs) {
    const int gw = F.vcu * NWAVES + F.wave, NGW = F.G * NWAVES, lane = F.lane;
    const float* GWj = F.GW + (size_t)jm * 1024 * 8;
    unsigned* cnt = F.ctl + CW_MOE + jm * 8 * 64;
    LAS float* gwt = (LAS float*)F.lds;
    for (int i = F.tid; i < 1024 * 8; i += 512) gwt[(i & 7) * 1024 + (i >> 3)] = GWj[i];
    LDS_WAIT(); __syncthreads();
    for (int t = gw; t < M; t += NGW) {
        const u32x2* hr = (const u32x2*)(F.HB + (size_t)t * D) + lane;
        float lg[8];
#pragma unroll
        for (int e = 0; e < 8; ++e) lg[e] = 0.f;
#pragma unroll
        for (int j = 0; j < 4; ++j) {
            const u32x2 hw = hr[64 * j]; const float hv[4] = {bflo(hw.x), bfhi(hw.x), bflo(hw.y), bfhi(hw.y)}; const int k0 = 4 * lane + 256 * j;
#pragma unroll
            for (int e = 0; e < 8; ++e) { const f32x4 g = *(const LAS f32x4*)(gwt + e * 1024 + k0); lg[e] += (hv[0] * g[0] + hv[1] * g[1]) + (hv[2] * g[2] + hv[3] * g[3]); }
        }
#pragma unroll
        for (int e = 0; e < 8; ++e) lg[e] = wave_sum(lg[e]);
        const float sr = 1.0f / sqrtf((float)rs[t] * (1.0f / (RS_SCALE * D)) + RMS_EPS);
        int e0 = 0; float v0 = lg[0];
#pragma unroll
        for (int e = 1; e < 8; ++e) if (lg[e] > v0) { v0 = lg[e]; e0 = e; }
        int e1 = -1; float v1 = -3.0e38f;
#pragma unroll
        for (int e = 0; e < 8; ++e) if (e != e0 && lg[e] > v1) { v1 = lg[e]; e1 = e; }
        const float w0 = 1.0f / (1.0f + expf((v1 - v0) * sr)), w1 = 1.0f - w0;
        if (lane == 0) {
            const int p0 = (int)atomicAdd(cnt + e0 * 64, 1u), p1 = (int)atomicAdd(cnt + e1 * 64, 1u);
            F.LIST[e0 * 16384 + p0] = t; F.LIST[e1 * 16384 + p1] = t;
            F.SROW[e0 * 16384 + p0] = sr; F.SROW[e1 * 16384 + p1] = sr;
            F.WSLOT[e0 * 16384 + p0] = w0; F.WSLOT[e1 * 16384 + p1] = w1;
            int4 ti; ti.x = e0; ti.y = p0; ti.z = e1; ti.w = p1; ((int4*)F.TOKI)[t] = ti;
        }
    }
    __syncthreads();
}
__device__ __forceinline__ void moe_sched_init(Frame& F, int jm, pg8::SchedMoe& S) {
    const unsigned* cnt = F.ctl + CW_MOE + jm * 8 * 64;
#define RFL(x) __builtin_amdgcn_readfirstlane((int)(x))
    S.cntp = cnt;
    const int c0 = RFL(cnt[0]), c1 = RFL(cnt[64]), c2 = RFL(cnt[128]), c3 = RFL(cnt[192]), c4 = RFL(cnt[256]), c5 = RFL(cnt[320]), c6 = RFL(cnt[384]), c7 = RFL(cnt[448]);
#undef RFL
    S.t1 = (c0 + 255) >> 8; S.t2 = S.t1 + ((c1 + 255) >> 8); S.t3 = S.t2 + ((c2 + 255) >> 8); S.t4 = S.t3 + ((c3 + 255) >> 8);
    S.t5 = S.t4 + ((c4 + 255) >> 8); S.t6 = S.t5 + ((c5 + 255) >> 8); S.t7 = S.t6 + ((c6 + 255) >> 8); S.t8 = S.t7 + ((c7 + 255) >> 8);
}
__device__ __forceinline__ void moe_combine(Frame& F, const Args& a, int jm, unsigned long long* rs_next, bool final_layer) {
    const int gw = F.vcu * NWAVES + F.wave, NGW = F.G * NWAVES, lane = F.lane;
    pg8::SchedMoe S; moe_sched_init(F, jm, S);
    for (int t = gw; t < M; t += NGW) {
        const int4 ti = ((const int4*)F.TOKI)[t];
        const int ta = ti.x == 0 ? 0 : ti.x == 1 ? S.t1 : ti.x == 2 ? S.t2 : ti.x == 3 ? S.t3 : ti.x == 4 ? S.t4 : ti.x == 5 ? S.t5 : ti.x == 6 ? S.t6 : S.t7;
        const int tb = ti.z == 0 ? 0 : ti.z == 1 ? S.t1 : ti.z == 2 ? S.t2 : ti.z == 3 ? S.t3 : ti.z == 4 ? S.t4 : ti.z == 5 ? S.t5 : ti.z == 6 ? S.t6 : S.t7;
        const size_t s0 = (size_t)ta * 256 + ti.y, s1 = (size_t)tb * 256 + ti.w;
        u32x2* hr = (u32x2*)(F.HB + (size_t)t * D) + lane;
        const u32x2* y0 = (const u32x2*)(F.YBUF + s0 * D) + lane; const u32x2* y1 = (const u32x2*)(F.YBUF + s1 * D) + lane;
        f32x4 v[4]; float ss = 0.f;
#pragma unroll
        for (int j = 0; j < 4; ++j) { const u32x2 a0 = y0[64 * j], a1 = y1[64 * j], hw = hr[64 * j]; f32x4 hv;
            hv[0] = bflo(hw.x) + bflo(a0.x) + bflo(a1.x); hv[1] = bfhi(hw.x) + bfhi(a0.x) + bfhi(a1.x); hv[2] = bflo(hw.y) + bflo(a0.y) + bflo(a1.y); hv[3] = bfhi(hw.y) + bfhi(a0.y) + bfhi(a1.y);
            v[j] = hv; ss += (hv[0] * hv[0] + hv[1] * hv[1]) + (hv[2] * hv[2] + hv[3] * hv[3]); }
        ss = wave_sum(ss);
        if (final_layer) {
            const float sr = 1.0f / sqrtf(ss * (1.0f / D) + RMS_EPS);
            f32x4* orow = (f32x4*)(F.H + (size_t)t * D) + lane;
#pragma unroll
            for (int j = 0; j < 4; ++j) { const f32x4 g = *((const f32x4*)a.final_g + lane + 64 * j); orow[64 * j] = v[j] * sr * g; }
        } else {
#pragma unroll
            for (int j = 0; j < 4; ++j) { u32x2 w; w.x = pk2(v[j][0], v[j][1]); w.y = pk2(v[j][2], v[j][3]); hr[64 * j] = w; }
            { unsigned* q8 = (unsigned*)(F.HB8 + (size_t)t * D) + lane;
#pragma unroll
              for (int j = 0; j < 4; ++j) q8[64 * j] = pk4_fp8(v[j][0], v[j][1], v[j][2], v[j][3]); }
            if (lane == 0) rs_next[t] = (unsigned long long)(ss * RS_SCALE);
        }
    }
}

__device__ __forceinline__ Frame mk_frame(const Args& args, LAS unsigned char* ldsp, int wave0) {
    Frame F;
    F.lds = ldsp;
    F.tid = tid_of(wave0); F.lane = F.tid & 63; F.wave = __builtin_amdgcn_readfirstlane(F.tid >> 6);
    F.G = gridDim.x; { const int bx = blockIdx.x; F.vcu = (F.G % 8 == 0) ? (bx % 8) * (F.G / 8) + bx / 8 : bx; }
    size_t zoff = 0; asm volatile("" : "+s"(zoff)); unsigned char* ws = args.ws + zoff; float* outp = args.out + zoff;
    F.ctl = (unsigned*)(ws + WS_CTL); F.H = outp;
    F.HB8 = ws + WS_HB8; F.HB = (bf16*)(ws + WS_HB); F.VT = nullptr; F.WIN8 = ws + WS_WIN8; F.BR = (bf16*)(ws + WS_BR); F.TP = (bf16*)(ws + WS_TP); F.MERGED = (bf16*)(ws + WS_MERGED);
    F.PROJ = (bf16*)(ws + WS_PROJ); F.HID = (bf16*)(ws + WS_HID); F.YBUF = (bf16*)(ws + WS_YBUF);
    F.WIN = (bf16*)(ws + WS_WIN); F.WBR = (bf16*)(ws + WS_WBR); F.WOUT = (bf16*)(ws + WS_WOUT); F.WGU = (bf16*)(ws + WS_WGU); F.WDN = (bf16*)(ws + WS_WDN);
    F.MGU = (bf16*)(ws + WS_MGU); F.MDN = (bf16*)(ws + WS_MDN); F.WL = (bf16*)(ws + WS_WL);
    F.NSP = (float*)(ws + WS_MISC); F.GW = (float*)(ws + WS_MISC + 65536); F.LSUM = (f32x2*)(ws + WS_LSUM); F.LSTH = (u32x4*)(ws + WS_LSTH); F.LSTP = (u32x4*)(ws + WS_LSTP); F.RS = (unsigned long long*)(ws + WS_RS);
    F.LIST = (int*)(ws + WS_MOEI); F.SROW = (float*)(ws + WS_MOEI + 524288); F.WSLOT = (float*)(ws + WS_MOEI + 2 * 524288); F.TOKI = (int*)(ws + WS_MOEI + 3 * 524288);
    return F;
}
__global__ void __launch_bounds__(NWAVES * 64, 2) enc_fwd(Args args) {
    extern __shared__ __attribute__((aligned(16))) unsigned char lds[];
    LAS unsigned char* const ldsp = (LAS unsigned char*)lds;
    volatile LAS unsigned* MISC = (volatile LAS unsigned*)(ldsp + MISC_OFF);
    const int wave0 = __builtin_amdgcn_readfirstlane((int)threadIdx.x >> 6);
    for (int u = wave0 * 64 + lane_id(); u < (LDS_BYTES - MISC_OFF) / 4; u += NWAVES * 64) ((LAS unsigned*)(ldsp + MISC_OFF))[u] = 0u;
    __syncthreads();
    XcdBarrier bar = xcd_barrier_post((unsigned*)(args.ws + WS_CTL) + CW_BAR + args.bar_region * XCD_BAR_WORDS, MISC + 8, wave0);
    const int lo = args.ph_lo, hi = args.ph_hi;
#ifndef PHASE_MASK
#define PHASE_MASK 0xFFFF
#endif
#define PM(k) (((PHASE_MASK) >> (k)) & 1)
#define IN(k) (lo <= (k) && (k) < hi)
#define SEAM(k) do { if (IN(k) && IN((k) + 1)) xcd_barrier(bar, wave0); } while (0)
#define RETID() Frame F = mk_frame(args, ldsp, wave0)

    if (PM(0) && IN(0)) { RETID(); p0_prologue(F, args); }
    SEAM(0);
#pragma unroll 1
    for (int l = 0; l < DEPTH; ++l) {
        const int pb = 1 + 9 * l;
        if (PM(1) && IN(pb + 0)) {
            RETID();
            { pg8::SchedPlain S; S.A = (const char*)F.HB; S.B = (const char*)(F.WIN + (size_t)l * INC * D); S.lda2 = D * 2; S.ldb2 = D * 2; S.nt = D / 64; S.nM = M / 256; S.nN = 12; S.G = F.G; S.c = (int)blockIdx.x;
              pg8::EpiProj<false> E; E.P = F.PROJ; E.VT = F.VT; E.bias = args.b_in + (size_t)l * INC; E.rs = F.RS + (size_t)(2 * l) * M; E.pn_off = 0; E.cs = 1.0f;
              pg8::gemm_phase<pg8::EpiProj<false>, pg8::SchedPlain, true, false>(F.lds, S, E, wave0); }
        }
        if (PM(1) && IN(pb + 0)) {
            RETID();
            { pg8::SchedPlain S; S.A = (const char*)F.HB8; S.B = (const char*)(F.WIN8 + (size_t)l * 3072 * D); S.lda2 = D; S.ldb2 = D; S.nt = D / 128; S.nM = M / 256; S.nN = 12; S.G = F.G; S.c = (int)blockIdx.x;
              pg8::EpiProj<true> E; E.P = F.PROJ; E.VT = F.VT; E.bias = args.b_in + (size_t)l * INC; E.rs = F.RS + (size_t)(2 * l) * M; E.pn_off = 12; E.cs = 1.0f / W8S;
              pg8::gemm_phase<pg8::EpiProj<true>, pg8::SchedPlain, true, false, true>(F.lds, S, E, wave0); }
        }
        SEAM(pb + 0);
        if (PM(2) && IN(pb + 1)) {
            RETID();
#ifndef P2M
#define P2M 7
#endif
            if (P2M & 1) {
            dft_fill_table<0>(F);
            LDS_WAIT(); __syncthreads();
            for (int u = F.vcu; u < 256; u += F.G) fft_a_unit(F, u);
            __syncthreads(); }
            if (P2M & 2) {
            for (int u = F.vcu; u < 256; u += F.G) { const int b = u >> 7, r = u & 127, rs = min(max(r - 4, 0), 120);
#pragma unroll 1
                for (int hp = 0; hp < 4; ++hp) {
                    const int h = 2 * hp + (F.wave >> 2), j = F.wave & 3;
                    AttnK K; attn_load_k(K, F.PROJ, b, r, h, j, F.lane);
                    __syncthreads();
                    { const int chunk = F.tid & 15, t0 = F.tid >> 4;
                      const bf16* vsrc = F.PROJ + ((size_t)b * SEQ + 64 * rs) * PPITCH + C_V + 128 * hp + 8 * chunk;
#pragma unroll 1
                      for (int hh = 0; hh < 2; ++hh) {
                      u32x4 vv[8];
#pragma unroll
                      for (int it = 0; it < 8; ++it) vv[it] = *(const u32x4*)(vsrc + (size_t)(t0 + 32 * (8 * hh + it)) * PPITCH);
#pragma unroll
                      for (int it = 0; it < 8; ++it) *(LAS u32x4*)(F.lds + (chunk >> 3) * AT_V1 + (t0 + 32 * (8 * hh + it)) * 128 + (chunk & 7) * 16) = vv[it];
                      }
                      const float* rp = args.na_rpb + ((size_t)l * 8 + 2 * hp) * 465; LAS float* rl = (LAS float*)(F.lds + AT_RPB);
                      for (int i = F.tid; i < 2 * 465; i += 512) rl[i] = rp[i]; }
                    LDS_WAIT(); __syncthreads();
                    attn_compute(K, F.lds + (F.wave >> 2) * AT_V1, (const LAS float*)(F.lds + AT_RPB) + (F.wave >> 2) * 465, F.BR, b, r, h, j, F.lane);
                } }
            __syncthreads(); }
            if (P2M & 4) for (int u = F.vcu; u < 256; u += F.G) lru_unit<1>(F, args, l, u >> 7, u & 127);
        }
        SEAM(pb + 1);
        if (PM(3) && IN(pb + 2)) {
            RETID();
            dft_fill_table<1>(F);
            LDS_WAIT(); __syncthreads();
            for (int u = F.vcu; u < 512; u += F.G) fft_c_unit(F, u);
            __syncthreads();
            for (int u = F.vcu; u < 256; u += F.G) lru_unit<2>(F, args, l, u >> 7, u & 127);
        }
        SEAM(pb + 2);
        if (PM(4) && IN(pb + 3)) {
            RETID();
            pg8::SchedMerge S; S.A = (const char*)F.BR; S.B = (const char*)(F.WBR + (size_t)l * D * BRP); S.lda2 = BRP * 2; S.ldb2 = BRP * 2; S.nM = M / 256; S.nN = D / 256; S.G = F.G; S.c = (int)blockIdx.x;
            pg8::EpiMerge E; E.G = (const unsigned char*)(F.PROJ + C_GATE); E.O = F.MERGED;
            pg8::gemm_phase<pg8::EpiMerge, pg8::SchedMerge, true, false>(F.lds, S, E, wave0);
        }
        SEAM(pb + 3);
        if (PM(5) && IN(pb + 4)) {
            RETID();
            pg8::SchedPlain S; S.A = (const char*)F.MERGED; S.B = (const char*)(F.WOUT + (size_t)l * D * D); S.lda2 = D * 2; S.ldb2 = D * 2; S.nt = D / 64; S.nM = M / 256; S.nN = D / 256; S.G = F.G; S.c = (int)blockIdx.x;
            pg8::EpiOut E; E.hb = F.HB; E.rs = F.RS + (size_t)(2 * l + 1) * M; E.hb8 = nullptr; E.cs = 1.0f;
            pg8::gemm_phase<pg8::EpiOut, pg8::SchedPlain, true, false>(F.lds, S, E, wave0);
        }
        SEAM(pb + 4);
        if ((l & 1) == 0) {
            const int j = l >> 1;
            if (PM(6) && IN(pb + 5)) {
                RETID();
                pg8::SchedPlain S; S.A = (const char*)F.HB; S.B = (const char*)(F.WGU + (size_t)j * 2 * DFF * D); S.lda2 = D * 2; S.ldb2 = D * 2; S.nt = D / 64; S.nM = M / 256; S.nN = 2 * DFF / 256; S.G = F.G; S.c = (int)blockIdx.x;
                pg8::EpiGU E; E.Hd = (unsigned char*)F.HID; E.ldh = DFF; E.rs = F.RS + (size_t)(2 * l + 1) * M; E.srow = nullptr; E.moe = false; E.cs = 1.0f;
                pg8::gemm_phase<pg8::EpiGU, pg8::SchedPlain, true, false, false>(F.lds, S, E, wave0);
            }
            SEAM(pb + 5);
            if (PM(7) && IN(pb + 6)) {
                RETID();
                pg8::SchedPlain S; S.A = (const char*)F.HID; S.B = (const char*)F.WDN + (size_t)j * D * DFF; S.lda2 = DFF; S.ldb2 = DFF; S.nt = DFF / 128; S.nM = M / 256; S.nN = D / 256; S.G = F.G; S.c = (int)blockIdx.x;
                pg8::EpiOut E; E.hb = F.HB; E.rs = F.RS + (size_t)(2 * l + 2) * M; E.hb8 = F.HB8; E.cs = 1.0f / (W8S * H8S);
                pg8::gemm_phase<pg8::EpiOut, pg8::SchedPlain, true, false, true>(F.lds, S, E, wave0);
            }
            SEAM(pb + 6);
        } else {
            const int jm = l >> 1;
            if (PM(8) && IN(pb + 5)) { RETID(); moe_router(F, jm, F.RS + (size_t)(2 * l + 1) * M); }
            SEAM(pb + 5);
            if (PM(9) && IN(pb + 6)) {
                RETID();
                pg8::SchedMoe S; moe_sched_init(F, jm, S);
                S.A = (const char*)F.HB; S.B = (const char*)(F.MGU + (size_t)(jm * 8) * 2 * DFE * D); S.list = F.LIST; S.lda2 = D * 2; S.ldb2 = D * 2; S.nt = D / 64; S.nN = 2 * DFE / 256; S.G = F.G; S.c = (int)blockIdx.x;
                S.bstride = (size_t)2 * DFE * D * 2; S.gather = true;
                pg8::EpiGU E; E.Hd = (unsigned char*)F.HID; E.ldh = DFE; E.rs = nullptr; E.srow = F.SROW; E.moe = true; E.cs = 1.0f;
                pg8::gemm_phase<pg8::EpiGU, pg8::SchedMoe, true, true, false>(F.lds, S, E, wave0);
            }
            SEAM(pb + 6);
            if (PM(10) && IN(pb + 7)) {
                RETID();
                pg8::SchedMoe S; moe_sched_init(F, jm, S);
                S.A = (const char*)F.HID; S.B = (const char*)F.MDN + (size_t)(jm * 8) * D * DFE; S.list = F.LIST; S.lda2 = DFE; S.ldb2 = DFE; S.nt = DFE / 128; S.nN = D / 256; S.G = F.G; S.c = (int)blockIdx.x;
                S.bstride = (size_t)D * DFE; S.gather = false;
                pg8::EpiMoeDown E; E.Y = F.YBUF; E.wslot = F.WSLOT;
                pg8::gemm_phase<pg8::EpiMoeDown, pg8::SchedMoe, true, false, true>(F.lds, S, E, wave0);
            }
            SEAM(pb + 7);
            if (PM(11) && IN(pb + 8)) { RETID(); moe_combine(F, args, jm, F.RS + (size_t)((2 * l + 2) & 7) * M, l == DEPTH - 1); }
            SEAM(pb + 8);
        }
    }
#undef IN
#undef SEAM
}

#ifndef ABL
#define ABL 0
#endif
#ifndef MK_PER_PHASE
#define MK_PER_PHASE 0
#endif
extern "C" void kernel_launch(void* const* d_in, const int* in_sizes, int n_in, void* d_out, int out_size, void* d_ws, size_t ws_size, hipStream_t stream) {
    static int grid = 0;
    if (grid == 0) {
        if (n_in != 21 || out_size != M * D || ws_size < WS_END) { fprintf(stderr, "kernel_launch: unexpected shapes (n_in %d out %d ws %zu)\n", n_in, out_size, ws_size); grid = -1; return; }
        int dev = 0, cus = 0, per_cu = 0;
        if (hipGetDevice(&dev) != hipSuccess || hipDeviceGetAttribute(&cus, hipDeviceAttributeMultiprocessorCount, dev) != hipSuccess) { grid = -1; return; }
        if (hipFuncSetAttribute((const void*)enc_fwd, hipFuncAttributeMaxDynamicSharedMemorySize, LDS_BYTES) != hipSuccess) { fprintf(stderr, "kernel_launch: hipFuncSetAttribute failed\n"); grid = -1; return; }
        if (hipOccupancyMaxActiveBlocksPerMultiprocessor(&per_cu, (const void*)enc_fwd, NWAVES * 64, LDS_BYTES) != hipSuccess || per_cu < 1)
            fprintf(stderr, "kernel_launch: note: occupancy query reports %d workgroups per CU\n", per_cu);
        (void)hipGetLastError();
        grid = cus;
    }
    if (grid < 0) return;
    (void)hipMemsetAsync((char*)d_ws + WS_CTL, 0, CTL_ZERO_BYTES, stream);
    (void)hipMemsetAsync((char*)d_ws + WS_RS, 0, 1 * MiB, stream);
    Args a{};
    a.x = (const float*)d_in[0]; a.norm_mix_g = (const float*)d_in[1]; a.w_in = (const float*)d_in[2]; a.b_in = (const float*)d_in[3]; a.na_rpb = (const float*)d_in[4];
    a.conv_w = (const float*)d_in[5]; a.conv_b = (const float*)d_in[6]; a.lru_wa = (const float*)d_in[7]; a.lru_ba = (const float*)d_in[8]; a.lru_wx = (const float*)d_in[9];
    a.lru_bx = (const float*)d_in[10]; a.lru_lambda = (const float*)d_in[11]; a.w_branch = (const float*)d_in[12]; a.w_out = (const float*)d_in[13]; a.norm_ffn_g = (const float*)d_in[14];
    a.ffn_w_gu = (const float*)d_in[15]; a.ffn_w_down = (const float*)d_in[16]; a.router_w = (const float*)d_in[17]; a.moe_w_gu = (const float*)d_in[18]; a.moe_w_down = (const float*)d_in[19];
    a.final_g = (const float*)d_in[20];
    a.out = (float*)d_out; a.ws = (unsigned char*)d_ws;
    constexpr int NPH = 1 + 9 * DEPTH;
#ifndef PROBE_LO
#define PROBE_LO -1
#define PROBE_HI -1
#endif
    if (PROBE_LO >= 0) {
        a.ph_lo = 0; a.ph_hi = PROBE_HI; a.bar_region = 0; hipLaunchKernelGGL(enc_fwd, dim3(grid), dim3(NWAVES * 64), LDS_BYTES, stream, a);
        a.ph_lo = PROBE_LO; a.ph_hi = PROBE_HI; a.bar_region = 1; hipLaunchKernelGGL(enc_fwd, dim3(grid), dim3(NWAVES * 64), LDS_BYTES, stream, a);
        a.ph_lo = PROBE_HI; a.ph_hi = NPH; a.bar_region = 2; hipLaunchKernelGGL(enc_fwd, dim3(grid), dim3(NWAVES * 64), LDS_BYTES, stream, a);
    } else {
        a.ph_lo = 0; a.ph_hi = NPH; a.bar_region = 0;
        hipLaunchKernelGGL(enc_fwd, dim3(grid), dim3(NWAVES * 64), LDS_BYTES, stream, a);
    }
    const hipError_t le = hipPeekAtLastError();
    if (le != hipSuccess) fprintf(stderr, "kernel_launch: launch failed: %s\n", hipGetErrorName(le));
}
```

```cpp
#include <hip/hip_runtime.h>
#include <cstdio>
#include <cstdint>

#ifndef ABL
#define ABL 0
#endif
#define LAS __attribute__((address_space(3)))
#define GAS __attribute__((address_space(1)))
typedef unsigned short bf16;
typedef short bf16x8 __attribute__((ext_vector_type(8)));
typedef short s16x4 __attribute__((ext_vector_type(4)));
typedef float f32x4 __attribute__((ext_vector_type(4)));
typedef float f32x2 __attribute__((ext_vector_type(2)));
typedef unsigned u32x4 __attribute__((ext_vector_type(4)));
typedef unsigned u32x2 __attribute__((ext_vector_type(2)));
typedef __bf16 bf16x2_t __attribute__((ext_vector_type(2)));
typedef GAS unsigned gu32;
#define RLX_AGENT __ATOMIC_RELAXED, __HIP_MEMORY_SCOPE_AGENT
#define LDS_WAIT() asm volatile("s_waitcnt lgkmcnt(0)" ::: "memory")
#define VM_WAIT() asm volatile("s_waitcnt vmcnt(0)" ::: "memory")

constexpr int NB = 2, SEQ = 8192, M = NB * SEQ, D = 1024, DEPTH = 4;
constexpr int INC = 6144;
constexpr int PPITCH = 6208;
constexpr int VTP = 8256;
constexpr int C_Q = 0, C_K = 512, C_V = 1024, C_UF = 1536, C_UX = 2048, C_UG = 2560, C_GATE = 3072;
constexpr int BRP = 2112;
constexpr int DFF = 3072, DFE = 1536, NEXP = 8;
constexpr float RMS_EPS = 1e-6f;
constexpr int NWAVES = 8;

constexpr size_t MiB = 1u << 20;
constexpr size_t WS_CTL = 0, CTL_ZERO_BYTES = 1 * MiB;
constexpr size_t WS_WIN = 1 * MiB;
constexpr size_t WS_WBR = 714 * MiB;
constexpr size_t WS_WOUT = 65 * MiB;
constexpr size_t WS_WGU = 73 * MiB;
constexpr size_t WS_WDN = 97 * MiB;
constexpr size_t WS_MGU = 109 * MiB;
constexpr size_t WS_MDN = 205 * MiB;
constexpr size_t WS_WL = 253 * MiB;
constexpr size_t WS_MISC = 254 * MiB;
constexpr size_t WS_LSUM = 255 * MiB;
constexpr size_t WS_MOEI = 257 * MiB;
constexpr size_t WS_HB = 259 * MiB;
constexpr size_t WS_HB8 = 291 * MiB;
constexpr size_t WS_WIN8 = 630 * MiB;
constexpr size_t WS_BR = 647 * MiB;
constexpr size_t WS_TP = 371 * MiB;
constexpr size_t WS_MERGED = 403 * MiB;
constexpr size_t WS_PROJ = 435 * MiB;
constexpr size_t WS_HID = 435 * MiB;
constexpr size_t WS_YBUF = 537 * MiB;
constexpr size_t WS_RS = 629 * MiB;
constexpr size_t WS_LSTH = 731 * MiB;
constexpr size_t WS_LSTP = WS_MERGED;
constexpr size_t WS_END = 747 * MiB;
constexpr int CW_BAR = 4096;
constexpr int CW_MOE = 16384;

constexpr int LDS_BYTES = 147456;
constexpr int SCR_BYTES = 139264;
constexpr int MISC_OFF = SCR_BYTES;

__device__ __forceinline__ unsigned pk2(float lo, float hi) { f32x2 v = {lo, hi}; bf16x2_t b = __builtin_convertvector(v, bf16x2_t); return __builtin_bit_cast(unsigned, b); }
__device__ __forceinline__ int opaque_i(int v) { asm volatile("" : "+v"(v)); return v; }
__device__ __forceinline__ int lane_id() { int l; asm volatile("v_mbcnt_lo_u32_b32 %0, -1, 0\n\tv_mbcnt_hi_u32_b32 %0, -1, %0" : "=&v"(l)); return l; }
__device__ __forceinline__ int tid_of(int wave0) { int w = wave0; asm volatile("" : "+s"(w)); return opaque_i(w * 64 + lane_id()); }
__device__ __forceinline__ float bf2f(unsigned short x) { return __uint_as_float((unsigned)x << 16); }
__device__ __forceinline__ unsigned pk4_u8(float a, float b, float c, float d) {
    unsigned r = 0; r = __builtin_amdgcn_cvt_pk_u8_f32(__builtin_fmaf(a, 256.f, -0.5f), 0, r); r = __builtin_amdgcn_cvt_pk_u8_f32(__builtin_fmaf(b, 256.f, -0.5f), 1, r);
    r = __builtin_amdgcn_cvt_pk_u8_f32(__builtin_fmaf(c, 256.f, -0.5f), 2, r); r = __builtin_amdgcn_cvt_pk_u8_f32(__builtin_fmaf(d, 256.f, -0.5f), 3, r); return r; }
__device__ __forceinline__ u32x4 pair16(u32x2 a, u32x2 b) {
    const auto rx = __builtin_amdgcn_permlane16_swap(a.x, b.x, false, false); const auto ry = __builtin_amdgcn_permlane16_swap(a.y, b.y, false, false);
    u32x4 r; r.x = rx[0]; r.y = ry[0]; r.z = rx[1]; r.w = ry[1]; return r;
}
__device__ __forceinline__ float ub8(unsigned x, int j) { return (float)((x >> (8 * j)) & 0xffu) + 0.5f; }
__device__ __forceinline__ float bflo(unsigned x) { return __uint_as_float(x << 16); }
__device__ __forceinline__ float bfhi(unsigned x) { return __uint_as_float(x & 0xffff0000u); }
__device__ __forceinline__ float wave_sum(float v) {
#pragma unroll
    for (int o = 1; o < 64; o <<= 1) v += __shfl_xor(v, o);
    return v;
}
constexpr float RS_SCALE = 16777216.0f;
constexpr float W8S = 64.0f, H8S = 8.0f;
typedef int i32x8 __attribute__((ext_vector_type(8)));
__device__ __forceinline__ float sat8(float x) { return __builtin_amdgcn_fmed3f(x, -448.0f, 448.0f); }
__device__ __forceinline__ unsigned pk4_fp8(float a, float b, float c, float d) { int r = 0; a = sat8(a); b = sat8(b); c = sat8(c); d = sat8(d); r = __builtin_amdgcn_cvt_pk_fp8_f32(a, b, r, false); r = __builtin_amdgcn_cvt_pk_fp8_f32(c, d, r, true); return (unsigned)r; }
__device__ __forceinline__ float rs_rstd(unsigned long long v) { return __builtin_amdgcn_rsqf((float)v * (1.0f / (RS_SCALE * D)) + RMS_EPS); }
__device__ __forceinline__ float fast_sigmoid(float x) { return __builtin_amdgcn_rcpf(1.0f + __builtin_amdgcn_exp2f(-1.44269504f * x)); }
__device__ __forceinline__ float gelu_tanh(float x) { const float z = 0.7978845608f * (x + 0.044715f * x * x * x); return x * fast_sigmoid(2.0f * z); }

namespace pg8 {
constexpr int BM = 256, BK = 64, HALF = 128, HTB = HALF * BK * 2, STAGE_BYTES = 8 * HTB, NXCD = 8, WGM = 8;
__host__ __device__ __forceinline__ int lds_byte(int r, int c) { const int st = (r >> 4) * 2 + (c >> 5), rr = r & 15, cc = c & 31, ob = rr * 64 + cc * 2; return st * 1024 + (ob ^ (((ob >> 9) & 1) << 5)); }
__host__ __device__ __forceinline__ void stage_rc(int b, int& R, int& C) { const int st = b / 1024, sb = b % 1024, swz = sb ^ (((sb >> 9) & 1) << 5); R = (st >> 1) * 16 + swz / 64; C = (st & 1) * 32 + (swz % 64) / 2; }
__host__ __device__ __forceinline__ int perm32(int rho) { const int n = rho >> 4, i = rho & 15; return 8 * (i >> 2) + 4 * n + (i & 3); }

struct Unit { int pm, pn, sub, aux; };
__device__ __forceinline__ bool tile_of(long L, int nM, int nN, int& pm, int& pn) {
    const int nwg = nM * nN; if (L >= nwg) return false;
    int wgid = (int)L; { const int q = nwg / NXCD, r = nwg % NXCD, xcd = wgid % NXCD, off = wgid / NXCD; wgid = (xcd < r ? xcd * (q + 1) : r * (q + 1) + (xcd - r) * q) + off; }
    const int nig = WGM * nN, gid = wgid / nig, fm = gid * WGM, gsz = (nM - fm) < WGM ? (nM - fm) : WGM;
    pm = fm + ((wgid % nig) % gsz); pn = (wgid % nig) / gsz; return true;
}
struct SchedPlain {
    const char* A; const char* B; int lda2, ldb2, nt, nM, nN, G, c;
    __device__ __forceinline__ bool next(int i, Unit& u) const { u.sub = 0; u.aux = 0; return tile_of((long)i * G + c, nM, nN, u.pm, u.pn); }
    __device__ __forceinline__ const char* a_ptr(const Unit& u) const { return A + (size_t)u.pm * 256 * lda2; }
    __device__ __forceinline__ const char* b_ptr(const Unit& u) const { return B + (size_t)u.pn * 256 * ldb2; }
    __device__ __forceinline__ int ntiles(const Unit&) const { return nt; }
    __device__ __forceinline__ unsigned row_off(const Unit&, int) const { return 0u; }
};
struct SchedMerge {
    const char* A; const char* B; int lda2, ldb2, nM, nN, G, c;
    __device__ __forceinline__ bool next(int i, Unit& u) const { u.sub = i % 3; u.aux = 0; return tile_of((long)(i / 3) * G + c, nM, nN, u.pm, u.pn); }
    __device__ __forceinline__ int koff(const Unit& u) const { return u.sub == 0 ? 0 : (u.sub == 1 ? 512 : 1536); }
    __device__ __forceinline__ const char* a_ptr(const Unit& u) const { return A + (size_t)u.pm * 256 * lda2 + koff(u) * 2; }
    __device__ __forceinline__ const char* b_ptr(const Unit& u) const { return B + (size_t)u.pn * 256 * ldb2 + koff(u) * 2; }
    __device__ __forceinline__ int ntiles(const Unit& u) const { return u.sub == 1 ? 16 : 8; }
    __device__ __forceinline__ unsigned row_off(const Unit&, int) const { return 0u; }
};
struct SchedMoe {
    const char* A; const char* B; const int* list; int lda2, ldb2, nt, nN, G, c; size_t bstride; bool gather;
    int t1, t2, t3, t4, t5, t6, t7, t8;
    const unsigned* cntp;
    __device__ __forceinline__ bool next(int i, Unit& u) const {
        if (!tile_of((long)i * G + c, t8, nN, u.pm, u.pn)) return false;
        const int pm = u.pm; int e = 0, a = 0;
        if (pm >= t1) { e = 1; a = t1; } if (pm >= t2) { e = 2; a = t2; } if (pm >= t3) { e = 3; a = t3; } if (pm >= t4) { e = 4; a = t4; }
        if (pm >= t5) { e = 5; a = t5; } if (pm >= t6) { e = 6; a = t6; } if (pm >= t7) { e = 7; a = t7; }
        u.sub = e; u.aux = a; return true;
    }
    __device__ __forceinline__ int cnt_of(int e) const { return __builtin_amdgcn_readfirstlane((int)cntp[e * 64]); }
    __device__ __forceinline__ const char* a_ptr(const Unit& u) const { return gather ? A : A + (size_t)u.pm * 256 * lda2; }
    __device__ __forceinline__ const char* b_ptr(const Unit& u) const { return B + (size_t)u.sub * bstride + (size_t)u.pn * 256 * ldb2; }
    __device__ __forceinline__ int ntiles(const Unit&) const { return nt; }
    __device__ __forceinline__ unsigned row_off(const Unit& u, int lrow) const {
        const int pos = (u.pm - u.aux) * 256 + lrow; const int cn = cnt_of(u.sub);
        const int tok = list[u.sub * 16384 + (pos < cn ? pos : 0)];
        return (unsigned)tok * (unsigned)lda2;
    }
};

template <class Epi, class Sched, bool ALIGN_EPI, bool GATHER, bool FP8 = false>
__device__ __forceinline__ void gemm_phase(LAS unsigned char* lds, const Sched& S, const Epi& E, int wave0) {
    const int tid = tid_of(wave0), wid = __builtin_amdgcn_readfirstlane(tid >> 6), lane = tid & 63, wr = wid >> 2, wc = wid & 3, fr = lane & 15, fq = lane >> 4;
    const int lda2 = S.lda2, ldb2 = S.ldb2;
    unsigned vA0[2], vA1[2], voffB[2];
    LAS unsigned* rowtab = (LAS unsigned*)(lds + STAGE_BYTES);
#pragma unroll
    for (int i = 0; i < 2; ++i) { int R, C; stage_rc(tid * 16 + i * 8192, R, C); const int Rb = Epi::PERM ? ((R & ~31) + perm32(R & 31)) : R;
        voffB[i] = (unsigned)(Rb * ldb2 + C * 2); vA0[i] = (unsigned)(R * lda2 + C * 2); vA1[i] = vA0[i] + (unsigned)(HALF * lda2); }
    const size_t kstep = (size_t)(BK * 2);
    const size_t hstepB = (size_t)HALF * ldb2;
    const unsigned ldsw = (unsigned)wid * 1024u;
    const int aoff = lds_byte(wr * 64 + fr, fq * 8), boff = lds_byte(wc * 32 + fr, fq * 8);
#define PG8_SA(b, h) (((b) * 2 + (h)) * HTB)
#define PG8_SB(b, h) ((4 + (b) * 2 + (h)) * HTB)
#define PG8_STAGE(bufoff, gbase, voff) do { _Pragma("unroll") for (int _i = 0; _i < 2; ++_i) \
        __builtin_amdgcn_global_load_lds((const unsigned*)((const char*)(gbase) + (voff)[_i]), (LAS unsigned*)(lds + (bufoff) + ldsw + _i * 8192), 16, 0, 0); } while (0)
#define PG8_LDA(dst, b, h) do { if constexpr (FP8) { _Pragma("unroll") for (int m = 0; m < 4; ++m) { const u32x4 lo_ = *(const LAS u32x4*)(lds + PG8_SA(b, h) + aoff + m * 2048), hi_ = *(const LAS u32x4*)(lds + PG8_SA(b, h) + aoff + m * 2048 + 1024); \
        dst##8[m] = __builtin_bit_cast(i32x8, __builtin_shufflevector(lo_, hi_, 0, 1, 2, 3, 4, 5, 6, 7)); } } \
    else { _Pragma("unroll") for (int m = 0; m < 4; ++m) _Pragma("unroll") for (int k = 0; k < 2; ++k) dst[m][k] = *(const LAS bf16x8*)(lds + PG8_SA(b, h) + aoff + m * 2048 + k * 1024); } } while (0)
#define PG8_LDB(dst, b, h) do { if constexpr (FP8) { _Pragma("unroll") for (int n = 0; n < 2; ++n) { const u32x4 lo_ = *(const LAS u32x4*)(lds + PG8_SB(b, h) + boff + n * 2048), hi_ = *(const LAS u32x4*)(lds + PG8_SB(b, h) + boff + n * 2048 + 1024); \
        dst##8[n] = __builtin_bit_cast(i32x8, __builtin_shufflevector(lo_, hi_, 0, 1, 2, 3, 4, 5, 6, 7)); } } \
    else { _Pragma("unroll") for (int n = 0; n < 2; ++n) _Pragma("unroll") for (int k = 0; k < 2; ++k) dst[n][k] = *(const LAS bf16x8*)(lds + PG8_SB(b, h) + boff + n * 2048 + k * 1024); } } while (0)
#define PG8_MMA(ai, bj, At, Bt) do { __builtin_amdgcn_s_setprio(1); _Pragma("unroll") for (int m = 0; m < 4; ++m) _Pragma("unroll") for (int n = 0; n < 2; ++n) { \
        if constexpr (FP8) asm volatile("v_mfma_scale_f32_16x16x128_f8f6f4 %0, %1, %2, %0, %3, %3 op_sel_hi:[0,0,0]" : "+v"(acc[ai][bj][m][n]) : "v"(Bt##8[n]), "v"(At##8[m]), "v"(sc1)); \
        else { _Pragma("unroll") for (int k = 0; k < 2; ++k) acc[ai][bj][m][n] = __builtin_amdgcn_mfma_f32_16x16x32_bf16(Bt[n][k], At[m][k], acc[ai][bj][m][n], 0, 0, 0); } } \
        __builtin_amdgcn_s_setprio(0); } while (0)
#define PG8_WAIT_V(n) asm volatile("s_waitcnt vmcnt(" #n ")" ::: "memory")
#define PG8_WAIT_L(n) asm volatile("s_waitcnt lgkmcnt(" #n ")" ::: "memory")
#define PG8_BAR __builtin_amdgcn_s_barrier()
#define PG8_SCHED __builtin_amdgcn_sched_barrier(0)
    Unit cur, nxt; int ui = 0;
    if (!S.next(0, cur)) return;
    f32x4 acc[2][2][4][2];
#pragma unroll
    for (int a = 0; a < 2; ++a)
#pragma unroll
        for (int b = 0; b < 2; ++b)
#pragma unroll
            for (int m = 0; m < 4; ++m)
#pragma unroll
                for (int n = 0; n < 2; ++n) acc[a][b][m][n] = (f32x4){0.f, 0.f, 0.f, 0.f};
    bf16x8 At[4][2], B0[2][2], B1[2][2];
    i32x8 At8[4], B08[2], B18[2]; const int sc1 = 0x7F7F7F7F;
    const char* cA = S.a_ptr(cur); const char* cB = S.b_ptr(cur); int nt = S.ntiles(cur);
    if constexpr (GATHER) {
#pragma unroll
        for (int i = 0; i < 2; ++i) { int R, C; stage_rc(tid * 16 + i * 8192, R, C); vA0[i] = S.row_off(cur, R) + (unsigned)(C * 2); vA1[i] = S.row_off(cur, HALF + R) + (unsigned)(C * 2); }
    }
    PG8_STAGE(PG8_SB(0, 0), cB, voffB); PG8_STAGE(PG8_SB(0, 1), cB + hstepB, voffB); PG8_STAGE(PG8_SA(0, 0), cA, vA0); PG8_STAGE(PG8_SA(0, 1), cA, vA1);
    if (wr == 1) PG8_BAR;
    PG8_WAIT_V(2); PG8_BAR;
    PG8_STAGE(PG8_SB(1, 0), cB + kstep, voffB); PG8_STAGE(PG8_SA(1, 0), cA + kstep, vA0); PG8_STAGE(PG8_SB(1, 1), cB + hstepB + kstep, voffB);
    PG8_WAIT_V(6); PG8_BAR;
    for (;;) {
        const bool has_next = S.next(ui + 1, nxt);
        const char* nA = has_next ? S.a_ptr(nxt) : cA; const char* nB = has_next ? S.b_ptr(nxt) : cB;
        for (int t = 0; t < nt; t += 2) {
            const bool last = (t == nt - 2);
            const char* a1 = cA + (size_t)(t + 1) * kstep;
            const char* a2 = last ? nA : cA + (size_t)(t + 2) * kstep; const char* b2 = last ? nB : cB + (size_t)(t + 2) * kstep;
            const char* a3 = a2 + kstep; const char* b3 = b2 + kstep;
            if constexpr (GATHER) { if (last && has_next) { if (tid < 256) rowtab[tid] = S.row_off(nxt, tid); } }
            PG8_LDB(B0, 0, 0); PG8_LDB(B1, 0, 1); PG8_SCHED; PG8_LDA(At, 0, 0); PG8_STAGE(PG8_SA(1, 1), a1, vA1);
            PG8_WAIT_V(8); PG8_WAIT_L(0); PG8_BAR; PG8_MMA(0, 0, At, B0); PG8_MMA(0, 1, At, B1); PG8_BAR; PG8_SCHED;
            if constexpr (GATHER) { if (last && has_next) {
_Pragma("unroll") for (int i = 0; i < 2; ++i) { int R, C; stage_rc(tid * 16 + i * 8192, R, C); vA0[i] = rowtab[R] + (unsigned)(C * 2); vA1[i] = rowtab[HALF + R] + (unsigned)(C * 2); } } }
            PG8_LDA(At, 0, 1); PG8_STAGE(PG8_SB(0, 0), b2, voffB); PG8_STAGE(PG8_SB(0, 1), b2 + hstepB, voffB); PG8_STAGE(PG8_SA(0, 0), a2, vA0);
            PG8_WAIT_V(8); PG8_WAIT_L(0); PG8_BAR; PG8_MMA(1, 0, At, B0); PG8_MMA(1, 1, At, B1); PG8_BAR; PG8_SCHED;
            PG8_LDB(B0, 1, 0); PG8_LDB(B1, 1, 1); PG8_SCHED; PG8_LDA(At, 1, 0); PG8_STAGE(PG8_SA(0, 1), a2, vA1);
            PG8_WAIT_V(8); PG8_WAIT_L(0); PG8_BAR; PG8_MMA(0, 0, At, B0); PG8_MMA(0, 1, At, B1); PG8_BAR; PG8_SCHED;
            PG8_LDA(At, 1, 1); PG8_STAGE(PG8_SB(1, 0), b3, voffB); PG8_STAGE(PG8_SB(1, 1), b3 + hstepB, voffB); PG8_STAGE(PG8_SA(1, 0), a3, vA0);
            PG8_WAIT_V(8); PG8_WAIT_L(0); PG8_BAR; PG8_MMA(1, 0, At, B0); PG8_MMA(1, 1, At, B1); PG8_BAR; PG8_SCHED;
        }
        if constexpr (ALIGN_EPI) { if (wr == 0) PG8_BAR; }
        if constexpr (FP8) asm volatile("s_nop 15\n\ts_nop 15" ::: "memory");
        E(acc, cur, wr, wc, opaque_i(fr), opaque_i(fq));
        if (!has_next) break;
        if (!(Epi::CARRY && E.keep(cur))) {
#pragma unroll
            for (int a = 0; a < 2; ++a)
#pragma unroll
                for (int b = 0; b < 2; ++b)
#pragma unroll
                    for (int m = 0; m < 4; ++m)
#pragma unroll
                        for (int n = 0; n < 2; ++n) acc[a][b][m][n] = (f32x4){0.f, 0.f, 0.f, 0.f};
        }
        cur = nxt; cA = nA; cB = nB; nt = S.ntiles(cur); ++ui;
        if constexpr (ALIGN_EPI) { if (wr == 1) PG8_BAR; }
    }
    PG8_WAIT_V(0);
    if constexpr (!ALIGN_EPI) { if (wr == 0) PG8_BAR; }
    PG8_BAR;
#undef PG8_SA
#undef PG8_SB
#undef PG8_STAGE
#undef PG8_LDA
#undef PG8_LDB
#undef PG8_MMA
#undef PG8_WAIT_V
#undef PG8_WAIT_L
#undef PG8_BAR
#undef PG8_SCHED
}

template <bool GATES>
struct EpiProj {
    static constexpr bool PERM = true, CARRY = false;
    bf16* P; bf16* VT; const float* bias; const unsigned long long* rs; int pn_off; float cs;
    __device__ __forceinline__ bool keep(const Unit&) const { return false; }
    __device__ __forceinline__ void operator()(f32x4 (&acc)[2][2][4][2], const Unit& u, int wr, int wc, int fr, int fq) const {
        const int pn = u.pn + pn_off; const int row0 = u.pm * BM + wr * 64 + fr, colb = pn * BM + wc * 32 + 8 * fq;
        const int kind = GATES ? 4 : (pn < 2) ? 0 : (pn < 10) ? 1 : 3;
        unsigned long long rsv[8]; f32x4 bv[2][2];
#pragma unroll
        for (int k = 0; k < 8; ++k) rsv[k] = rs[row0 + (k >> 2) * HALF + (k & 3) * 16];
#pragma unroll
        for (int bj = 0; bj < 2; ++bj) { bv[bj][0] = *(const f32x4*)(bias + colb + bj * HALF); bv[bj][1] = *(const f32x4*)(bias + colb + bj * HALF + 4); }
        __builtin_amdgcn_sched_barrier(0);
        if constexpr (GATES) {
            unsigned char* gp = (unsigned char*)(P + (size_t)(row0 + (fq & 1) * 16) * PPITCH + C_GATE) + (pn * BM - C_GATE) + wc * 32 + 8 * (fq & ~1);
#pragma unroll
            for (int ai = 0; ai < 2; ++ai)
#pragma unroll
                for (int mp = 0; mp < 2; ++mp)
#pragma unroll
                    for (int bj = 0; bj < 2; ++bj) {
                        u32x2 w8[2];
#pragma unroll
                        for (int h = 0; h < 2; ++h) {
                            const int m = mp * 2 + h; const float sr = rs_rstd(rsv[ai * 4 + m]) * cs;
                            float v[8];
                            const f32x4 bv0 = bv[bj][0], bv1 = bv[bj][1];
#pragma unroll
                            for (int i = 0; i < 4; ++i) { v[i] = acc[ai][bj][m][0][i] * sr + bv0[i]; v[4 + i] = acc[ai][bj][m][1][i] * sr + bv1[i]; }
#pragma unroll
                            for (int e = 0; e < 8; ++e) v[e] = fast_sigmoid(fminf(fmaxf(v[e], -30.f), 30.f));
                            w8[h].x = pk4_u8(v[0], v[1], v[2], v[3]); w8[h].y = pk4_u8(v[4], v[5], v[6], v[7]);
                        }
                        *(u32x4*)(gp + (size_t)(ai * HALF + mp * 32) * (2 * PPITCH) + bj * HALF) = pair16(w8[0], w8[1]);
                    }
        } else {
#pragma unroll
        for (int ai = 0; ai < 2; ++ai)
#pragma unroll
            for (int m = 0; m < 4; ++m) {
                const int row = row0 + ai * HALF + m * 16;
                const float sr = rs_rstd(rsv[ai * 4 + m]) * cs;
#pragma unroll
                for (int bj = 0; bj < 2; ++bj) {
                    float v[8];
                    const f32x4 bv0 = bv[bj][0], bv1 = bv[bj][1];
#pragma unroll
                    for (int i = 0; i < 4; ++i) { v[i] = acc[ai][bj][m][0][i] * sr + bv0[i]; v[4 + i] = acc[ai][bj][m][1][i] * sr + bv1[i]; }
                    if (kind == 0) {
#pragma unroll
                        for (int e = 0; e < 8; ++e) v[e] *= 0.125f;
                    } else if (kind == 3) {
#pragma unroll
                        for (int e = 0; e < 8; ++e) v[e] = gelu_tanh(v[e]);
                    }
                    { u32x4 w; w.x = pk2(v[0], v[1]); w.y = pk2(v[2], v[3]); w.z = pk2(v[4], v[5]); w.w = pk2(v[6], v[7]);
                      *(u32x4*)(P + (size_t)row * PPITCH + colb + bj * HALF) = w; }
                }
            }
        }
    }
};
struct EpiMerge {
    static constexpr bool PERM = true, CARRY = true;
    const unsigned char* G; bf16* O;
    __device__ __forceinline__ bool keep(const Unit& u) const { return u.sub < 2; }
    __device__ __forceinline__ void operator()(f32x4 (&acc)[2][2][4][2], const Unit& u, int wr, int wc, int fr, int fq) const {
        const int row0 = u.pm * BM + wr * 64 + fr, colb = u.pn * BM + wc * 32 + 8 * fq, sub = u.sub;
#pragma unroll
        for (int ai = 0; ai < 2; ++ai) {
            u32x2 gk[4][2], gn[4][2];
#pragma unroll
            for (int m = 0; m < 4; ++m)
#pragma unroll
                for (int bj = 0; bj < 2; ++bj) {
                    const unsigned char* gp = G + (size_t)(row0 + ai * HALF + m * 16) * (2 * PPITCH) + sub * D + colb + bj * HALF;
                    gk[m][bj] = *(const u32x2*)gp;
                    if (sub < 2) gn[m][bj] = *(const u32x2*)(gp + D);
                }
            __builtin_amdgcn_sched_barrier(0);
#pragma unroll
            for (int m = 0; m < 4; ++m) {
                const int row = row0 + ai * HALF + m * 16;
#pragma unroll
                for (int bj = 0; bj < 2; ++bj) {
                    const u32x2 g4 = gk[m][bj];
                    float f[8] = {ub8(g4.x, 0), ub8(g4.x, 1), ub8(g4.x, 2), ub8(g4.x, 3), ub8(g4.y, 0), ub8(g4.y, 1), ub8(g4.y, 2), ub8(g4.y, 3)};
                    if (sub < 2) {
                        const u32x2 n4 = gn[m][bj];
                        const float d[8] = {ub8(n4.x, 0), ub8(n4.x, 1), ub8(n4.x, 2), ub8(n4.x, 3), ub8(n4.y, 0), ub8(n4.y, 1), ub8(n4.y, 2), ub8(n4.y, 3)};
#pragma unroll
                        for (int e = 0; e < 8; ++e) f[e] *= __builtin_amdgcn_rcpf(d[e]);
                    } else {
#pragma unroll
                        for (int e = 0; e < 8; ++e) f[e] *= (1.0f / 256.0f);
                    }
#pragma unroll
                    for (int n = 0; n < 2; ++n)
#pragma unroll
                        for (int i = 0; i < 4; ++i) acc[ai][bj][m][n][i] *= f[n * 4 + i];
                    if (sub == 2) {
                        u32x4 w; w.x = pk2(acc[ai][bj][m][0][0], acc[ai][bj][m][0][1]); w.y = pk2(acc[ai][bj][m][0][2], acc[ai][bj][m][0][3]);
                        w.z = pk2(acc[ai][bj][m][1][0], acc[ai][bj][m][1][1]); w.w = pk2(acc[ai][bj][m][1][2], acc[ai][bj][m][1][3]);
                        *(u32x4*)(O + (size_t)row * D + colb + bj * HALF) = w;
                    }
                }
            }
        }
    }
};
struct EpiOut {
    static constexpr bool PERM = true, CARRY = false;
    bf16* hb; unsigned long long* rs; unsigned char* hb8; float cs;
    __device__ __forceinline__ bool keep(const Unit&) const { return false; }
    __device__ __forceinline__ void operator()(f32x4 (&acc)[2][2][4][2], const Unit& u, int wr, int wc, int fr, int fq) const {
        const int row0 = u.pm * BM + wr * 64 + fr, colb = u.pn * BM + wc * 32 + 8 * fq;
#pragma unroll
        for (int ai = 0; ai < 2; ++ai) {
            u32x4 hv[4][2];
#pragma unroll
            for (int m = 0; m < 4; ++m)
#pragma unroll
                for (int bj = 0; bj < 2; ++bj) hv[m][bj] = *(const u32x4*)(hb + (size_t)(row0 + ai * HALF + m * 16) * D + colb + bj * HALF);
            __builtin_amdgcn_sched_barrier(0);
            float ssm[4]; u32x2 w8[4][2];
#pragma unroll
            for (int m = 0; m < 4; ++m) {
                const int row = row0 + ai * HALF + m * 16; float ss = 0.f;
#pragma unroll
                for (int bj = 0; bj < 2; ++bj) {
                    bf16* hp = hb + (size_t)row * D + colb + bj * HALF;
                    const u32x4 h4 = hv[m][bj];
                    float v[8] = {bflo(h4.x), bfhi(h4.x), bflo(h4.y), bfhi(h4.y), bflo(h4.z), bfhi(h4.z), bflo(h4.w), bfhi(h4.w)};
#pragma unroll
                    for (int n = 0; n < 2; ++n)
#pragma unroll
                        for (int i = 0; i < 4; ++i) { v[n * 4 + i] += acc[ai][bj][m][n][i] * cs; ss += v[n * 4 + i] * v[n * 4 + i]; }
                    u32x4 w; w.x = pk2(v[0], v[1]); w.y = pk2(v[2], v[3]); w.z = pk2(v[4], v[5]); w.w = pk2(v[6], v[7]);
                    *(u32x4*)hp = w;
                    if (hb8) { w8[m][bj].x = pk4_fp8(v[0], v[1], v[2], v[3]); w8[m][bj].y = pk4_fp8(v[4], v[5], v[6], v[7]); }
                }
                ss += __shfl_xor(ss, 16); ss += __shfl_xor(ss, 32); ssm[m] = ss;
            }
            if (hb8) {
                unsigned char* qp = hb8 + (size_t)(row0 + ai * HALF + (fq & 1) * 16) * D + u.pn * BM + wc * 32 + 8 * (fq & ~1);
#pragma unroll
                for (int mp = 0; mp < 2; ++mp)
#pragma unroll
                    for (int bj = 0; bj < 2; ++bj) *(u32x4*)(qp + (size_t)(mp * 32) * D + bj * HALF) = pair16(w8[mp * 2][bj], w8[mp * 2 + 1][bj]);
            }
            { const float ssel = (fq == 0) ? ssm[0] : (fq == 1) ? ssm[1] : (fq == 2) ? ssm[2] : ssm[3];
              atomicAdd(rs + row0 + ai * HALF + fq * 16, (unsigned long long)(ssel * RS_SCALE)); }
        }
    }
};
struct EpiGU {
    static constexpr bool PERM = true, CARRY = false;
    unsigned char* Hd; int ldh; const unsigned long long* rs; const float* srow; bool moe; float cs;
    __device__ __forceinline__ bool keep(const Unit&) const { return false; }
    __device__ __forceinline__ void operator()(f32x4 (&acc)[2][2][4][2], const Unit& u, int wr, int wc, int fr, int fq) const {
        const int lrow0 = wr * 64 + fr, hcol = u.pn * HALF + wc * 32 + 8 * fq;
        float srv[8];
#pragma unroll
        for (int k = 0; k < 8; ++k) { const int lrow = lrow0 + (k >> 2) * HALF + (k & 3) * 16;
            if (moe) srv[k] = srow[u.sub * 16384 + (u.pm - u.aux) * 256 + lrow]; else srv[k] = rs_rstd(rs[u.pm * BM + lrow]); }
        __builtin_amdgcn_sched_barrier(0);
        unsigned char* hp = Hd + (size_t)(u.pm * BM + lrow0 + (fq & 1) * 16) * ldh + u.pn * HALF + wc * 32 + 8 * (fq & ~1);
#pragma unroll
        for (int ai = 0; ai < 2; ++ai)
#pragma unroll
            for (int mp = 0; mp < 2; ++mp) {
                u32x2 w[2];
#pragma unroll
                for (int h = 0; h < 2; ++h) {
                    const int m = mp * 2 + h; const float sr = srv[ai * 4 + m] * cs;
                    float o[8];
#pragma unroll
                    for (int n = 0; n < 2; ++n)
#pragma unroll
                        for (int i = 0; i < 4; ++i) { const float g = acc[ai][0][m][n][i] * sr, uu = acc[ai][1][m][n][i] * sr; o[n * 4 + i] = g * fast_sigmoid(g) * uu * H8S; }
                    w[h].x = pk4_fp8(o[0], o[1], o[2], o[3]); w[h].y = pk4_fp8(o[4], o[5], o[6], o[7]);
                }
                *(u32x4*)(hp + (size_t)(ai * HALF + mp * 32) * ldh) = pair16(w[0], w[1]);
            }
    }
};
struct EpiMoeDown {
    static constexpr bool PERM = true, CARRY = false;
    bf16* Y; const float* wslot;
    __device__ __forceinline__ bool keep(const Unit&) const { return false; }
    __device__ __forceinline__ void operator()(f32x4 (&acc)[2][2][4][2], const Unit& u, int wr, int wc, int fr, int fq) const {
        const int lrow0 = wr * 64 + fr, colb = u.pn * BM + wc * 32 + 8 * fq;
        float wtv[8];
#pragma unroll
        for (int k = 0; k < 8; ++k) wtv[k] = wslot[u.sub * 16384 + (u.pm - u.aux) * 256 + lrow0 + (k >> 2) * HALF + (k & 3) * 16];
        __builtin_amdgcn_sched_barrier(0);
#pragma unroll
        for (int ai = 0; ai < 2; ++ai)
#pragma unroll
            for (int m = 0; m < 4; ++m) {
                const int lrow = lrow0 + ai * HALF + m * 16; const int row = u.pm * BM + lrow;
                const float wt = wtv[ai * 4 + m] * (1.0f / (W8S * H8S));
#pragma unroll
                for (int bj = 0; bj < 2; ++bj) {
                    const f32x4 v0 = acc[ai][bj][m][0] * wt, v1 = acc[ai][bj][m][1] * wt;
                    u32x4 w; w.x = pk2(v0[0], v0[1]); w.y = pk2(v0[2], v0[3]); w.z = pk2(v1[0], v1[1]); w.w = pk2(v1[2], v1[3]);
                    *(u32x4*)(Y + (size_t)row * D + colb + bj * HALF) = w;
                }
            }
    }
};
}

#define XB_TMO      128
#define XB_XCNT(j)  (256  + 64 * (j))
#define XB_XSUB(j)  (1280 + 64 * (j))
#define XB_XGEN(j)  (2304 + 64 * (j))
#define XB_TOP      3328
#define XB_TOPGEN   3392
#define XCD_BAR_WORDS 3456
#define XB_SPIN_CAP (1u << 18)
__device__ __forceinline__ unsigned xb_ld(unsigned* p)              { return __hip_atomic_load(p, __ATOMIC_RELAXED, __HIP_MEMORY_SCOPE_AGENT); }
__device__ __forceinline__ unsigned xb_add(unsigned* p, unsigned v) { return __hip_atomic_fetch_add(p, v, __ATOMIC_RELAXED, __HIP_MEMORY_SCOPE_AGENT); }
__device__ __forceinline__ unsigned xb_xcc_id() { return (unsigned)__builtin_amdgcn_s_getreg((3 << 11) | 20) & 0xFu; }
#define XB_SPIN(cond, bar) do { unsigned _sp = 0; while (cond) { __builtin_amdgcn_s_sleep(1); \
    if ((++_sp & 255u) == 0u) { if (xb_ld(&(bar)[XB_TMO])) break; if (_sp > XB_SPIN_CAP) { atomicAdd(&(bar)[XB_TMO], 1u); break; } } } } while (0)
struct XcdBarrier { unsigned* bar; unsigned x; volatile LAS unsigned* st; };
__device__ __forceinline__ XcdBarrier xcd_barrier_post(unsigned* bar, volatile LAS unsigned* st, int wave0) {
    XcdBarrier b; b.bar = bar; b.x = xb_xcc_id(); b.st = st;
    if (wave0 == 0 && lane_id() == 0) (void)xb_add(&bar[XB_XCNT(b.x)], 1u);
    return b;
}
__device__ __forceinline__ void xcd_barrier_complete(unsigned* bar, unsigned x, unsigned& nloc, unsigned& nx) {
    const unsigned G = gridDim.x * gridDim.y * gridDim.z;
    unsigned sum, cnt, mine, sp = 0u;
    for (;;) {
        sum = 0u; cnt = 0u; mine = 0u;
#pragma unroll
        for (unsigned j = 0; j < 16; ++j) { const unsigned c = xb_ld(&bar[XB_XCNT(j)]); sum += c; cnt += (c > 0u) ? 1u : 0u; mine = (j == x) ? c : mine; }
        if (sum == G) break;
        __builtin_amdgcn_s_sleep(1);
        if ((++sp & 255u) == 0u) { if (xb_ld(&bar[XB_TMO])) break; if (sp > XB_SPIN_CAP) { atomicAdd(&bar[XB_TMO], 1u); break; } }
    }
    nloc = mine > 0u ? mine : 1u; nx = cnt > 0u ? cnt : 1u;
}
__device__ __forceinline__ void xcd_barrier(const XcdBarrier& b, int wave0) {
    asm volatile("s_waitcnt vmcnt(0)" ::: "memory");
    __syncthreads();
    if (wave0 == 0 && lane_id() == 0) {
        unsigned* bar = b.bar;
        __builtin_amdgcn_s_waitcnt(0);
        unsigned nloc = b.st[0], nx = b.st[1];
        if (nloc == 0u) { xcd_barrier_complete(bar, b.x, nloc, nx); b.st[0] = nloc; b.st[1] = nx; }
        const unsigned old = xb_add(&bar[XB_XSUB(b.x)], 1u);
        const unsigned gen = old / nloc;
        if (old + 1u == (gen + 1u) * nloc) {
            __builtin_amdgcn_fence(__ATOMIC_RELEASE, "agent");
            asm volatile("s_waitcnt vmcnt(0)" ::: "memory");
            const unsigned og = xb_add(&bar[XB_TOP], 1u);
            const unsigned tg = og / nx;
            if (og + 1u == (tg + 1u) * nx) xb_add(&bar[XB_TOPGEN], 1u);
            else XB_SPIN(xb_ld(&bar[XB_TOPGEN]) == tg, bar);
            __builtin_amdgcn_fence(__ATOMIC_ACQUIRE, "agent");
            xb_add(&bar[XB_XGEN(b.x)], 1u);
            asm volatile("s_waitcnt vmcnt(0)" ::: "memory");
        } else {
            XB_SPIN(xb_ld(&bar[XB_XGEN(b.x)]) == gen, bar);
            __builtin_amdgcn_fence(__ATOMIC_ACQUIRE, "agent");
            asm volatile("s_waitcnt vmcnt(0)" ::: "memory");
        }
    }
    __syncthreads();
}

struct Args {
    const float* x; const float* norm_mix_g; const float* w_in; const float* b_in; const float* na_rpb; const float* conv_w; const float* conv_b;
    const float* lru_wa; const float* lru_ba; const float* lru_wx; const float* lru_bx; const float* lru_lambda; const float* w_branch; const float* w_out;
    const float* norm_ffn_g; const float* ffn_w_gu; const float* ffn_w_down; const float* router_w; const float* moe_w_gu; const float* moe_w_down; const float* final_g;
    float* out; unsigned char* ws; int ph_lo, ph_hi, bar_region, pad;
};
struct Frame {
    LAS unsigned char* lds;
    int tid, lane, wave, vcu, G;
    unsigned* ctl;
    float* H;
    bf16 *HB, *VT, *BR, *TP, *MERGED, *PROJ, *HID, *YBUF; unsigned char* HB8;
    bf16 *WIN, *WBR, *WOUT, *WGU, *WDN, *MGU, *MDN, *WL; unsigned char* WIN8;
    float *NSP, *GW; f32x2* LSUM; unsigned long long* RS; u32x4 *LSTH, *LSTP;
    int* LIST; float* SROW; float* WSLOT; int* TOKI;
};

template <int STEP> __device__ __forceinline__ u32x4 dft_table_entry(int idx);
struct TrDesc { const float* W; const float* ks; unsigned char* WT; int ldw, k0, n0, ldwt, drow0, dcol0, fp8; };
__device__ __forceinline__ void tr_load(const TrDesc& d, float (&tv)[32], float (&kv)[32], int lane) {
#pragma unroll
    for (int i = 0; i < 32; ++i) tv[i] = __builtin_nontemporal_load(d.W + (size_t)(d.k0 + 2 * i + (lane >> 5)) * d.ldw + d.n0 + (lane & 31));
    if (d.ks) {
#pragma unroll
        for (int i = 0; i < 32; ++i) kv[i] = d.ks[d.k0 + 2 * i + (lane >> 5)];
    } else {
#pragma unroll
        for (int i = 0; i < 32; ++i) kv[i] = 1.0f;
    }
}
__device__ __forceinline__ void tr_store(const TrDesc& d, const float (&tv)[32], const float (&kv)[32], LAS float* scr, int lane) {
    const float sc = d.fp8 ? W8S : 1.0f;
#pragma unroll
    for (int i = 0; i < 32; ++i) scr[(2 * i + (lane >> 5)) * 33 + (lane & 31)] = tv[i] * kv[i] * sc;
    LDS_WAIT(); asm volatile("" ::: "memory");
    const int c = lane & 7;
#pragma unroll
    for (int j = 0; j < 4; ++j) { const int n = (lane >> 3) + 8 * j; const LAS float* s = scr + (8 * c) * 33 + n;
        if (d.fp8) { u32x2 o; o.x = pk4_fp8(s[0 * 33], s[1 * 33], s[2 * 33], s[3 * 33]); o.y = pk4_fp8(s[4 * 33], s[5 * 33], s[6 * 33], s[7 * 33]);
            *(u32x2*)(d.WT + (size_t)(d.drow0 + n) * d.ldwt + d.dcol0 + d.k0 + 8 * c) = o; }
        else { u32x4 o; o.x = pk2(s[0 * 33], s[1 * 33]); o.y = pk2(s[2 * 33], s[3 * 33]); o.z = pk2(s[4 * 33], s[5 * 33]); o.w = pk2(s[6 * 33], s[7 * 33]);
            *(u32x4*)((bf16*)d.WT + (size_t)(d.drow0 + n) * d.ldwt + d.dcol0 + d.k0 + 8 * c) = o; } }
    LDS_WAIT(); asm volatile("" ::: "memory");
}
__device__ __forceinline__ int gu_row(int n0, int half) { const int isu = n0 >= half ? 1 : 0; const int hid = n0 - isu * half; return 256 * (hid >> 7) + 128 * isu + (hid & 127); }
template <int STEP> __device__ __forceinline__ u32x4 dft_table_entry(int idx);
__device__ __forceinline__ const Args& fresh_args() { const Args* p = (const Args*)__builtin_amdgcn_kernarg_segment_ptr(); asm volatile("" : "+s"(p)); return *p; }
constexpr int I_IN = 16 * 192, I_BR = 8 * 32, I_OUT = 16 * 32, I_GU = 16 * 192, I_DN = 48 * 32, I_MGU = 16 * 96, I_MDN = 24 * 32;
constexpr int N_IN = 4 * I_IN, N_BR = 8 * I_BR, N_OUT = 4 * I_OUT, N_GU = 2 * I_GU, N_DN = 2 * I_DN, N_MGU = 16 * I_MGU, N_MDN = 16 * I_MDN;
constexpr int NITEMS = N_IN + N_BR + N_OUT + N_GU + N_DN + N_MGU + N_MDN;
__device__ __forceinline__ TrDesc tr_decode(Frame& F, int it) {
    const Args& a = fresh_args(); TrDesc d; d.ks = nullptr; d.dcol0 = 0; d.fp8 = 0;
    int r = it;
    if (r < N_IN) { const int l = r / I_IN, q = r % I_IN, half = q / (I_IN / 2), q2 = q % (I_IN / 2), kb = q2 / 96, nb = q2 % 96;
        d.W = a.w_in + (size_t)l * D * INC; d.ldw = INC; d.k0 = 64 * kb; d.ks = a.norm_mix_g + l * D; d.ldwt = D; d.drow0 = 32 * nb;
        if (half == 0) { d.n0 = 32 * nb; d.WT = (unsigned char*)(F.WIN + (size_t)l * INC * D); } else { d.n0 = 3072 + 32 * nb; d.WT = F.WIN8 + (size_t)l * 3072 * D; d.fp8 = 1; }
        return d; } r -= N_IN;
    if (r < N_BR) { const int lk = r / I_BR, l = lk >> 1, k = (lk & 1) * 2, q = r % I_BR, kb = q / 32, nb = q % 32;
        d.W = a.w_branch + ((size_t)(l * 3 + k) * 512) * D; d.ldw = D; d.k0 = 64 * kb; d.n0 = 32 * nb; d.WT = (unsigned char*)(F.WBR + (size_t)l * D * BRP); d.ldwt = BRP; d.drow0 = 32 * nb; d.dcol0 = k == 0 ? 0 : 1536; return d; } r -= N_BR;
    if (r < N_OUT) { const int l = r / I_OUT, q = r % I_OUT, kb = q / 32, nb = q % 32;
        d.W = a.w_out + (size_t)l * D * D; d.ldw = D; d.k0 = 64 * kb; d.n0 = 32 * nb; d.WT = (unsigned char*)(F.WOUT + (size_t)l * D * D); d.ldwt = D; d.drow0 = 32 * nb; return d; } r -= N_OUT;
    if (r < N_GU) { const int j = r / I_GU, q = r % I_GU, kb = q / 192, nb = q % 192;
        d.W = a.ffn_w_gu + (size_t)j * D * 2 * DFF; d.ldw = 2 * DFF; d.k0 = 64 * kb; d.n0 = 32 * nb; d.ks = a.norm_ffn_g + (2 * j) * D; d.WT = (unsigned char*)(F.WGU + (size_t)j * 2 * DFF * D); d.ldwt = D; d.drow0 = gu_row(32 * nb, DFF); return d; } r -= N_GU;
    if (r < N_DN) { const int j = r / I_DN, q = r % I_DN, kb = q / 32, nb = q % 32;
        d.W = a.ffn_w_down + (size_t)j * DFF * D; d.ldw = D; d.k0 = 64 * kb; d.n0 = 32 * nb; d.WT = (unsigned char*)F.WDN + (size_t)j * D * DFF; d.ldwt = DFF; d.drow0 = 32 * nb; d.fp8 = 1; return d; } r -= N_DN;
    if (r < N_MGU) { const int je = r / I_MGU, j = je >> 3, q = r % I_MGU, kb = q / 96, nb = q % 96;
        d.W = a.moe_w_gu + (size_t)je * D * 2 * DFE; d.ldw = 2 * DFE; d.k0 = 64 * kb; d.n0 = 32 * nb; d.ks = a.norm_ffn_g + (2 * j + 1) * D; d.WT = (unsigned char*)(F.MGU + (size_t)je * 2 * DFE * D); d.ldwt = D; d.drow0 = gu_row(32 * nb, DFE); return d; } r -= N_MGU;
    { const int je = r / I_MDN, q = r % I_MDN, kb = q / 32, nb = q % 32;
        d.W = a.moe_w_down + (size_t)je * DFE * D; d.ldw = D; d.k0 = 64 * kb; d.n0 = 32 * nb; d.WT = (unsigned char*)F.MDN + (size_t)je * D * DFE; d.ldwt = DFE; d.drow0 = 32 * nb; d.fp8 = 1; return d; }
}
__device__ __forceinline__ void p0_prologue(Frame& F, const Args& a_unused) {
    LAS float* scr = (LAS float*)(F.lds + F.wave * 16384);
    const int gw = F.vcu * NWAVES + F.wave, NGW = F.G * NWAVES, lane = F.lane;
    if (gw < NITEMS) {
        TrDesc dc = tr_decode(F, gw); float tv[32], kv[32];
        tr_load(dc, tv, kv, lane);
        for (int it = gw;;) {
            const int itn = it + NGW; const bool has = itn < NITEMS;
            TrDesc dn = dc; float tn[32], kn[32];
            if (has) { dn = tr_decode(F, itn); tr_load(dn, tn, kn, lane); }
            tr_store(dc, tv, kv, scr, lane);
            if (!has) break;
            dc = dn; it = itn;
#pragma unroll
            for (int i = 0; i < 32; ++i) { tv[i] = tn[i]; kv[i] = kn[i]; }
        }
    }
    const Args& a = fresh_args();
    {
        float sv, cv; sincospif((float)lane * (1.0f / 32.0f), &sv, &cv); const float ctab = cv * 0.125f, stab = sv * 0.125f;
        for (int itq = gw; itq < 4 * 4 * 8 * 16; itq += NGW) {
            const int it = itq >> 2, jq = itq & 3;
            const int l = it >> 7, g = (it >> 4) & 7, db = it & 15, d = db * 64 + lane;
            const float* wsrc = a.w_branch + ((size_t)(l * 3 + 1) * 512 + g * 64) * D + d;
            float w[64];
#pragma unroll
            for (int c = 0; c < 64; ++c) w[c] = wsrc[(size_t)c * D];
            bf16* dst = F.WBR + (size_t)l * D * BRP + (size_t)d * BRP + 512 + g * 64;
            for (int j = 16 * jq; j < 16 * jq + 16; ++j) {
                float ac = 0.f, as = 0.f;
#pragma unroll
                for (int c = 0; c < 64; ++c) { const int mi = (j * c) & 63; ac += __uint_as_float((unsigned)__builtin_amdgcn_readlane((int)__float_as_uint(ctab), mi)) * w[c]; as += __uint_as_float((unsigned)__builtin_amdgcn_readlane((int)__float_as_uint(stab), mi)) * w[c]; }
                dst[j] = (bf16)(pk2(ac, 0.f) & 0xffffu); dst[512 + j] = (bf16)(pk2(as, 0.f) & 0xffffu);
            }
        }
    }
    const int gt = F.vcu * 512 + F.tid, NGT = F.G * 512;
    for (int o = gt; o < 4 * 8 * 4 * 4096; o += NGT) {
        const int in = o & 63, out = (o >> 6) & 63, mat = (o >> 12) & 3, n = (o >> 14) & 7, l = o >> 17, dir = mat >> 1;
        const float* src = (mat & 1) ? a.lru_wx : a.lru_wa;
        F.WL[o] = (bf16)(pk2(src[((((size_t)(l * 2 + dir) * 8 + n) * 64 + in) * 64) + out], 0.f) & 0xffffu);
    }
    for (int o = gt; o < 4096 + 2048; o += NGT) { u32x4* dst = (u32x4*)(F.GW) + 12288; if (o < 4096) dst[o] = dft_table_entry<0>(o); else dst[o] = dft_table_entry<1>(o - 4096); }
    for (int o = gt; o < 4 * 2 * 512; o += NGT) { const float lam = a.lru_lambda[o]; F.NSP[o] = -8.0f * log1pf(expf(-lam)); }
    for (int o = gt; o < 2 * 1024 * 8; o += NGT) { const int j = o >> 13, k = (o >> 3) & 1023; F.GW[o] = a.norm_ffn_g[(2 * j + 1) * D + k] * a.router_w[o]; }
    for (int m = gw; m < M; m += NGW) {
        const f32x4* xr = (const f32x4*)(a.x + (size_t)m * D) + lane; f32x4 v[4]; float s = 0.f;
#pragma unroll
        for (int j = 0; j < 4; ++j) { v[j] = xr[64 * j]; s += (v[j][0] * v[j][0] + v[j][1] * v[j][1]) + (v[j][2] * v[j][2] + v[j][3] * v[j][3]); }
        s = wave_sum(s);
        u32x2* o8 = (u32x2*)(F.HB + (size_t)m * D) + lane;
#pragma unroll
        for (int j = 0; j < 4; ++j) { u32x2 w; w.x = pk2(v[j][0], v[j][1]); w.y = pk2(v[j][2], v[j][3]); o8[64 * j] = w; }
        { unsigned* q8 = (unsigned*)(F.HB8 + (size_t)m * D) + lane;
#pragma unroll
          for (int j = 0; j < 4; ++j) q8[64 * j] = pk4_fp8(v[j][0], v[j][1], v[j][2], v[j][3]); }
        if (lane == 0) F.RS[m] = (unsigned long long)(s * RS_SCALE);
    }
}

__device__ __forceinline__ f32x4 mfma16(bf16x8 a, bf16x8 b, f32x4 c) { return __builtin_amdgcn_mfma_f32_16x16x32_bf16(a, b, c, 0, 0, 0); }
__device__ __forceinline__ bf16x8 tr_frag(const LAS unsigned char* p0, const LAS unsigned char* p1) {
    const s16x4 lo = __builtin_bit_cast(s16x4, __builtin_amdgcn_ds_read_tr16_b64_v4i16((LAS s16x4*)p0));
    const s16x4 hi = __builtin_bit_cast(s16x4, __builtin_amdgcn_ds_read_tr16_b64_v4i16((LAS s16x4*)p1));
    bf16x8 r; r[0] = lo[0]; r[1] = lo[1]; r[2] = lo[2]; r[3] = lo[3]; r[4] = hi[0]; r[5] = hi[1]; r[6] = hi[2]; r[7] = hi[3]; return r;
}
constexpr int AT_V1 = 65536, AT_RPB = 131072;
struct AttnK { bf16x8 q0, q1; bf16x8 kf[8][2][2]; };
__device__ __forceinline__ void attn_load_k(AttnK& K, const bf16* __restrict__ PROJ, int b, int r, int h, int j, int lane) {
    const int fr = lane & 15, rq = lane >> 4;
    const int rs = min(max(r - 4, 0), 120);
    const int cb = (j == 0) ? 0 : (j == 1) ? 8 : (j == 2) ? 24 : 32;
    const size_t tq = (size_t)b * SEQ + 64 * r + 16 * j + fr;
    const bf16* qp = PROJ + tq * PPITCH + C_Q + h * 64 + 16 * rq;
    K.q0 = *(const bf16x8*)qp; K.q1 = *(const bf16x8*)(qp + 8);
    const bf16* kbase = PROJ + ((size_t)b * SEQ + 64 * rs + cb + fr) * PPITCH + C_K + h * 64 + 16 * rq;
#pragma unroll
    for (int ir = 0; ir < 8; ++ir)
#pragma unroll
        for (int hf = 0; hf < 2; ++hf) {
            const bf16* kp = kbase + (size_t)(64 * ir + 16 * hf) * PPITCH;
            K.kf[ir][hf][0] = *(const bf16x8*)kp; K.kf[ir][hf][1] = *(const bf16x8*)(kp + 8);
        }
}
__device__ __forceinline__ void attn_compute(const AttnK& K, const LAS unsigned char* vt, const LAS float* rpb, bf16* __restrict__ BR, int b, int r, int h, int j, int lane) {
    const int fr = lane & 15, rq = lane >> 4;
    const int rs = min(max(r - 4, 0), 120);
    const int cb = (j == 0) ? 0 : (j == 1) ? 8 : (j == 2) ? 24 : 32;
    const size_t tq = (size_t)b * SEQ + 64 * r + 16 * j + fr;
    f32x4 S[8][2];
#pragma unroll
    for (int ir = 0; ir < 8; ++ir)
#pragma unroll
        for (int hf = 0; hf < 2; ++hf) {
            f32x4 s = {0.f, 0.f, 0.f, 0.f};
            s = mfma16(K.kf[ir][hf][0], K.q0, s); s = mfma16(K.kf[ir][hf][1], K.q1, s);
            S[ir][hf] = s;
        }
    const int c = 16 * j + fr, cs = min(max(c - 8, 0), 48);
    float mx = -1e30f;
#pragma unroll
    for (int ir = 0; ir < 8; ++ir) {
        const LAS float* brow = rpb + (rs + ir - r + 7) * 31;
#pragma unroll
        for (int hf = 0; hf < 2; ++hf)
#pragma unroll
            for (int i = 0; i < 4; ++i) {
                const int kc = cb + 16 * hf + 4 * rq + i; const bool valid = (kc >= cs) && (kc < cs + 16);
                const int bi = min(max(kc - c + 15, 0), 30);
                const float sv = valid ? S[ir][hf][i] + brow[bi] : -1e30f;
                S[ir][hf][i] = sv; mx = fmaxf(mx, sv);
            }
    }
    mx = fmaxf(mx, __shfl_xor(mx, 16)); mx = fmaxf(mx, __shfl_xor(mx, 32));
    float sum = 0.f;
#pragma unroll
    for (int ir = 0; ir < 8; ++ir)
#pragma unroll
        for (int hf = 0; hf < 2; ++hf)
#pragma unroll
            for (int i = 0; i < 4; ++i) { const float p = __builtin_amdgcn_exp2f((S[ir][hf][i] - mx) * 1.44269504f); S[ir][hf][i] = p; sum += p; }
    sum += __shfl_xor(sum, 16); sum += __shfl_xor(sum, 32);
    f32x4 O[4];
#pragma unroll
    for (int d = 0; d < 4; ++d) O[d] = (f32x4){0.f, 0.f, 0.f, 0.f};
    const int q4 = (lane & 15) >> 2, p4 = lane & 3;
    const LAS unsigned char* vb = vt + (cb + 4 * rq + q4) * 128 + 8 * p4;
#pragma unroll
    for (int ir = 0; ir < 8; ++ir) {
        u32x4 pw; pw.x = pk2(S[ir][0][0], S[ir][0][1]); pw.y = pk2(S[ir][0][2], S[ir][0][3]); pw.z = pk2(S[ir][1][0], S[ir][1][1]); pw.w = pk2(S[ir][1][2], S[ir][1][3]);
        const bf16x8 Bp = __builtin_bit_cast(bf16x8, pw);
#pragma unroll
        for (int d = 0; d < 4; ++d) {
            const LAS unsigned char* p0 = vb + (64 * ir) * 128 + 32 * d;
            O[d] = mfma16(tr_frag(p0, p0 + 16 * 128), Bp, O[d]);
        }
    }
    const float inv = 1.0f / sum;
#pragma unroll
    for (int dp = 0; dp < 2; ++dp) { u32x2 w[2];
#pragma unroll
        for (int hh = 0; hh < 2; ++hh) { const int d = 2 * dp + hh; w[hh].x = pk2(O[d][0] * inv, O[d][1] * inv); w[hh].y = pk2(O[d][2] * inv, O[d][3] * inv); }
        *(u32x4*)(BR + tq * BRP + h * 64 + 32 * dp + 16 * (rq & 1) + 4 * (rq & ~1)) = pair16(w[0], w[1]); }
}
constexpr int XP = 544;
constexpr int FX_OFF = 0, FT_OFF = 128 * XP;
template <int NMT, int NNT>
__device__ __forceinline__ void dft_core(const LAS unsigned char* xl, const LAS unsigned char* tl, int wm, int cbase, int lane, f32x4 (&acc)[2][NMT][NNT]) {
#pragma unroll
    for (int p = 0; p < 2; ++p)
#pragma unroll
        for (int m = 0; m < NMT; ++m)
#pragma unroll
            for (int n = 0; n < NNT; ++n) acc[p][m][n] = (f32x4){0.f, 0.f, 0.f, 0.f};
    const int g = lane >> 4, q = (lane & 15) >> 2, p4 = lane & 3;
#pragma unroll 1
    for (int ks = 0; ks < 4; ++ks) {
        bf16x8 Bf[NNT];
#pragma unroll
        for (int n = 0; n < NNT; ++n) {
            const LAS unsigned char* p0 = xl + (32 * ks + 8 * g + q) * XP + (cbase + 16 * n + 4 * p4) * 2;
            Bf[n] = tr_frag(p0, p0 + 4 * XP);
        }
#pragma unroll
        for (int p = 0; p < 2; ++p)
#pragma unroll
            for (int m = 0; m < NMT; ++m) {
                const int tile = p * (2 * NMT) + wm * NMT + m;
                const bf16x8 Af = *(const LAS bf16x8*)(tl + ((tile * 4 + ks) * 64 + lane) * 16);
#pragma unroll
                for (int n = 0; n < NNT; ++n) acc[p][m][n] = mfma16(Bf[n], Af, acc[p][m][n]);
            }
    }
}
__device__ __forceinline__ void dft_load_x(Frame& F, const bf16* src, size_t rstride) {
    const int chunk = F.tid & 31, row0 = F.tid >> 5;
    u32x4 v[8];
#pragma unroll
    for (int it = 0; it < 8; ++it) v[it] = *(const u32x4*)(src + (size_t)(row0 + 16 * it) * rstride + chunk * 8);
#pragma unroll
    for (int it = 0; it < 8; ++it) *(LAS u32x4*)(F.lds + FX_OFF + (row0 + 16 * it) * XP + chunk * 16) = v[it];
}
template <int STEP>
__device__ __forceinline__ u32x4 dft_table_entry(int idx) {
    const int tile = idx >> 8, ks = (idx >> 6) & 3, ln = idx & 63;
    float v[8];
#pragma unroll
    for (int j = 0; j < 8; ++j) {
        const int k = 32 * ks + 8 * (ln >> 4) + j; float sv, cv;
        if (STEP == 0) { const int part = tile >> 3, prow = (tile & 7) * 16 + (ln & 15); const int mi = (prow * k) & 127; sincospif((float)mi * (1.0f / 64.0f), &sv, &cv);
            v[j] = (part == 0 ? cv : -sv) * 0.08838834764831845f; }
        else { const int part = tile >> 2, prow = (tile & 3) * 16 + (ln & 15), pin = k >> 6, n2 = k & 63; const int mi = (prow * n2) & 63; sincospif((float)mi * (1.0f / 32.0f), &sv, &cv);
            v[j] = (part == 0 ? (pin == 0 ? cv : sv) : (pin == 0 ? -sv : cv)) * 0.125f; }
    }
    u32x4 w; w.x = pk2(v[0], v[1]); w.y = pk2(v[2], v[3]); w.z = pk2(v[4], v[5]); w.w = pk2(v[6], v[7]);
    return w;
}
template <int STEP>
__device__ __forceinline__ void dft_fill_table(Frame& F) {
    constexpr int NE = (STEP == 0 ? 16 : 8) * 256;
    const u32x4* src = (const u32x4*)(F.GW) + (STEP == 0 ? 12288 : 16384);
#pragma unroll
    for (int it = 0; it < NE / 512; ++it) { const int idx = F.tid + 512 * it; *(LAS u32x4*)(F.lds + FT_OFF + idx * 16) = src[idx]; }
}
__device__ __forceinline__ void fft_a_unit(Frame& F, int unit) {
    const int b = unit >> 7, n2 = (unit >> 1) & 63, chh = unit & 1, lane = F.lane, wm = F.wave >> 2, wn = F.wave & 3, rq = lane >> 4;
    dft_load_x(F, F.PROJ + ((size_t)b * SEQ + n2) * PPITCH + C_UF + 256 * chh, (size_t)64 * PPITCH);
    LDS_WAIT(); __syncthreads();
#pragma unroll 1
    for (int cp = 0; cp < 2; ++cp) {
    f32x4 acc[2][4][2];
    dft_core<4, 2>(F.lds + FX_OFF, F.lds + FT_OFF, wm, 64 * wn + 32 * cp, lane, acc);
#pragma unroll
    for (int m = 0; m < 4; ++m) {
        const int k1 = 64 * wm + 16 * m + (lane & 15); float sv, cv; sincospif((float)(n2 * k1) * (1.0f / 4096.0f), &sv, &cv);
        u32x2 wre[2], wim[2];
#pragma unroll
        for (int n = 0; n < 2; ++n) {
            float re[4], im[4];
#pragma unroll
            for (int i = 0; i < 4; ++i) { const float tr = acc[0][m][n][i], ti = acc[1][m][n][i]; re[i] = tr * cv + ti * sv; im[i] = ti * cv - tr * sv; }
            wre[n].x = pk2(re[0], re[1]); wre[n].y = pk2(re[2], re[3]); wim[n].x = pk2(im[0], im[1]); wim[n].y = pk2(im[2], im[3]);
        }
        bf16* o0 = F.TP + ((((size_t)(b * 128 + k1) * 2 + 0) * 64 + n2) * 512) + 256 * chh + 64 * wn + 32 * cp + 16 * (rq & 1) + 4 * (rq & ~1);
        *(u32x4*)o0 = pair16(wre[0], wre[1]);
        *(u32x4*)(o0 + 64 * 512) = pair16(wim[0], wim[1]);
    }
    }
    __syncthreads();
}
__device__ __forceinline__ void fft_c_unit(Frame& F, int unit) {
    const int b = unit >> 8, k1 = (unit >> 1) & 127, chh = unit & 1, lane = F.lane, wm = F.wave >> 2, wn = F.wave & 3, rq = lane >> 4;
    dft_load_x(F, F.TP + ((size_t)(b * 128 + k1) * 128) * 512 + 256 * chh, (size_t)512);
    LDS_WAIT(); __syncthreads();
    f32x4 acc[2][2][4];
    dft_core<2, 4>(F.lds + FX_OFF, F.lds + FT_OFF, wm, 64 * wn, lane, acc);
#pragma unroll
    for (int p = 0; p < 2; ++p)
#pragma unroll
        for (int m = 0; m < 2; ++m) {
            const int k2 = 32 * wm + 16 * m + (lane & 15);
            bf16* o0 = F.BR + ((size_t)b * SEQ + k1 + 128 * k2) * BRP + 512 + p * 512 + 256 * chh + 64 * wn + 16 * (rq & 1) + 4 * (rq & ~1);
#pragma unroll
            for (int np = 0; np < 2; ++np) {
                u32x2 w[2];
#pragma unroll
                for (int h = 0; h < 2; ++h) { w[h].x = pk2(acc[p][m][2 * np + h][0], acc[p][m][2 * np + h][1]); w[h].y = pk2(acc[p][m][2 * np + h][2], acc[p][m][2 * np + h][3]); }
                *(u32x4*)(o0 + 32 * np) = pair16(w[0], w[1]);
            }
        }
    __syncthreads();
}

template <bool REV, bool FULL>
__device__ __forceinline__ void lru_scan(const f32x4 (&a)[4], const f32x4 (&bt)[4], float carry_in, f32x4 (&h)[4], f32x4 (&P)[4], float& Atot, float& Btot, int lane) {
    const int rq = lane >> 4, fr = lane & 15;
    float carry = carry_in, At = 1.f;
#pragma unroll
    for (int mm = 0; mm < 4; ++mm) {
        const int mt = REV ? 3 - mm : mm;
        float hl[4], cA[4];
        if (!REV) { hl[0] = bt[mt][0]; cA[0] = a[mt][0];
#pragma unroll
            for (int i = 1; i < 4; ++i) { hl[i] = a[mt][i] * hl[i - 1] + bt[mt][i]; cA[i] = a[mt][i] * cA[i - 1]; } }
        else { hl[3] = bt[mt][3]; cA[3] = a[mt][3];
#pragma unroll
            for (int i = 2; i >= 0; --i) { hl[i] = a[mt][i] * hl[i + 1] + bt[mt][i]; cA[i] = a[mt][i] * cA[i + 1]; } }
        float SA = REV ? cA[0] : cA[3], SB = REV ? hl[0] : hl[3];
        float pA, pB;
        if (!REV) {
            pA = __shfl_up(SA, 16); pB = __shfl_up(SB, 16); if (rq >= 1) { SB = SA * pB + SB; SA = SA * pA; }
            pA = __shfl_up(SA, 32); pB = __shfl_up(SB, 32); if (rq >= 2) { SB = SA * pB + SB; SA = SA * pA; }
        } else {
            pA = __shfl_down(SA, 16); pB = __shfl_down(SB, 16); if (rq <= 2) { SB = SA * pB + SB; SA = SA * pA; }
            pA = __shfl_down(SA, 32); pB = __shfl_down(SB, 32); if (rq <= 1) { SB = SA * pB + SB; SA = SA * pA; }
        }
        float eA, eB;
        if (!REV) { eA = __shfl_up(SA, 16); eB = __shfl_up(SB, 16); if (rq == 0) { eA = 1.f; eB = 0.f; } }
        else { eA = __shfl_down(SA, 16); eB = __shfl_down(SB, 16); if (rq == 3) { eA = 1.f; eB = 0.f; } }
        const float tA = __shfl(SA, REV ? fr : 48 + fr), tB = __shfl(SB, REV ? fr : 48 + fr);
        if (FULL) { const float hs = eA * carry + eB, pe = eA * At;
#pragma unroll
            for (int i = 0; i < 4; ++i) { h[mt][i] += hl[i] + cA[i] * hs; P[mt][i] = cA[i] * pe; } }
        carry = tA * carry + tB; At *= tA;
        __builtin_amdgcn_sched_barrier(0);
    }
    Atot = At; Btot = carry;
}
template <int PASS>
__device__ __forceinline__ void lru_unit(Frame& F, const Args& a, int l, int b, int r) {
    const int w = F.wave, ch0 = 64 * w;
    LAS float* carry_lds = (LAS float*)(F.lds);
    if (PASS == 2) {
        const int ch = F.wave * 64 + lane_id(); float hf = 0.f, hb = 0.f;
        const f32x2* sf = F.LSUM + ((size_t)(0 * 2 + b) * 128) * 512 + ch; const f32x2* sb = F.LSUM + ((size_t)(1 * 2 + b) * 128) * 512 + ch;
        for (int r0 = 0; r0 < r; r0 += 32) {
            f32x2 sv[32];
#pragma unroll
            for (int k = 0; k < 32; ++k) sv[k] = sf[(size_t)min(r0 + k, 127) * 512];
#pragma unroll
            for (int k = 0; k < 32; ++k) if (r0 + k < r) hf = sv[k].x * hf + sv[k].y;
        }
        for (int r0 = 127; r0 > r; r0 -= 32) {
            f32x2 sv[32];
#pragma unroll
            for (int k = 0; k < 32; ++k) sv[k] = sb[(size_t)max(r0 - k, 0) * 512];
#pragma unroll
            for (int k = 0; k < 32; ++k) if (r0 - k > r) hb = sv[k].x * hb + sv[k].y;
        }
        carry_lds[ch] = hf; carry_lds[512 + ch] = hb;
        LDS_WAIT(); __syncthreads();
    }
    const int lane = lane_id(), fr = lane & 15, rq = lane >> 4;
    if constexpr (PASS == 2) {
#pragma unroll 1
        for (int nt = 0; nt < 4; ++nt) {
            const int ch = ch0 + 16 * nt + fr;
            const size_t sb = ((size_t)((b * 128 + r) * 8 + w) * 4 + nt);
            const u32x4* ph = F.LSTH + sb * 128 + lane; const u32x4* pp = F.LSTP + sb * 256 + lane;
            u32x4 hv[2], pf[2], pb[2];
#pragma unroll
            for (int hh = 0; hh < 2; ++hh) { hv[hh] = ph[64 * hh]; pf[hh] = pp[64 * hh]; pb[hh] = pp[128 + 64 * hh]; }
            unsigned short ggv[4][4];
#pragma unroll
            for (int mt = 0; mt < 4; ++mt)
#pragma unroll
                for (int i = 0; i < 4; ++i) ggv[mt][i] = F.PROJ[((size_t)b * SEQ + 64 * r + 16 * mt + 4 * rq + i) * PPITCH + C_UG + ch];
            const float cf = carry_lds[ch], cb = carry_lds[512 + ch];
#pragma unroll
            for (int mt = 0; mt < 4; ++mt)
#pragma unroll
                for (int i = 0; i < 4; ++i) {
                    const int hh = mt >> 1, dwi = (mt & 1) * 2 + (i >> 1);
                    const unsigned hw = hv[hh][dwi], fw = pf[hh][dwi], bw = pb[hh][dwi];
                    const float hval = (i & 1) ? bfhi(hw) : bflo(hw), fval = (i & 1) ? bfhi(fw) : bflo(fw), bval = (i & 1) ? bfhi(bw) : bflo(bw);
                    const size_t tok = (size_t)b * SEQ + 64 * r + 16 * mt + 4 * rq + i;
                    F.BR[tok * BRP + 1536 + ch] = (bf16)(pk2((hval + fval * cf + bval * cb) * bf2f(ggv[mt][i]), 0.f) & 0xffffu);
                }
        }
        __syncthreads();
        return;
    }
    bf16x8 Af[4][2];
#pragma unroll
    for (int ks = 0; ks < 2; ++ks) {
        const int chA = ch0 + 32 * ks + 8 * rq;
        float cw[4][8], cbv[8];
#pragma unroll
        for (int t = 0; t < 4; ++t) { const f32x4 w0 = *(const f32x4*)(a.conv_w + ((size_t)l * 4 + t) * 512 + chA), w1 = *(const f32x4*)(a.conv_w + ((size_t)l * 4 + t) * 512 + chA + 4);
            cw[t][0] = w0[0]; cw[t][1] = w0[1]; cw[t][2] = w0[2]; cw[t][3] = w0[3]; cw[t][4] = w1[0]; cw[t][5] = w1[1]; cw[t][6] = w1[2]; cw[t][7] = w1[3]; }
        { const f32x4 b0 = *(const f32x4*)(a.conv_b + (size_t)l * 512 + chA), b1 = *(const f32x4*)(a.conv_b + (size_t)l * 512 + chA + 4);
            cbv[0] = b0[0]; cbv[1] = b0[1]; cbv[2] = b0[2]; cbv[3] = b0[3]; cbv[4] = b1[0]; cbv[5] = b1[1]; cbv[6] = b1[2]; cbv[7] = b1[3]; }
#pragma unroll
        for (int mt = 0; mt < 4; ++mt) {
            const int s = 64 * r + 16 * mt + fr;
            float c8[8];
#pragma unroll
            for (int e = 0; e < 8; ++e) c8[e] = cbv[e];
#pragma unroll
            for (int t = 0; t < 4; ++t) {
                const int sp = s + t - 2;
                if (sp >= 0 && sp < SEQ) {
                    const u32x4 uv = *(const u32x4*)(F.PROJ + ((size_t)b * SEQ + sp) * PPITCH + C_UX + chA);
                    c8[0] += cw[t][0] * bflo(uv.x); c8[1] += cw[t][1] * bfhi(uv.x); c8[2] += cw[t][2] * bflo(uv.y); c8[3] += cw[t][3] * bfhi(uv.y);
                    c8[4] += cw[t][4] * bflo(uv.z); c8[5] += cw[t][5] * bfhi(uv.z); c8[6] += cw[t][6] * bflo(uv.w); c8[7] += cw[t][7] * bfhi(uv.w);
                }
            }
            u32x4 pw; pw.x = pk2(c8[0], c8[1]); pw.y = pk2(c8[2], c8[3]); pw.z = pk2(c8[4], c8[5]); pw.w = pk2(c8[6], c8[7]);
            Af[mt][ks] = __builtin_bit_cast(bf16x8, pw);
            __builtin_amdgcn_sched_barrier(0);
        }
    }
    const bf16* WLb = F.WL + ((size_t)(l * 8 + w) * 4) * 4096;
#pragma unroll 1
    for (int nt = 0; nt < 4; ++nt) {
        const int ch = ch0 + 16 * nt + fr;
        f32x4 cD[4];
#pragma unroll
        for (int mt = 0; mt < 4; ++mt) cD[mt] = (f32x4){0.f, 0.f, 0.f, 0.f};
#pragma unroll
        for (int ks = 0; ks < 2; ++ks) {
            bf16x8 I8;
#pragma unroll
            for (int j = 0; j < 8; ++j) I8[j] = (32 * ks + 8 * rq + j == 16 * nt + fr) ? (short)0x3F80 : (short)0;
#pragma unroll
            for (int mt = 0; mt < 4; ++mt) cD[mt] = mfma16(Af[mt][ks], I8, cD[mt]);
        }
        f32x4 hsum[4];
#pragma unroll
        for (int mt = 0; mt < 4; ++mt) hsum[mt] = (f32x4){0.f, 0.f, 0.f, 0.f};
        bf16x8 Bw[2][2][2];
#pragma unroll
        for (int dir = 0; dir < 2; ++dir)
#pragma unroll
            for (int mat = 0; mat < 2; ++mat)
#pragma unroll
                for (int ks = 0; ks < 2; ++ks) Bw[dir][mat][ks] = *(const bf16x8*)(WLb + (size_t)(2 * dir + mat) * 4096 + (16 * nt + fr) * 64 + 32 * ks + 8 * rq);
        float pba[2], pbx[2], pns[2];
#pragma unroll
        for (int dir = 0; dir < 2; ++dir) { pba[dir] = -1.44269504f * a.lru_ba[(size_t)(l * 2 + dir) * 512 + ch]; pbx[dir] = -1.44269504f * a.lru_bx[(size_t)(l * 2 + dir) * 512 + ch]; pns[dir] = 1.44269504f * F.NSP[(l * 2 + dir) * 512 + ch]; }
#pragma unroll
        for (int dir = 0; dir < 2; ++dir) {
            __builtin_amdgcn_sched_barrier(0);
            f32x4 xa[4], xx[4];
#pragma unroll
            for (int mt = 0; mt < 4; ++mt) { xa[mt] = (f32x4){0.f, 0.f, 0.f, 0.f}; xx[mt] = (f32x4){0.f, 0.f, 0.f, 0.f}; }
#pragma unroll
            for (int ks = 0; ks < 2; ++ks) {
#pragma unroll
                for (int mt = 0; mt < 4; ++mt) { xa[mt] = mfma16(Af[mt][ks], Bw[dir][0][ks], xa[mt]); xx[mt] = mfma16(Af[mt][ks], Bw[dir][1][ks], xx[mt]); }
            }
            const float ba = pba[dir], bx = pbx[dir], ns = pns[dir];
            f32x4 av[4], bt[4]; float igc_first = 0.f, igc_last = 0.f;
#pragma unroll
            for (int mt = 0; mt < 4; ++mt)
#pragma unroll
                for (int i = 0; i < 4; ++i) {
                    const float rg = __builtin_amdgcn_rcpf(1.0f + __builtin_amdgcn_exp2f(__builtin_fmaf(xa[mt][i], -1.44269504f, ba)));
                    const float ig = __builtin_amdgcn_rcpf(1.0f + __builtin_amdgcn_exp2f(__builtin_fmaf(xx[mt][i], -1.44269504f, bx)));
                    const float aa = __builtin_amdgcn_exp2f(ns * rg);
                    const float mult = __builtin_amdgcn_sqrtf(fmaxf(__builtin_fmaf(-aa, aa, 1.0f), 0.f));
                    const float igc = ig * cD[mt][i];
                    if (mt == 0 && i == 0) igc_first = igc;
                    if (mt == 3 && i == 3) igc_last = igc;
                    av[mt][i] = aa; bt[mt][i] = mult * igc;
                    if (i == 3) __builtin_amdgcn_sched_barrier(0);
                }
            if (dir == 0) { if (r == 0 && rq == 0) bt[0][0] = igc_first; }
            else { if (r == 127 && rq == 3) bt[3][3] = igc_last; }
            float At, Bt; f32x4 Pd[4];
            if (dir == 0) lru_scan<false, true>(av, bt, 0.f, hsum, Pd, At, Bt, lane); else lru_scan<true, true>(av, bt, 0.f, hsum, Pd, At, Bt, lane);
            if (rq == 0) { f32x2 sm; sm.x = At; sm.y = Bt; F.LSUM[((size_t)(dir * 2 + b) * 128 + r) * 512 + ch] = sm; }
            { u32x4* pp = F.LSTP + ((size_t)((b * 128 + r) * 8 + w) * 4 + nt) * 256 + dir * 128 + lane;
#pragma unroll
              for (int hh = 0; hh < 2; ++hh) { u32x4 o; o.x = pk2(Pd[2 * hh][0], Pd[2 * hh][1]); o.y = pk2(Pd[2 * hh][2], Pd[2 * hh][3]); o.z = pk2(Pd[2 * hh + 1][0], Pd[2 * hh + 1][1]); o.w = pk2(Pd[2 * hh + 1][2], Pd[2 * hh + 1][3]); pp[64 * hh] = o; } }

        }
        { u32x4* ph = F.LSTH + ((size_t)((b * 128 + r) * 8 + w) * 4 + nt) * 128 + lane;
#pragma unroll
          for (int hh = 0; hh < 2; ++hh) { u32x4 o; o.x = pk2(hsum[2 * hh][0], hsum[2 * hh][1]); o.y = pk2(hsum[2 * hh][2], hsum[2 * hh][3]); o.z = pk2(hsum[2 * hh + 1][0], hsum[2 * hh + 1][1]); o.w = pk2(hsum[2 * hh + 1][2], hsum[2 * hh + 1][3]); ph[64 * hh] = o; } }
    }
}

__device__ __forceinline__ void moe_router(Frame& F, int jm, const unsigned long long* rs) {
    const int gw = F.vcu * NWAVES + F.wave, NGW = F.G * NWAVES, lane = F.lane;
    const float* GWj = F.GW + (size_t)jm * 1024 * 8;
    unsigned* cnt = F.ctl + CW_MOE + jm * 8 * 64;
    LAS float* gwt = (LAS float*)F.lds;
    for (int i = F.tid; i < 1024 * 8; i += 512) gwt[(i & 7) * 1024 + (i >> 3)] = GWj[i];
    LDS_WAIT(); __syncthreads();
    for (int t = gw; t < M; t += NGW) {
        const u32x2* hr = (const u32x2*)(F.HB + (size_t)t * D) + lane;
        float lg[8];
#pragma unroll
        for (int e = 0; e < 8; ++e) lg[e] = 0.f;
#pragma unroll
        for (int j = 0; j < 4; ++j) {
            const u32x2 hw = hr[64 * j]; const float hv[4] = {bflo(hw.x), bfhi(hw.x), bflo(hw.y), bfhi(hw.y)}; const int k0 = 4 * lane + 256 * j;
#pragma unroll
            for (int e = 0; e < 8; ++e) { const f32x4 g = *(const LAS f32x4*)(gwt + e * 1024 + k0); lg[e] += (hv[0] * g[0] + hv[1] * g[1]) + (hv[2] * g[2] + hv[3] * g[3]); }
        }
#pragma unroll
        for (int e = 0; e < 8; ++e) lg[e] = wave_sum(lg[e]);
        const float sr = 1.0f / sqrtf((float)rs[t] * (1.0f / (RS_SCALE * D)) + RMS_EPS);
        int e0 = 0; float v0 = lg[0];
#pragma unroll
        for (int e = 1; e < 8; ++e) if (lg[e] > v0) { v0 = lg[e]; e0 = e; }
        int e1 = -1; float v1 = -3.0e38f;
#pragma unroll
        for (int e = 0; e < 8; ++e) if (e != e0 && lg[e] > v1) { v1 = lg[e]; e1 = e; }
        const float w0 = 1.0f / (1.0f + expf((v1 - v0) * sr)), w1 = 1.0f - w0;
        if (lane == 0) {
            const int p0 = (int)atomicAdd(cnt + e0 * 64, 1u), p1 = (int)atomicAdd(cnt + e1 * 64, 1u);
            F.LIST[e0 * 16384 + p0] = t; F.LIST[e1 * 16384 + p1] = t;
            F.SROW[e0 * 16384 + p0] = sr; F.SROW[e1 * 16384 + p1] = sr;
            F.WSLOT[e0 * 16384 + p0] = w0; F.WSLOT[e1 * 16384 + p1] = w1;
            int4 ti; ti.x = e0; ti.y = p0; ti.z = e1; ti.w = p1; ((int4*)F.TOKI)[t] = ti;
        }
    }
    __syncthreads();
}
__device__ __forceinline__ void moe_sched_init(Frame& F, int jm, pg8::SchedMoe& S) {
    const unsigned* cnt = F.ctl + CW_MOE + jm * 8 * 64;
#define RFL(x) __builtin_amdgcn_readfirstlane((int)(x))
    S.cntp = cnt;
    const int c0 = RFL(cnt[0]), c1 = RFL(cnt[64]), c2 = RFL(cnt[128]), c3 = RFL(cnt[192]), c4 = RFL(cnt[256]), c5 = RFL(cnt[320]), c6 = RFL(cnt[384]), c7 = RFL(cnt[448]);
#undef RFL
    S.t1 = (c0 + 255) >> 8; S.t2 = S.t1 + ((c1 + 255) >> 8); S.t3 = S.t2 + ((c2 + 255) >> 8); S.t4 = S.t3 + ((c3 + 255) >> 8);
    S.t5 = S.t4 + ((c4 + 255) >> 8); S.t6 = S.t5 + ((c5 + 255) >> 8); S.t7 = S.t6 + ((c6 + 255) >> 8); S.t8 = S.t7 + ((c7 + 255) >> 8);
}
__device__ __forceinline__ void moe_combine(Frame& F, const Args& a, int jm, unsigned long long* rs_next, bool final_layer) {
    const int gw = F.vcu * NWAVES + F.wave, NGW = F.G * NWAVES, lane = F.lane;
    pg8::SchedMoe S; moe_sched_init(F, jm, S);
    for (int t = gw; t < M; t += NGW) {
        const int4 ti = ((const int4*)F.TOKI)[t];
        const int ta = ti.x == 0 ? 0 : ti.x == 1 ? S.t1 : ti.x == 2 ? S.t2 : ti.x == 3 ? S.t3 : ti.x == 4 ? S.t4 : ti.x == 5 ? S.t5 : ti.x == 6 ? S.t6 : S.t7;
        const int tb = ti.z == 0 ? 0 : ti.z == 1 ? S.t1 : ti.z == 2 ? S.t2 : ti.z == 3 ? S.t3 : ti.z == 4 ? S.t4 : ti.z == 5 ? S.t5 : ti.z == 6 ? S.t6 : S.t7;
        const size_t s0 = (size_t)ta * 256 + ti.y, s1 = (size_t)tb * 256 + ti.w;
        u32x2* hr = (u32x2*)(F.HB + (size_t)t * D) + lane;
        const u32x2* y0 = (const u32x2*)(F.YBUF + s0 * D) + lane; const u32x2* y1 = (const u32x2*)(F.YBUF + s1 * D) + lane;
        f32x4 v[4]; float ss = 0.f;
#pragma unroll
        for (int j = 0; j < 4; ++j) { const u32x2 a0 = y0[64 * j], a1 = y1[64 * j], hw = hr[64 * j]; f32x4 hv;
            hv[0] = bflo(hw.x) + bflo(a0.x) + bflo(a1.x); hv[1] = bfhi(hw.x) + bfhi(a0.x) + bfhi(a1.x); hv[2] = bflo(hw.y) + bflo(a0.y) + bflo(a1.y); hv[3] = bfhi(hw.y) + bfhi(a0.y) + bfhi(a1.y);
            v[j] = hv; ss += (hv[0] * hv[0] + hv[1] * hv[1]) + (hv[2] * hv[2] + hv[3] * hv[3]); }
        ss = wave_sum(ss);
        if (final_layer) {
            const float sr = 1.0f / sqrtf(ss * (1.0f / D) + RMS_EPS);
            f32x4* orow = (f32x4*)(F.H + (size_t)t * D) + lane;
#pragma unroll
            for (int j = 0; j < 4; ++j) { const f32x4 g = *((const f32x4*)a.final_g + lane + 64 * j); orow[64 * j] = v[j] * sr * g; }
        } else {
#pragma unroll
            for (int j = 0; j < 4; ++j) { u32x2 w; w.x = pk2(v[j][0], v[j][1]); w.y = pk2(v[j][2], v[j][3]); hr[64 * j] = w; }
            { unsigned* q8 = (unsigned*)(F.HB8 + (size_t)t * D) + lane;
#pragma unroll
              for (int j = 0; j < 4; ++j) q8[64 * j] = pk4_fp8(v[j][0], v[j][1], v[j][2], v[j][3]); }
            if (lane == 0) rs_next[t] = (unsigned long long)(ss * RS_SCALE);
        }
    }
}

__device__ __forceinline__ Frame mk_frame(const Args& args, LAS unsigned char* ldsp, int wave0) {
    Frame F;
    F.lds = ldsp;
    F.tid = tid_of(wave0); F.lane = F.tid & 63; F.wave = __builtin_amdgcn_readfirstlane(F.tid >> 6);
    F.G = gridDim.x; { const int bx = blockIdx.x; F.vcu = (F.G % 8 == 0) ? (bx % 8) * (F.G / 8) + bx / 8 : bx; }
    size_t zoff = 0; asm volatile("" : "+s"(zoff)); unsigned char* ws = args.ws + zoff; float* outp = args.out + zoff;
    F.ctl = (unsigned*)(ws + WS_CTL); F.H = outp;
    F.HB8 = ws + WS_HB8; F.HB = (bf16*)(ws + WS_HB); F.VT = nullptr; F.WIN8 = ws + WS_WIN8; F.BR = (bf16*)(ws + WS_BR); F.TP = (bf16*)(ws + WS_TP); F.MERGED = (bf16*)(ws + WS_MERGED);
    F.PROJ = (bf16*)(ws + WS_PROJ); F.HID = (bf16*)(ws + WS_HID); F.YBUF = (bf16*)(ws + WS_YBUF);
    F.WIN = (bf16*)(ws + WS_WIN); F.WBR = (bf16*)(ws + WS_WBR); F.WOUT = (bf16*)(ws + WS_WOUT); F.WGU = (bf16*)(ws + WS_WGU); F.WDN = (bf16*)(ws + WS_WDN);
    F.MGU = (bf16*)(ws + WS_MGU); F.MDN = (bf16*)(ws + WS_MDN); F.WL = (bf16*)(ws + WS_WL);
    F.NSP = (float*)(ws + WS_MISC); F.GW = (float*)(ws + WS_MISC + 65536); F.LSUM = (f32x2*)(ws + WS_LSUM); F.LSTH = (u32x4*)(ws + WS_LSTH); F.LSTP = (u32x4*)(ws + WS_LSTP); F.RS = (unsigned long long*)(ws + WS_RS);
    F.LIST = (int*)(ws + WS_MOEI); F.SROW = (float*)(ws + WS_MOEI + 524288); F.WSLOT = (float*)(ws + WS_MOEI + 2 * 524288); F.TOKI = (int*)(ws + WS_MOEI + 3 * 524288);
    return F;
}
__global__ void __launch_bounds__(NWAVES * 64, 2) enc_fwd(Args args) {
    extern __shared__ __attribute__((aligned(16))) unsigned char lds[];
    LAS unsigned char* const ldsp = (LAS unsigned char*)lds;
    volatile LAS unsigned* MISC = (volatile LAS unsigned*)(ldsp + MISC_OFF);
    const int wave0 = __builtin_amdgcn_readfirstlane((int)threadIdx.x >> 6);
    for (int u = wave0 * 64 + lane_id(); u < (LDS_BYTES - MISC_OFF) / 4; u += NWAVES * 64) ((LAS unsigned*)(ldsp + MISC_OFF))[u] = 0u;
    __syncthreads();
    XcdBarrier bar = xcd_barrier_post((unsigned*)(args.ws + WS_CTL) + CW_BAR + args.bar_region * XCD_BAR_WORDS, MISC + 8, wave0);
    const int lo = args.ph_lo, hi = args.ph_hi;
#ifndef PHASE_MASK
#define PHASE_MASK 0xFFFF
#endif
#define PM(k) (((PHASE_MASK) >> (k)) & 1)
#define IN(k) (lo <= (k) && (k) < hi)
#define SEAM(k) do { if (IN(k) && IN((k) + 1)) xcd_barrier(bar, wave0); } while (0)
#define RETID() Frame F = mk_frame(args, ldsp, wave0)

    if (PM(0) && IN(0)) { RETID(); p0_prologue(F, args); }
    SEAM(0);
#pragma unroll 1
    for (int l = 0; l < DEPTH; ++l) {
        const int pb = 1 + 9 * l;
        if (PM(1) && IN(pb + 0)) {
            RETID();
            { pg8::SchedPlain S; S.A = (const char*)F.HB; S.B = (const char*)(F.WIN + (size_t)l * INC * D); S.lda2 = D * 2; S.ldb2 = D * 2; S.nt = D / 64; S.nM = M / 256; S.nN = 12; S.G = F.G; S.c = (int)blockIdx.x;
              pg8::EpiProj<false> E; E.P = F.PROJ; E.VT = F.VT; E.bias = args.b_in + (size_t)l * INC; E.rs = F.RS + (size_t)(2 * l) * M; E.pn_off = 0; E.cs = 1.0f;
              pg8::gemm_phase<pg8::EpiProj<false>, pg8::SchedPlain, true, false>(F.lds, S, E, wave0); }
        }
        if (PM(1) && IN(pb + 0)) {
            RETID();
            { pg8::SchedPlain S; S.A = (const char*)F.HB8; S.B = (const char*)(F.WIN8 + (size_t)l * 3072 * D); S.lda2 = D; S.ldb2 = D; S.nt = D / 128; S.nM = M / 256; S.nN = 12; S.G = F.G; S.c = (int)blockIdx.x;
              pg8::EpiProj<true> E; E.P = F.PROJ; E.VT = F.VT; E.bias = args.b_in + (size_t)l * INC; E.rs = F.RS + (size_t)(2 * l) * M; E.pn_off = 12; E.cs = 1.0f / W8S;
              pg8::gemm_phase<pg8::EpiProj<true>, pg8::SchedPlain, true, false, true>(F.lds, S, E, wave0); }
        }
        SEAM(pb + 0);
        if (PM(2) && IN(pb + 1)) {
            RETID();
#ifndef P2M
#define P2M 7
#endif
            if (P2M & 1) {
            dft_fill_table<0>(F);
            LDS_WAIT(); __syncthreads();
            for (int u = F.vcu; u < 256; u += F.G) fft_a_unit(F, u);
            __syncthreads(); }
            if (P2M & 2) {
            for (int u = F.vcu; u < 256; u += F.G) { const int b = u >> 7, r = u & 127, rs = min(max(r - 4, 0), 120);
#pragma unroll 1
                for (int hp = 0; hp < 4; ++hp) {
                    const int h = 2 * hp + (F.wave >> 2), j = F.wave & 3;
                    AttnK K; attn_load_k(K, F.PROJ, b, r, h, j, F.lane);
                    __syncthreads();
                    { const int chunk = F.tid & 15, t0 = F.tid >> 4;
                      const bf16* vsrc = F.PROJ + ((size_t)b * SEQ + 64 * rs) * PPITCH + C_V + 128 * hp + 8 * chunk;
#pragma unroll 1
                      for (int hh = 0; hh < 2; ++hh) {
                      u32x4 vv[8];
#pragma unroll
                      for (int it = 0; it < 8; ++it) vv[it] = *(const u32x4*)(vsrc + (size_t)(t0 + 32 * (8 * hh + it)) * PPITCH);
#pragma unroll
                      for (int it = 0; it < 8; ++it) *(LAS u32x4*)(F.lds + (chunk >> 3) * AT_V1 + (t0 + 32 * (8 * hh + it)) * 128 + (chunk & 7) * 16) = vv[it];
                      }
                      const float* rp = args.na_rpb + ((size_t)l * 8 + 2 * hp) * 465; LAS float* rl = (LAS float*)(F.lds + AT_RPB);
                      for (int i = F.tid; i < 2 * 465; i += 512) rl[i] = rp[i]; }
                    LDS_WAIT(); __syncthreads();
                    attn_compute(K, F.lds + (F.wave >> 2) * AT_V1, (const LAS float*)(F.lds + AT_RPB) + (F.wave >> 2) * 465, F.BR, b, r, h, j, F.lane);
                } }
            __syncthreads(); }
            if (P2M & 4) for (int u = F.vcu; u < 256; u += F.G) lru_unit<1>(F, args, l, u >> 7, u & 127);
        }
        SEAM(pb + 1);
        if (PM(3) && IN(pb + 2)) {
            RETID();
            dft_fill_table<1>(F);
            LDS_WAIT(); __syncthreads();
            for (int u = F.vcu; u < 512; u += F.G) fft_c_unit(F, u);
            __syncthreads();
            for (int u = F.vcu; u < 256; u += F.G) lru_unit<2>(F, args, l, u >> 7, u & 127);
        }
        SEAM(pb + 2);
        if (PM(4) && IN(pb + 3)) {
            RETID();
            pg8::SchedMerge S; S.A = (const char*)F.BR; S.B = (const char*)(F.WBR + (size_t)l * D * BRP); S.lda2 = BRP * 2; S.ldb2 = BRP * 2; S.nM = M / 256; S.nN = D / 256; S.G = F.G; S.c = (int)blockIdx.x;
            pg8::EpiMerge E; E.G = (const unsigned char*)(F.PROJ + C_GATE); E.O = F.MERGED;
            pg8::gemm_phase<pg8::EpiMerge, pg8::SchedMerge, true, false>(F.lds, S, E, wave0);
        }
        SEAM(pb + 3);
        if (PM(5) && IN(pb + 4)) {
            RETID();
            pg8::SchedPlain S; S.A = (const char*)F.MERGED; S.B = (const char*)(F.WOUT + (size_t)l * D * D); S.lda2 = D * 2; S.ldb2 = D * 2; S.nt = D / 64; S.nM = M / 256; S.nN = D / 256; S.G = F.G; S.c = (int)blockIdx.x;
            pg8::EpiOut E; E.hb = F.HB; E.rs = F.RS + (size_t)(2 * l + 1) * M; E.hb8 = nullptr; E.cs = 1.0f;
            pg8::gemm_phase<pg8::EpiOut, pg8::SchedPlain, true, false>(F.lds, S, E, wave0);
        }
        SEAM(pb + 4);
        if ((l & 1) == 0) {
            const int j = l >> 1;
            if (PM(6) && IN(pb + 5)) {
                RETID();
                pg8::SchedPlain S; S.A = (const char*)F.HB; S.B = (const char*)(F.WGU + (size_t)j * 2 * DFF * D); S.lda2 = D * 2; S.ldb2 = D * 2; S.nt = D / 64; S.nM = M / 256; S.nN = 2 * DFF / 256; S.G = F.G; S.c = (int)blockIdx.x;
                pg8::EpiGU E; E.Hd = (unsigned char*)F.HID; E.ldh = DFF; E.rs = F.RS + (size_t)(2 * l + 1) * M; E.srow = nullptr; E.moe = false; E.cs = 1.0f;
                pg8::gemm_phase<pg8::EpiGU, pg8::SchedPlain, true, false, false>(F.lds, S, E, wave0);
            }
            SEAM(pb + 5);
            if (PM(7) && IN(pb + 6)) {
                RETID();
                pg8::SchedPlain S; S.A = (const char*)F.HID; S.B = (const char*)F.WDN + (size_t)j * D * DFF; S.lda2 = DFF; S.ldb2 = DFF; S.nt = DFF / 128; S.nM = M / 256; S.nN = D / 256; S.G = F.G; S.c = (int)blockIdx.x;
                pg8::EpiOut E; E.hb = F.HB; E.rs = F.RS + (size_t)(2 * l + 2) * M; E.hb8 = F.HB8; E.cs = 1.0f / (W8S * H8S);
                pg8::gemm_phase<pg8::EpiOut, pg8::SchedPlain, true, false, true>(F.lds, S, E, wave0);
            }
            SEAM(pb + 6);
        } else {
            const int jm = l >> 1;
            if (PM(8) && IN(pb + 5)) { RETID(); moe_router(F, jm, F.RS + (size_t)(2 * l + 1) * M); }
            SEAM(pb + 5);
            if (PM(9) && IN(pb + 6)) {
                RETID();
                pg8::SchedMoe S; moe_sched_init(F, jm, S);
                S.A = (const char*)F.HB; S.B = (const char*)(F.MGU + (size_t)(jm * 8) * 2 * DFE * D); S.list = F.LIST; S.lda2 = D * 2; S.ldb2 = D * 2; S.nt = D / 64; S.nN = 2 * DFE / 256; S.G = F.G; S.c = (int)blockIdx.x;
                S.bstride = (size_t)2 * DFE * D * 2; S.gather = true;
                pg8::EpiGU E; E.Hd = (unsigned char*)F.HID; E.ldh = DFE; E.rs = nullptr; E.srow = F.SROW; E.moe = true; E.cs = 1.0f;
                pg8::gemm_phase<pg8::EpiGU, pg8::SchedMoe, true, true, false>(F.lds, S, E, wave0);
            }
            SEAM(pb + 6);
            if (PM(10) && IN(pb + 7)) {
                RETID();
                pg8::SchedMoe S; moe_sched_init(F, jm, S);
                S.A = (const char*)F.HID; S.B = (const char*)F.MDN + (size_t)(jm * 8) * D * DFE; S.list = F.LIST; S.lda2 = DFE; S.ldb2 = DFE; S.nt = DFE / 128; S.nN = D / 256; S.G = F.G; S.c = (int)blockIdx.x;
                S.bstride = (size_t)D * DFE; S.gather = false;
                pg8::EpiMoeDown E; E.Y = F.YBUF; E.wslot = F.WSLOT;
                pg8::gemm_phase<pg8::EpiMoeDown, pg8::SchedMoe, true, false, true>(F.lds, S, E, wave0);
            }
            SEAM(pb + 7);
            if (PM(11) && IN(pb + 8)) { RETID(); moe_combine(F, args, jm, F.RS + (size_t)((2 * l + 2) & 7) * M, l == DEPTH - 1); }
            SEAM(pb + 8);
        }
    }
#undef IN
#undef SEAM
}

#ifndef ABL
#define ABL 0
#endif
#ifndef MK_PER_PHASE
#define MK_PER_PHASE 0
#endif
extern "C" void kernel_launch(void* const* d_in, const int* in_sizes, int n_in, void* d_out, int out_size, void* d_ws, size_t ws_size, hipStream_t stream) {
    static int grid = 0;
    if (grid == 0) {
        if (n_in != 21 || out_size != M * D || ws_size < WS_END) { fprintf(stderr, "kernel_launch: unexpected shapes (n_in %d out %d ws %zu)\n", n_in, out_size, ws_size); grid = -1; return; }
        int dev = 0, cus = 0, per_cu = 0;
        if (hipGetDevice(&dev) != hipSuccess || hipDeviceGetAttribute(&cus, hipDeviceAttributeMultiprocessorCount, dev) != hipSuccess) { grid = -1; return; }
        if (hipFuncSetAttribute((const void*)enc_fwd, hipFuncAttributeMaxDynamicSharedMemorySize, LDS_BYTES) != hipSuccess) { fprintf(stderr, "kernel_launch: hipFuncSetAttribute failed\n"); grid = -1; return; }
        if (hipOccupancyMaxActiveBlocksPerMultiprocessor(&per_cu, (const void*)enc_fwd, NWAVES * 64, LDS_BYTES) != hipSuccess || per_cu < 1)
            fprintf(stderr, "kernel_launch: note: occupancy query reports %d workgroups per CU\n", per_cu);
        (void)hipGetLastError();
        grid = cus;
    }
    if (grid < 0) return;
    (void)hipMemsetAsync((char*)d_ws + WS_CTL, 0, CTL_ZERO_BYTES, stream);
    (void)hipMemsetAsync((char*)d_ws + WS_RS, 0, 1 * MiB, stream);
    Args a{};
    a.x = (const float*)d_in[0]; a.norm_mix_g = (const float*)d_in[1]; a.w_in = (const float*)d_in[2]; a.b_in = (const float*)d_in[3]; a.na_rpb = (const float*)d_in[4];
    a.conv_w = (const float*)d_in[5]; a.conv_b = (const float*)d_in[6]; a.lru_wa = (const float*)d_in[7]; a.lru_ba = (const float*)d_in[8]; a.lru_wx = (const float*)d_in[9];
    a.lru_bx = (const float*)d_in[10]; a.lru_lambda = (const float*)d_in[11]; a.w_branch = (const float*)d_in[12]; a.w_out = (const float*)d_in[13]; a.norm_ffn_g = (const float*)d_in[14];
    a.ffn_w_gu = (const float*)d_in[15]; a.ffn_w_down = (const float*)d_in[16]; a.router_w = (const float*)d_in[17]; a.moe_w_gu = (const float*)d_in[18]; a.moe_w_down = (const float*)d_in[19];
    a.final_g = (const float*)d_in[20];
    a.out = (float*)d_out; a.ws = (unsigned char*)d_ws;
    constexpr int NPH = 1 + 9 * DEPTH;
#ifndef PROBE_LO
#define PROBE_LO -1
#define PROBE_HI -1
#endif
    if (PROBE_LO >= 0) {
        a.ph_lo = 0; a.ph_hi = PROBE_HI; a.bar_region = 0; hipLaunchKernelGGL(enc_fwd, dim3(grid), dim3(NWAVES * 64), LDS_BYTES, stream, a);
        a.ph_lo = PROBE_LO; a.ph_hi = PROBE_HI; a.bar_region = 1; hipLaunchKernelGGL(enc_fwd, dim3(grid), dim3(NWAVES * 64), LDS_BYTES, stream, a);
        a.ph_lo = PROBE_HI; a.ph_hi = NPH; a.bar_region = 2; hipLaunchKernelGGL(enc_fwd, dim3(grid), dim3(NWAVES * 64), LDS_BYTES, stream, a);
    } else {
        a.ph_lo = 0; a.ph_hi = NPH; a.bar_region = 0;
        hipLaunchKernelGGL(enc_fwd, dim3(grid), dim3(NWAVES * 64), LDS_BYTES, stream, a);
    }
    const hipError_t le = hipPeekAtLastError();
    if (le != hipSuccess) fprintf(stderr, "kernel_launch: launch failed: %s\n", hipGetErrorName(le));
}
```

```cpp
#include <hip/hip_runtime.h>
#include <cstdio>
#include <cstdint>

#ifndef ABL
#define ABL 0
#endif
#define LAS __attribute__((address_space(3)))
#define GAS __attribute__((address_space(1)))
typedef unsigned short bf16;
typedef short bf16x8 __attribute__((ext_vector_type(8)));
typedef short s16x4 __attribute__((ext_vector_type(4)));
typedef float f32x4 __attribute__((ext_vector_type(4)));
typedef float f32x2 __attribute__((ext_vector_type(2)));
typedef unsigned u32x4 __attribute__((ext_vector_type(4)));
typedef unsigned u32x2 __attribute__((ext_vector_type(2)));
typedef __bf16 bf16x2_t __attribute__((ext_vector_type(2)));
typedef GAS unsigned gu32;
#define RLX_AGENT __ATOMIC_RELAXED, __HIP_MEMORY_SCOPE_AGENT
#define LDS_WAIT() asm volatile("s_waitcnt lgkmcnt(0)" ::: "memory")
#define VM_WAIT() asm volatile("s_waitcnt vmcnt(0)" ::: "memory")

constexpr int NB = 2, SEQ = 8192, M = NB * SEQ, D = 1024, DEPTH = 4;
constexpr int INC = 6144;
constexpr int PPITCH = 6208;
constexpr int VTP = 8256;
constexpr int C_Q = 0, C_K = 512, C_V = 1024, C_UF = 1536, C_UX = 2048, C_UG = 2560, C_GATE = 3072;
constexpr int BRP = 2112;
constexpr int DFF = 3072, DFE = 1536, NEXP = 8;
constexpr float RMS_EPS = 1e-6f;
constexpr int NWAVES = 8;

constexpr size_t MiB = 1u << 20;
constexpr size_t WS_CTL = 0, CTL_ZERO_BYTES = 1 * MiB;
constexpr size_t WS_WIN = 1 * MiB;
constexpr size_t WS_WBR = 714 * MiB;
constexpr size_t WS_WOUT = 65 * MiB;
constexpr size_t WS_WGU = 73 * MiB;
constexpr size_t WS_WDN = 97 * MiB;
constexpr size_t WS_MGU = 109 * MiB;
constexpr size_t WS_MDN = 205 * MiB;
constexpr size_t WS_WL = 253 * MiB;
constexpr size_t WS_MISC = 254 * MiB;
constexpr size_t WS_LSUM = 255 * MiB;
constexpr size_t WS_MOEI = 257 * MiB;
constexpr size_t WS_HB = 259 * MiB;
constexpr size_t WS_HB8 = 291 * MiB;
constexpr size_t WS_WIN8 = 630 * MiB;
constexpr size_t WS_BR = 647 * MiB;
constexpr size_t WS_TP = 371 * MiB;
constexpr size_t WS_MERGED = 403 * MiB;
constexpr size_t WS_PROJ = 435 * MiB;
constexpr size_t WS_HID = 435 * MiB;
constexpr size_t WS_YBUF = 537 * MiB;
constexpr size_t WS_RS = 629 * MiB;
constexpr size_t WS_LSTH = 731 * MiB;
constexpr size_t WS_LSTP = WS_MERGED;
constexpr size_t WS_END = 747 * MiB;
constexpr int CW_BAR = 4096;
constexpr int CW_MOE = 16384;

constexpr int LDS_BYTES = 147456;
constexpr int SCR_BYTES = 139264;
constexpr int MISC_OFF = SCR_BYTES;

__device__ __forceinline__ unsigned pk2(float lo, float hi) { f32x2 v = {lo, hi}; bf16x2_t b = __builtin_convertvector(v, bf16x2_t); return __builtin_bit_cast(unsigned, b); }
__device__ __forceinline__ int opaque_i(int v) { asm volatile("" : "+v"(v)); return v; }
__device__ __forceinline__ int lane_id() { int l; asm volatile("v_mbcnt_lo_u32_b32 %0, -1, 0\n\tv_mbcnt_hi_u32_b32 %0, -1, %0" : "=&v"(l)); return l; }
__device__ __forceinline__ int tid_of(int wave0) { int w = wave0; asm volatile("" : "+s"(w)); return opaque_i(w * 64 + lane_id()); }
__device__ __forceinline__ float bf2f(unsigned short x) { return __uint_as_float((unsigned)x << 16); }
__device__ __forceinline__ unsigned pk4_u8(float a, float b, float c, float d) {
    unsigned r = 0; r = __builtin_amdgcn_cvt_pk_u8_f32(__builtin_fmaf(a, 256.f, -0.5f), 0, r); r = __builtin_amdgcn_cvt_pk_u8_f32(__builtin_fmaf(b, 256.f, -0.5f), 1, r);
    r = __builtin_amdgcn_cvt_pk_u8_f32(__builtin_fmaf(c, 256.f, -0.5f), 2, r); r = __builtin_amdgcn_cvt_pk_u8_f32(__builtin_fmaf(d, 256.f, -0.5f), 3, r); return r; }
__device__ __forceinline__ u32x4 pair16(u32x2 a, u32x2 b) {
    const auto rx = __builtin_amdgcn_permlane16_swap(a.x, b.x, false, false); const auto ry = __builtin_amdgcn_permlane16_swap(a.y, b.y, false, false);
    u32x4 r; r.x = rx[0]; r.y = ry[0]; r.z = rx[1]; r.w = ry[1]; return r;
}
__device__ __forceinline__ float ub8(unsigned x, int j) { return (float)((x >> (8 * j)) & 0xffu) + 0.5f; }
__device__ __forceinline__ float bflo(unsigned x) { return __uint_as_float(x << 16); }
__device__ __forceinline__ float bfhi(unsigned x) { return __uint_as_float(x & 0xffff0000u); }
__device__ __forceinline__ float wave_sum(float v) {
#pragma unroll
    for (int o = 1; o < 64; o <<= 1) v += __shfl_xor(v, o);
    return v;
}
constexpr float RS_SCALE = 16777216.0f;
constexpr float W8S = 64.0f, H8S = 8.0f;
typedef int i32x8 __attribute__((ext_vector_type(8)));
__device__ __forceinline__ float sat8(float x) { return __builtin_amdgcn_fmed3f(x, -448.0f, 448.0f); }
__device__ __forceinline__ unsigned pk4_fp8(float a, float b, float c, float d) { int r = 0; a = sat8(a); b = sat8(b); c = sat8(c); d = sat8(d); r = __builtin_amdgcn_cvt_pk_fp8_f32(a, b, r, false); r = __builtin_amdgcn_cvt_pk_fp8_f32(c, d, r, true); return (unsigned)r; }
__device__ __forceinline__ float rs_rstd(unsigned long long v) { return __builtin_amdgcn_rsqf((float)v * (1.0f / (RS_SCALE * D)) + RMS_EPS); }
__device__ __forceinline__ float fast_sigmoid(float x) { return __builtin_amdgcn_rcpf(1.0f + __builtin_amdgcn_exp2f(-1.44269504f * x)); }
__device__ __forceinline__ float gelu_tanh(float x) { const float z = 0.7978845608f * (x + 0.044715f * x * x * x); return x * fast_sigmoid(2.0f * z); }

namespace pg8 {
constexpr int BM = 256, BK = 64, HALF = 128, HTB = HALF * BK * 2, STAGE_BYTES = 8 * HTB, NXCD = 8, WGM = 8;
__host__ __device__ __forceinline__ int lds_byte(int r, int c) { const int st = (r >> 4) * 2 + (c >> 5), rr = r & 15, cc = c & 31, ob = rr * 64 + cc * 2; return st * 1024 + (ob ^ (((ob >> 9) & 1) << 5)); }
__host__ __device__ __forceinline__ void stage_rc(int b, int& R, int& C) { const int st = b / 1024, sb = b % 1024, swz = sb ^ (((sb >> 9) & 1) << 5); R = (st >> 1) * 16 + swz / 64; C = (st & 1) * 32 + (swz % 64) / 2; }
__host__ __device__ __forceinline__ int perm32(int rho) { const int n = rho >> 4, i = rho & 15; return 8 * (i >> 2) + 4 * n + (i & 3); }

struct Unit { int pm, pn, sub, aux; };
__device__ __forceinline__ bool tile_of(long L, int nM, int nN, int& pm, int& pn) {
    const int nwg = nM * nN; if (L >= nwg) return false;
    int wgid = (int)L; { const int q = nwg / NXCD, r = nwg % NXCD, xcd = wgid % NXCD, off = wgid / NXCD; wgid = (xcd < r ? xcd * (q + 1) : r * (q + 1) + (xcd - r) * q) + off; }
    const int nig = WGM * nN, gid = wgid / nig, fm = gid * WGM, gsz = (nM - fm) < WGM ? (nM - fm) : WGM;
    pm = fm + ((wgid % nig) % gsz); pn = (wgid % nig) / gsz; return true;
}
struct SchedPlain {
    const char* A; const char* B; int lda2, ldb2, nt, nM, nN, G, c;
    __device__ __forceinline__ bool next(int i, Unit& u) const { u.sub = 0; u.aux = 0; return tile_of((long)i * G + c, nM, nN, u.pm, u.pn); }
    __device__ __forceinline__ const char* a_ptr(const Unit& u) const { return A + (size_t)u.pm * 256 * lda2; }
    __device__ __forceinline__ const char* b_ptr(const Unit& u) const { return B + (size_t)u.pn * 256 * ldb2; }
    __device__ __forceinline__ int ntiles(const Unit&) const { return nt; }
    __device__ __forceinline__ unsigned row_off(const Unit&, int) const { return 0u; }
};
struct SchedMerge {
    const char* A; const char* B; int lda2, ldb2, nM, nN, G, c;
    __device__ __forceinline__ bool next(int i, Unit& u) const { u.sub = i % 3; u.aux = 0; return tile_of((long)(i / 3) * G + c, nM, nN, u.pm, u.pn); }
    __device__ __forceinline__ int koff(const Unit& u) const { return u.sub == 0 ? 0 : (u.sub == 1 ? 512 : 1536); }
    __device__ __forceinline__ const char* a_ptr(const Unit& u) const { return A + (size_t)u.pm * 256 * lda2 + koff(u) * 2; }
    __device__ __forceinline__ const char* b_ptr(const Unit& u) const { return B + (size_t)u.pn * 256 * ldb2 + koff(u) * 2; }
    __device__ __forceinline__ int ntiles(const Unit& u) const { return u.sub == 1 ? 16 : 8; }
    __device__ __forceinline__ unsigned row_off(const Unit&, int) const { return 0u; }
};
struct SchedMoe {
    const char* A; const char* B; const int* list; int lda2, ldb2, nt, nN, G, c; size_t bstride; bool gather;
    int t1, t2, t3, t4, t5, t6, t7, t8;
    const unsigned* cntp;
    __device__ __forceinline__ bool next(int i, Unit& u) const {
        if (!tile_of((long)i * G + c, t8, nN, u.pm, u.pn)) return false;
        const int pm = u.pm; int e = 0, a = 0;
        if (pm >= t1) { e = 1; a = t1; } if (pm >= t2) { e = 2; a = t2; } if (pm >= t3) { e = 3; a = t3; } if (pm >= t4) { e = 4; a = t4; }
        if (pm >= t5) { e = 5; a = t5; } if (pm >= t6) { e = 6; a = t6; } if (pm >= t7) { e = 7; a = t7; }
        u.sub = e; u.aux = a; return true;
    }
    __device__ __forceinline__ int cnt_of(int e) const { return __builtin_amdgcn_readfirstlane((int)cntp[e * 64]); }
    __device__ __forceinline__ const char* a_ptr(const Unit& u) const { return gather ? A : A + (size_t)u.pm * 256 * lda2; }
    __device__ __forceinline__ const char* b_ptr(const Unit& u) const { return B + (size_t)u.sub * bstride + (size_t)u.pn * 256 * ldb2; }
    __device__ __forceinline__ int ntiles(const Unit&) const { return nt; }
    __device__ __forceinline__ unsigned row_off(const Unit& u, int lrow) const {
        const int pos = (u.pm - u.aux) * 256 + lrow; const int cn = cnt_of(u.sub);
        const int tok = list[u.sub * 16384 + (pos < cn ? pos : 0)];
        return (unsigned)tok * (unsigned)lda2;
    }
};

template <class Epi, class Sched, bool ALIGN_EPI, bool GATHER, bool FP8 = false>
__device__ __forceinline__ void gemm_phase(LAS unsigned char* lds, const Sched& S, const Epi& E, int wave0) {
    const int tid = tid_of(wave0), wid = __builtin_amdgcn_readfirstlane(tid >> 6), lane = tid & 63, wr = wid >> 2, wc = wid & 3, fr = lane & 15, fq = lane >> 4;
    const int lda2 = S.lda2, ldb2 = S.ldb2;
    unsigned vA0[2], vA1[2], voffB[2];
    LAS unsigned* rowtab = (LAS unsigned*)(lds + STAGE_BYTES);
#pragma unroll
    for (int i = 0; i < 2; ++i) { int R, C; stage_rc(tid * 16 + i * 8192, R, C); const int Rb = Epi::PERM ? ((R & ~31) + perm32(R & 31)) : R;
        voffB[i] = (unsigned)(Rb * ldb2 + C * 2); vA0[i] = (unsigned)(R * lda2 + C * 2); vA1[i] = vA0[i] + (unsigned)(HALF * lda2); }
    const size_t kstep = (size_t)(BK * 2);
    const size_t hstepB = (size_t)HALF * ldb2;
    const unsigned ldsw = (unsigned)wid * 1024u;
    const int aoff = lds_byte(wr * 64 + fr, fq * 8), boff = lds_byte(wc * 32 + fr, fq * 8);
#define PG8_SA(b, h) (((b) * 2 + (h)) * HTB)
#define PG8_SB(b, h) ((4 + (b) * 2 + (h)) * HTB)
#define PG8_STAGE(bufoff, gbase, voff) do { _Pragma("unroll") for (int _i = 0; _i < 2; ++_i) \
        __builtin_amdgcn_global_load_lds((const unsigned*)((const char*)(gbase) + (voff)[_i]), (LAS unsigned*)(lds + (bufoff) + ldsw + _i * 8192), 16, 0, 0); } while (0)
#define PG8_LDA(dst, b, h) do { if constexpr (FP8) { _Pragma("unroll") for (int m = 0; m < 4; ++m) { const u32x4 lo_ = *(const LAS u32x4*)(lds + PG8_SA(b, h) + aoff + m * 2048), hi_ = *(const LAS u32x4*)(lds + PG8_SA(b, h) + aoff + m * 2048 + 1024); \
        dst##8[m] = __builtin_bit_cast(i32x8, __builtin_shufflevector(lo_, hi_, 0, 1, 2, 3, 4, 5, 6, 7)); } } \
    else { _Pragma("unroll") for (int m = 0; m < 4; ++m) _Pragma("unroll") for (int k = 0; k < 2; ++k) dst[m][k] = *(const LAS bf16x8*)(lds + PG8_SA(b, h) + aoff + m * 2048 + k * 1024); } } while (0)
#define PG8_LDB(dst, b, h) do { if constexpr (FP8) { _Pragma("unroll") for (int n = 0; n < 2; ++n) { const u32x4 lo_ = *(const LAS u32x4*)(lds + PG8_SB(b, h) + boff + n * 2048), hi_ = *(const LAS u32x4*)(lds + PG8_SB(b, h) + boff + n * 2048 + 1024); \
        dst##8[n] = __builtin_bit_cast(i32x8, __builtin_shufflevector(lo_, hi_, 0, 1, 2, 3, 4, 5, 6, 7)); } } \
    else { _Pragma("unroll") for (int n = 0; n < 2; ++n) _Pragma("unroll") for (int k = 0; k < 2; ++k) dst[n][k] = *(const LAS bf16x8*)(lds + PG8_SB(b, h) + boff + n * 2048 + k * 1024); } } while (0)
#define PG8_MMA(ai, bj, At, Bt) do { __builtin_amdgcn_s_setprio(1); _Pragma("unroll") for (int m = 0; m < 4; ++m) _Pragma("unroll") for (int n = 0; n < 2; ++n) { \
        if constexpr (FP8) asm volatile("v_mfma_scale_f32_16x16x128_f8f6f4 %0, %1, %2, %0, %3, %3 op_sel_hi:[0,0,0]" : "+v"(acc[ai][bj][m][n]) : "v"(Bt##8[n]), "v"(At##8[m]), "v"(sc1)); \
        else { _Pragma("unroll") for (int k = 0; k < 2; ++k) acc[ai][bj][m][n] = __builtin_amdgcn_mfma_f32_16x16x32_bf16(Bt[n][k], At[m][k], acc[ai][bj][m][n], 0, 0, 0); } } \
        __builtin_amdgcn_s_setprio(0); } while (0)
#define PG8_WAIT_V(n) asm volatile("s_waitcnt vmcnt(" #n ")" ::: "memory")
#define PG8_WAIT_L(n) asm volatile("s_waitcnt lgkmcnt(" #n ")" ::: "memory")
#define PG8_BAR __builtin_amdgcn_s_barrier()
#define PG8_SCHED __builtin_amdgcn_sched_barrier(0)
    Unit cur, nxt; int ui = 0;
    if (!S.next(0, cur)) return;
    f32x4 acc[2][2][4][2];
#pragma unroll
    for (int a = 0; a < 2; ++a)
#pragma unroll
        for (int b = 0; b < 2; ++b)
#pragma unroll
            for (int m = 0; m < 4; ++m)
#pragma unroll
                for (int n = 0; n < 2; ++n) acc[a][b][m][n] = (f32x4){0.f, 0.f, 0.f, 0.f};
    bf16x8 At[4][2], B0[2][2], B1[2][2];
    i32x8 At8[4], B08[2], B18[2]; const int sc1 = 0x7F7F7F7F;
    const char* cA = S.a_ptr(cur); const char* cB = S.b_ptr(cur); int nt = S.ntiles(cur);
    if constexpr (GATHER) {
#pragma unroll
        for (int i = 0; i < 2; ++i) { int R, C; stage_rc(tid * 16 + i * 8192, R, C); vA0[i] = S.row_off(cur, R) + (unsigned)(C * 2); vA1[i] = S.row_off(cur, HALF + R) + (unsigned)(C * 2); }
    }
    PG8_STAGE(PG8_SB(0, 0), cB, voffB); PG8_STAGE(PG8_SB(0, 1), cB + hstepB, voffB); PG8_STAGE(PG8_SA(0, 0), cA, vA0); PG8_STAGE(PG8_SA(0, 1), cA, vA1);
    if (wr == 1) PG8_BAR;
    PG8_WAIT_V(2); PG8_BAR;
    PG8_STAGE(PG8_SB(1, 0), cB + kstep, voffB); PG8_STAGE(PG8_SA(1, 0), cA + kstep, vA0); PG8_STAGE(PG8_SB(1, 1), cB + hstepB + kstep, voffB);
    PG8_WAIT_V(6); PG8_BAR;
    for (;;) {
        const bool has_next = S.next(ui + 1, nxt);
        const char* nA = has_next ? S.a_ptr(nxt) : cA; const char* nB = has_next ? S.b_ptr(nxt) : cB;
        for (int t = 0; t < nt; t += 2) {
            const bool last = (t == nt - 2);
            const char* a1 = cA + (size_t)(t + 1) * kstep;
            const char* a2 = last ? nA : cA + (size_t)(t + 2) * kstep; const char* b2 = last ? nB : cB + (size_t)(t + 2) * kstep;
            const char* a3 = a2 + kstep; const char* b3 = b2 + kstep;
            if constexpr (GATHER) { if (last && has_next) { if (tid < 256) rowtab[tid] = S.row_off(nxt, tid); } }
            PG8_LDB(B0, 0, 0); PG8_LDB(B1, 0, 1); PG8_SCHED; PG8_LDA(At, 0, 0); PG8_STAGE(PG8_SA(1, 1), a1, vA1);
            PG8_WAIT_V(8); PG8_WAIT_L(0); PG8_BAR; PG8_MMA(0, 0, At, B0); PG8_MMA(0, 1, At, B1); PG8_BAR; PG8_SCHED;
            if constexpr (GATHER) { if (last && has_next) {
_Pragma("unroll") for (int i = 0; i < 2; ++i) { int R, C; stage_rc(tid * 16 + i * 8192, R, C); vA0[i] = rowtab[R] + (unsigned)(C * 2); vA1[i] = rowtab[HALF + R] + (unsigned)(C * 2); } } }
            PG8_LDA(At, 0, 1); PG8_STAGE(PG8_SB(0, 0), b2, voffB); PG8_STAGE(PG8_SB(0, 1), b2 + hstepB, voffB); PG8_STAGE(PG8_SA(0, 0), a2, vA0);
            PG8_WAIT_V(8); PG8_WAIT_L(0); PG8_BAR; PG8_MMA(1, 0, At, B0); PG8_MMA(1, 1, At, B1); PG8_BAR; PG8_SCHED;
            PG8_LDB(B0, 1, 0); PG8_LDB(B1, 1, 1); PG8_SCHED; PG8_LDA(At, 1, 0); PG8_STAGE(PG8_SA(0, 1), a2, vA1);
            PG8_WAIT_V(8); PG8_WAIT_L(0); PG8_BAR; PG8_MMA(0, 0, At, B0); PG8_MMA(0, 1, At, B1); PG8_BAR; PG8_SCHED;
            PG8_LDA(At, 1, 1); PG8_STAGE(PG8_SB(1, 0), b3, voffB); PG8_STAGE(PG8_SB(1, 1), b3 + hstepB, voffB); PG8_STAGE(PG8_SA(1, 0), a3, vA0);
            PG8_WAIT_V(8); PG8_WAIT_L(0); PG8_BAR; PG8_MMA(1, 0, At, B0); PG8_MMA(1, 1, At, B1); PG8_BAR; PG8_SCHED;
        }
        if constexpr (ALIGN_EPI) { if (wr == 0) PG8_BAR; }
        if constexpr (FP8) asm volatile("s_nop 15\n\ts_nop 15" ::: "memory");
        E(acc, cur, wr, wc, opaque_i(fr), opaque_i(fq));
        if (!has_next) break;
        if (!(Epi::CARRY && E.keep(cur))) {
#pragma unroll
            for (int a = 0; a < 2; ++a)
#pragma unroll
                for (int b = 0; b < 2; ++b)
#pragma unroll
                    for (int m = 0; m < 4; ++m)
#pragma unroll
                        for (int n = 0; n < 2; ++n) acc[a][b][m][n] = (f32x4){0.f, 0.f, 0.f, 0.f};
        }
        cur = nxt; cA = nA; cB = nB; nt = S.ntiles(cur); ++ui;
        if constexpr (ALIGN_EPI) { if (wr == 1) PG8_BAR; }
    }
    PG8_WAIT_V(0);
    if constexpr (!ALIGN_EPI) { if (wr == 0) PG8_BAR; }
    PG8_BAR;
#undef PG8_SA
#undef PG8_SB
#undef PG8_STAGE
#undef PG8_LDA
#undef PG8_LDB
#undef PG8_MMA
#undef PG8_WAIT_V
#undef PG8_WAIT_L
#undef PG8_BAR
#undef PG8_SCHED
}

template <bool GATES>
struct EpiProj {
    static constexpr bool PERM = true, CARRY = false;
    bf16* P; bf16* VT; const float* bias; const unsigned long long* rs; int pn_off; float cs;
    __device__ __forceinline__ bool keep(const Unit&) const { return false; }
    __device__ __forceinline__ void operator()(f32x4 (&acc)[2][2][4][2], const Unit& u, int wr, int wc, int fr, int fq) const {
        const int pn = u.pn + pn_off; const int row0 = u.pm * BM + wr * 64 + fr, colb = pn * BM + wc * 32 + 8 * fq;
        const int kind = GATES ? 4 : (pn < 2) ? 0 : (pn < 10) ? 1 : 3;
        unsigned long long rsv[8]; f32x4 bv[2][2];
#pragma unroll
        for (int k = 0; k < 8; ++k) rsv[k] = rs[row0 + (k >> 2) * HALF + (k & 3) * 16];
#pragma unroll
        for (int bj = 0; bj < 2; ++bj) { bv[bj][0] = *(const f32x4*)(bias + colb + bj * HALF); bv[bj][1] = *(const f32x4*)(bias + colb + bj * HALF + 4); }
        __builtin_amdgcn_sched_barrier(0);
        if constexpr (GATES) {
            unsigned char* gp = (unsigned char*)(P + (size_t)(row0 + (fq & 1) * 16) * PPITCH + C_GATE) + (pn * BM - C_GATE) + wc * 32 + 8 * (fq & ~1);
#pragma unroll
            for (int ai = 0; ai < 2; ++ai)
#pragma unroll
                for (int mp = 0; mp < 2; ++mp)
#pragma unroll
                    for (int bj = 0; bj < 2; ++bj) {
                        u32x2 w8[2];
#pragma unroll
                        for (int h = 0; h < 2; ++h) {
                            const int m = mp * 2 + h; const float sr = rs_rstd(rsv[ai * 4 + m]) * cs;
                            float v[8];
                            const f32x4 bv0 = bv[bj][0], bv1 = bv[bj][1];
#pragma unroll
                            for (int i = 0; i < 4; ++i) { v[i] = acc[ai][bj][m][0][i] * sr + bv0[i]; v[4 + i] = acc[ai][bj][m][1][i] * sr + bv1[i]; }
#pragma unroll
                            for (int e = 0; e < 8; ++e) v[e] = fast_sigmoid(fminf(fmaxf(v[e], -30.f), 30.f));
                            w8[h].x = pk4_u8(v[0], v[1], v[2], v[3]); w8[h].y = pk4_u8(v[4], v[5], v[6], v[7]);
                        }
                        *(u32x4*)(gp + (size_t)(ai * HALF + mp * 32) * (2 * PPITCH) + bj * HALF) = pair16(w8[0], w8[1]);
                    }
        } else {
#pragma unroll
        for (int ai = 0; ai < 2; ++ai)
#pragma unroll
            for (int m = 0; m < 4; ++m) {
                const int row = row0 + ai * HALF + m * 16;
                const float sr = rs_rstd(rsv[ai * 4 + m]) * cs;
#pragma unroll
                for (int bj = 0; bj < 2; ++bj) {
                    float v[8];
                    const f32x4 bv0 = bv[bj][0], bv1 = bv[bj][1];
#pragma unroll
                    for (int i = 0; i < 4; ++i) { v[i] = acc[ai][bj][m][0][i] * sr + bv0[i]; v[4 + i] = acc[ai][bj][m][1][i] * sr + bv1[i]; }
                    if (kind == 0) {
#pragma unroll
                        for (int e = 0; e < 8; ++e) v[e] *= 0.125f;
                    } else if (kind == 3) {
#pragma unroll
                        for (int e = 0; e < 8; ++e) v[e] = gelu_tanh(v[e]);
                    }
                    { u32x4 w; w.x = pk2(v[0], v[1]); w.y = pk2(v[2], v[3]); w.z = pk2(v[4], v[5]); w.w = pk2(v[6], v[7]);
                      *(u32x4*)(P + (size_t)row * PPITCH + colb + bj * HALF) = w; }
                }
            }
        }
    }
};
struct EpiMerge {
    static constexpr bool PERM = true, CARRY = true;
    const unsigned char* G; bf16* O;
    __device__ __forceinline__ bool keep(const Unit& u) const { return u.sub < 2; }
    __device__ __forceinline__ void operator()(f32x4 (&acc)[2][2][4][2], const Unit& u, int wr, int wc, int fr, int fq) const {
        const int row0 = u.pm * BM + wr * 64 + fr, colb = u.pn * BM + wc * 32 + 8 * fq, sub = u.sub;
#pragma unroll
        for (int ai = 0; ai < 2; ++ai) {
            u32x2 gk[4][2], gn[4][2];
#pragma unroll
            for (int m = 0; m < 4; ++m)
#pragma unroll
                for (int bj = 0; bj < 2; ++bj) {
                    const unsigned char* gp = G + (size_t)(row0 + ai * HALF + m * 16) * (2 * PPITCH) + sub * D + colb + bj * HALF;
                    gk[m][bj] = *(const u32x2*)gp;
                    if (sub < 2) gn[m][bj] = *(const u32x2*)(gp + D);
                }
            __builtin_amdgcn_sched_barrier(0);
#pragma unroll
            for (int m = 0; m < 4; ++m) {
                const int row = row0 + ai * HALF + m * 16;
#pragma unroll
                for (int bj = 0; bj < 2; ++bj) {
                    const u32x2 g4 = gk[m][bj];
                    float f[8] = {ub8(g4.x, 0), ub8(g4.x, 1), ub8(g4.x, 2), ub8(g4.x, 3), ub8(g4.y, 0), ub8(g4.y, 1), ub8(g4.y, 2), ub8(g4.y, 3)};
                    if (sub < 2) {
                        const u32x2 n4 = gn[m][bj];
                        const float d[8] = {ub8(n4.x, 0), ub8(n4.x, 1), ub8(n4.x, 2), ub8(n4.x, 3), ub8(n4.y, 0), ub8(n4.y, 1), ub8(n4.y, 2), ub8(n4.y, 3)};
#pragma unroll
                        for (int e = 0; e < 8; ++e) f[e] *= __builtin_amdgcn_rcpf(d[e]);
                    } else {
#pragma unroll
                        for (int e = 0; e < 8; ++e) f[e] *= (1.0f / 256.0f);
                    }
#pragma unroll
                    for (int n = 0; n < 2; ++n)
#pragma unroll
                        for (int i = 0; i < 4; ++i) acc[ai][bj][m][n][i] *= f[n * 4 + i];
                    if (sub == 2) {
                        u32x4 w; w.x = pk2(acc[ai][bj][m][0][0], acc[ai][bj][m][0][1]); w.y = pk2(acc[ai][bj][m][0][2], acc[ai][bj][m][0][3]);
                        w.z = pk2(acc[ai][bj][m][1][0], acc[ai][bj][m][1][1]); w.w = pk2(acc[ai][bj][m][1][2], acc[ai][bj][m][1][3]);
                        *(u32x4*)(O + (size_t)row * D + colb + bj * HALF) = w;
                    }
                }
            }
        }
    }
};
struct EpiOut {
    static constexpr bool PERM = true, CARRY = false;
    bf16* hb; unsigned long long* rs; unsigned char* hb8; float cs;
    __device__ __forceinline__ bool keep(const Unit&) const { return false; }
    __device__ __forceinline__ void operator()(f32x4 (&acc)[2][2][4][2], const Unit& u, int wr, int wc, int fr, int fq) const {
        const int row0 = u.pm * BM + wr * 64 + fr, colb = u.pn * BM + wc * 32 + 8 * fq;
#pragma unroll
        for (int ai = 0; ai < 2; ++ai) {
            u32x4 hv[4][2];
#pragma unroll
            for (int m = 0; m < 4; ++m)
#pragma unroll
                for (int bj = 0; bj < 2; ++bj) hv[m][bj] = *(const u32x4*)(hb + (size_t)(row0 + ai * HALF + m * 16) * D + colb + bj * HALF);
            __builtin_amdgcn_sched_barrier(0);
            float ssm[4]; u32x2 w8[4][2];
#pragma unroll
            for (int m = 0; m < 4; ++m) {
                const int row = row0 + ai * HALF + m * 16; float ss = 0.f;
#pragma unroll
                for (int bj = 0; bj < 2; ++bj) {
                    bf16* hp = hb + (size_t)row * D + colb + bj * HALF;
                    const u32x4 h4 = hv[m][bj];
                    float v[8] = {bflo(h4.x), bfhi(h4.x), bflo(h4.y), bfhi(h4.y), bflo(h4.z), bfhi(h4.z), bflo(h4.w), bfhi(h4.w)};
#pragma unroll
                    for (int n = 0; n < 2; ++n)
#pragma unroll
                        for (int i = 0; i < 4; ++i) { v[n * 4 + i] += acc[ai][bj][m][n][i] * cs; ss += v[n * 4 + i] * v[n * 4 + i]; }
                    u32x4 w; w.x = pk2(v[0], v[1]); w.y = pk2(v[2], v[3]); w.z = pk2(v[4], v[5]); w.w = pk2(v[6], v[7]);
                    *(u32x4*)hp = w;
                    if (hb8) { w8[m][bj].x = pk4_fp8(v[0], v[1], v[2], v[3]); w8[m][bj].y = pk4_fp8(v[4], v[5], v[6], v[7]); }
                }
                ss += __shfl_xor(ss, 16); ss += __shfl_xor(ss, 32); ssm[m] = ss;
            }
            if (hb8) {
                unsigned char* qp = hb8 + (size_t)(row0 + ai * HALF + (fq & 1) * 16) * D + u.pn * BM + wc * 32 + 8 * (fq & ~1);
#pragma unroll
                for (int mp = 0; mp < 2; ++mp)
#pragma unroll
                    for (int bj = 0; bj < 2; ++bj) *(u32x4*)(qp + (size_t)(mp * 32) * D + bj * HALF) = pair16(w8[mp * 2][bj], w8[mp * 2 + 1][bj]);
            }
            { const float ssel = (fq == 0) ? ssm[0] : (fq == 1) ? ssm[1] : (fq == 2) ? ssm[2] : ssm[3];
              atomicAdd(rs + row0 + ai * HALF + fq * 16, (unsigned long long)(ssel * RS_SCALE)); }
        }
    }
};
struct EpiGU {
    static constexpr bool PERM = true, CARRY = false;
    unsigned char* Hd; int ldh; const unsigned long long* rs; const float* srow; bool moe; float cs;
    __device__ __forceinline__ bool keep(const Unit&) const { return false; }
    __device__ __forceinline__ void operator()(f32x4 (&acc)[2][2][4][2], const Unit& u, int wr, int wc, int fr, int fq) const {
        const int lrow0 = wr * 64 + fr, hcol = u.pn * HALF + wc * 32 + 8 * fq;
        float srv[8];
#pragma unroll
        for (int k = 0; k < 8; ++k) { const int lrow = lrow0 + (k >> 2) * HALF + (k & 3) * 16;
            if (moe) srv[k] = srow[u.sub * 16384 + (u.pm - u.aux) * 256 + lrow]; else srv[k] = rs_rstd(rs[u.pm * BM + lrow]); }
        __builtin_amdgcn_sched_barrier(0);
        unsigned char* hp = Hd + (size_t)(u.pm * BM + lrow0 + (fq & 1) * 16) * ldh + u.pn * HALF + wc * 32 + 8 * (fq & ~1);
#pragma unroll
        for (int ai = 0; ai < 2; ++ai)
#pragma unroll
            for (int mp = 0; mp < 2; ++mp) {
                u32x2 w[2];
#pragma unroll
                for (int h = 0; h < 2; ++h) {
                    const int m = mp * 2 + h; const float sr = srv[ai * 4 + m] * cs;
                    float o[8];
#pragma unroll
                    for (int n = 0; n < 2; ++n)
#pragma unroll
                        for (int i = 0; i < 4; ++i) { const float g = acc[ai][0][m][n][i] * sr, uu = acc[ai][1][m][n][i] * sr; o[n * 4 + i] = g * fast_sigmoid(g) * uu * H8S; }
                    w[h].x = pk4_fp8(o[0], o[1], o[2], o[3]); w[h].y = pk4_fp8(o[4], o[5], o[6], o[7]);
                }
                *(u32x4*)(hp + (size_t)(ai * HALF + mp * 32) * ldh) = pair16(w[0], w[1]);
            }
    }
};
struct EpiMoeDown {
    static constexpr bool PERM = true, CARRY = false;
    bf16* Y; const float* wslot;
    __device__ __forceinline__ bool keep(const Unit&) const { return false; }
    __device__ __forceinline__ void operator()(f32x4 (&acc)[2][2][4][2], const Unit& u, int wr, int wc, int fr, int fq) const {
        const int lrow0 = wr * 64 + fr, colb = u.pn * BM + wc * 32 + 8 * fq;
        float wtv[8];
#pragma unroll
        for (int k = 0; k < 8; ++k) wtv[k] = wslot[u.sub * 16384 + (u.pm - u.aux) * 256 + lrow0 + (k >> 2) * HALF + (k & 3) * 16];
        __builtin_amdgcn_sched_barrier(0);
#pragma unroll
        for (int ai = 0; ai < 2; ++ai)
#pragma unroll
            for (int m = 0; m < 4; ++m) {
                const int lrow = lrow0 + ai * HALF + m * 16; const int row = u.pm * BM + lrow;
                const float wt = wtv[ai * 4 + m] * (1.0f / (W8S * H8S));
#pragma unroll
                for (int bj = 0; bj < 2; ++bj) {
                    const f32x4 v0 = acc[ai][bj][m][0] * wt, v1 = acc[ai][bj][m][1] * wt;
                    u32x4 w; w.x = pk2(v0[0], v0[1]); w.y = pk2(v0[2], v0[3]); w.z = pk2(v1[0], v1[1]); w.w = pk2(v1[2], v1[3]);
                    *(u32x4*)(Y + (size_t)row * D + colb + bj * HALF) = w;
                }
            }
    }
};
}

#define XB_TMO      128
#define XB_XCNT(j)  (256  + 64 * (j))
#define XB_XSUB(j)  (1280 + 64 * (j))
#define XB_XGEN(j)  (2304 + 64 * (j))
#define XB_TOP      3328
#define XB_TOPGEN   3392
#define XCD_BAR_WORDS 3456
#define XB_SPIN_CAP (1u << 18)
__device__ __forceinline__ unsigned xb_ld(unsigned* p)              { return __hip_atomic_load(p, __ATOMIC_RELAXED, __HIP_MEMORY_SCOPE_AGENT); }
__device__ __forceinline__ unsigned xb_add(unsigned* p, unsigned v) { return __hip_atomic_fetch_add(p, v, __ATOMIC_RELAXED, __HIP_MEMORY_SCOPE_AGENT); }
__device__ __forceinline__ unsigned xb_xcc_id() { return (unsigned)__builtin_amdgcn_s_getreg((3 << 11) | 20) & 0xFu; }
#define XB_SPIN(cond, bar) do { unsigned _sp = 0; while (cond) { __builtin_amdgcn_s_sleep(1); \
    if ((++_sp & 255u) == 0u) { if (xb_ld(&(bar)[XB_TMO])) break; if (_sp > XB_SPIN_CAP) { atomicAdd(&(bar)[XB_TMO], 1u); break; } } } } while (0)
struct XcdBarrier { unsigned* bar; unsigned x; volatile LAS unsigned* st; };
__device__ __forceinline__ XcdBarrier xcd_barrier_post(unsigned* bar, volatile LAS unsigned* st, int wave0) {
    XcdBarrier b; b.bar = bar; b.x = xb_xcc_id(); b.st = st;
    if (wave0 == 0 && lane_id() == 0) (void)xb_add(&bar[XB_XCNT(b.x)], 1u);
    return b;
}
__device__ __forceinline__ void xcd_barrier_complete(unsigned* bar, unsigned x, unsigned& nloc, unsigned& nx) {
    const unsigned G = gridDim.x * gridDim.y * gridDim.z;
    unsigned sum, cnt, mine, sp = 0u;
    for (;;) {
        sum = 0u; cnt = 0u; mine = 0u;
#pragma unroll
        for (unsigned j = 0; j < 16; ++j) { const unsigned c = xb_ld(&bar[XB_XCNT(j)]); sum += c; cnt += (c > 0u) ? 1u : 0u; mine = (j == x) ? c : mine; }
        if (sum == G) break;
        __builtin_amdgcn_s_sleep(1);
        if ((++sp & 255u) == 0u) { if (xb_ld(&bar[XB_TMO])) break; if (sp > XB_SPIN_CAP) { atomicAdd(&bar[XB_TMO], 1u); break; } }
    }
    nloc = mine > 0u ? mine : 1u; nx = cnt > 0u ? cnt : 1u;
}
__device__ __forceinline__ void xcd_barrier(const XcdBarrier& b, int wave0) {
    asm volatile("s_waitcnt vmcnt(0)" ::: "memory");
    __syncthreads();
    if (wave0 == 0 && lane_id() == 0) {
        unsigned* bar = b.bar;
        __builtin_amdgcn_s_waitcnt(0);
        unsigned nloc = b.st[0], nx = b.st[1];
        if (nloc == 0u) { xcd_barrier_complete(bar, b.x, nloc, nx); b.st[0] = nloc; b.st[1] = nx; }
        const unsigned old = xb_add(&bar[XB_XSUB(b.x)], 1u);
        const unsigned gen = old / nloc;
        if (old + 1u == (gen + 1u) * nloc) {
            __builtin_amdgcn_fence(__ATOMIC_RELEASE, "agent");
            asm volatile("s_waitcnt vmcnt(0)" ::: "memory");
            const unsigned og = xb_add(&bar[XB_TOP], 1u);
            const unsigned tg = og / nx;
            if (og + 1u == (tg + 1u) * nx) xb_add(&bar[XB_TOPGEN], 1u);
            else XB_SPIN(xb_ld(&bar[XB_TOPGEN]) == tg, bar);
            __builtin_amdgcn_fence(__ATOMIC_ACQUIRE, "agent");
            xb_add(&bar[XB_XGEN(b.x)], 1u);
            asm volatile("s_waitcnt vmcnt(0)" ::: "memory");
        } else {
            XB_SPIN(xb_ld(&bar[XB_XGEN(b.x)]) == gen, bar);
            __builtin_amdgcn_fence(__ATOMIC_ACQUIRE, "agent");
            asm volatile("s_waitcnt vmcnt(0)" ::: "memory");
        }
    }
    __syncthreads();
}

struct Args {
    const float* x; const float* norm_mix_g; const float* w_in; const float* b_in; const float* na_rpb; const float* conv_w; const float* conv_b;
    const float* lru_wa; const float* lru_ba; const float* lru_wx; const float* lru_bx; const float* lru_lambda; const float* w_branch; const float* w_out;
    const float* norm_ffn_g; const float* ffn_w_gu; const float* ffn_w_down; const float* router_w; const float* moe_w_gu; const float* moe_w_down; const float* final_g;
    float* out; unsigned char* ws; int ph_lo, ph_hi, bar_region, pad;
};
struct Frame {
    LAS unsigned char* lds;
    int tid, lane, wave, vcu, G;
    unsigned* ctl;
    float* H;
    bf16 *HB, *VT, *BR, *TP, *MERGED, *PROJ, *HID, *YBUF; unsigned char* HB8;
    bf16 *WIN, *WBR, *WOUT, *WGU, *WDN, *MGU, *MDN, *WL; unsigned char* WIN8;
    float *NSP, *GW; f32x2* LSUM; unsigned long long* RS; u32x4 *LSTH, *LSTP;
    int* LIST; float* SROW; float* WSLOT; int* TOKI;
};

template <int STEP> __device__ __forceinline__ u32x4 dft_table_entry(int idx);
struct TrDesc { const float* W; const float* ks; unsigned char* WT; int ldw, k0, n0, ldwt, drow0, dcol0, fp8; };
__device__ __forceinline__ void tr_load(const TrDesc& d, float (&tv)[32], float (&kv)[32], int lane) {
#pragma unroll
    for (int i = 0; i < 32; ++i) tv[i] = __builtin_nontemporal_load(d.W + (size_t)(d.k0 + 2 * i + (lane >> 5)) * d.ldw + d.n0 + (lane & 31));
    if (d.ks) {
#pragma unroll
        for (int i = 0; i < 32; ++i) kv[i] = d.ks[d.k0 + 2 * i + (lane >> 5)];
    } else {
#pragma unroll
        for (int i = 0; i < 32; ++i) kv[i] = 1.0f;
    }
}
__device__ __forceinline__ void tr_store(const TrDesc& d, const float (&tv)[32], const float (&kv)[32], LAS float* scr, int lane) {
    const float sc = d.fp8 ? W8S : 1.0f;
#pragma unroll
    for (int i = 0; i < 32; ++i) scr[(2 * i + (lane >> 5)) * 33 + (lane & 31)] = tv[i] * kv[i] * sc;
    LDS_WAIT(); asm volatile("" ::: "memory");
    const int c = lane & 7;
#pragma unroll
    for (int j = 0; j < 4; ++j) { const int n = (lane >> 3) + 8 * j; const LAS float* s = scr + (8 * c) * 33 + n;
        if (d.fp8) { u32x2 o; o.x = pk4_fp8(s[0 * 33], s[1 * 33], s[2 * 33], s[3 * 33]); o.y = pk4_fp8(s[4 * 33], s[5 * 33], s[6 * 33], s[7 * 33]);
            *(u32x2*)(d.WT + (size_t)(d.drow0 + n) * d.ldwt + d.dcol0 + d.k0 + 8 * c) = o; }
        else { u32x4 o; o.x = pk2(s[0 * 33], s[1 * 33]); o.y = pk2(s[2 * 33], s[3 * 33]); o.z = pk2(s[4 * 33], s[5 * 33]); o.w = pk2(s[6 * 33], s[7 * 33]);
            *(u32x4*)((bf16*)d.WT + (size_t)(d.drow0 + n) * d.ldwt + d.dcol0 + d.k0 + 8 * c) = o; } }
    LDS_WAIT(); asm volatile("" ::: "memory");
}
__device__ __forceinline__ int gu_row(int n0, int half) { const int isu = n0 >= half ? 1 : 0; const int hid = n0 - isu * half; return 256 * (hid >> 7) + 128 * isu + (hid & 127); }
template <int STEP> __device__ __forceinline__ u32x4 dft_table_entry(int idx);
__device__ __forceinline__ const Args& fresh_args() { const Args* p = (const Args*)__builtin_amdgcn_kernarg_segment_ptr(); asm volatile("" : "+s"(p)); return *p; }
constexpr int I_IN = 16 * 192, I_BR = 8 * 32, I_OUT = 16 * 32, I_GU = 16 * 192, I_DN = 48 * 32, I_MGU = 16 * 96, I_MDN = 24 * 32;
constexpr int N_IN = 4 * I_IN, N_BR = 8 * I_BR, N_OUT = 4 * I_OUT, N_GU = 2 * I_GU, N_DN = 2 * I_DN, N_MGU = 16 * I_MGU, N_MDN = 16 * I_MDN;
constexpr int NITEMS = N_IN + N_BR + N_OUT + N_GU + N_DN + N_MGU + N_MDN;
__device__ __forceinline__ TrDesc tr_decode(Frame& F, int it) {
    const Args& a = fresh_args(); TrDesc d; d.ks = nullptr; d.dcol0 = 0; d.fp8 = 0;
    int r = it;
    if (r < N_IN) { const int l = r / I_IN, q = r % I_IN, half = q / (I_IN / 2), q2 = q % (I_IN / 2), kb = q2 / 96, nb = q2 % 96;
        d.W = a.w_in + (size_t)l * D * INC; d.ldw = INC; d.k0 = 64 * kb; d.ks = a.norm_mix_g + l * D; d.ldwt = D; d.drow0 = 32 * nb;
        if (half == 0) { d.n0 = 32 * nb; d.WT = (unsigned char*)(F.WIN + (size_t)l * INC * D); } else { d.n0 = 3072 + 32 * nb; d.WT = F.WIN8 + (size_t)l * 3072 * D; d.fp8 = 1; }
        return d; } r -= N_IN;
    if (r < N_BR) { const int lk = r / I_BR, l = lk >> 1, k = (lk & 1) * 2, q = r % I_BR, kb = q / 32, nb = q % 32;
        d.W = a.w_branch + ((size_t)(l * 3 + k) * 512) * D; d.ldw = D; d.k0 = 64 * kb; d.n0 = 32 * nb; d.WT = (unsigned char*)(F.WBR + (size_t)l * D * BRP); d.ldwt = BRP; d.drow0 = 32 * nb; d.dcol0 = k == 0 ? 0 : 1536; return d; } r -= N_BR;
    if (r < N_OUT) { const int l = r / I_OUT, q = r % I_OUT, kb = q / 32, nb = q % 32;
        d.W = a.w_out + (size_t)l * D * D; d.ldw = D; d.k0 = 64 * kb; d.n0 = 32 * nb; d.WT = (unsigned char*)(F.WOUT + (size_t)l * D * D); d.ldwt = D; d.drow0 = 32 * nb; return d; } r -= N_OUT;
    if (r < N_GU) { const int j = r / I_GU, q = r % I_GU, kb = q / 192, nb = q % 192;
        d.W = a.ffn_w_gu + (size_t)j * D * 2 * DFF; d.ldw = 2 * DFF; d.k0 = 64 * kb; d.n0 = 32 * nb; d.ks = a.norm_ffn_g + (2 * j) * D; d.WT = (unsigned char*)(F.WGU + (size_t)j * 2 * DFF * D); d.ldwt = D; d.drow0 = gu_row(32 * nb, DFF); return d; } r -= N_GU;
    if (r < N_DN) { const int j = r / I_DN, q = r % I_DN, kb = q / 32, nb = q % 32;
        d.W = a.ffn_w_down + (size_t)j * DFF * D; d.ldw = D; d.k0 = 64 * kb; d.n0 = 32 * nb; d.WT = (unsigned char*)F.WDN + (size_t)j * D * DFF; d.ldwt = DFF; d.drow0 = 32 * nb; d.fp8 = 1; return d; } r -= N_DN;
    if (r < N_MGU) { const int je = r / I_MGU, j = je >> 3, q = r % I_MGU, kb = q / 96, nb = q % 96;
        d.W = a.moe_w_gu + (size_t)je * D * 2 * DFE; d.ldw = 2 * DFE; d.k0 = 64 * kb; d.n0 = 32 * nb; d.ks = a.norm_ffn_g + (2 * j + 1) * D; d.WT = (unsigned char*)(F.MGU + (size_t)je * 2 * DFE * D); d.ldwt = D; d.drow0 = gu_row(32 * nb, DFE); return d; } r -= N_MGU;
    { const int je = r / I_MDN, q = r % I_MDN, kb = q / 32, nb = q % 32;
        d.W = a.moe_w_down + (size_t)je * DFE * D; d.ldw = D; d.k0 = 64 * kb; d.n0 = 32 * nb; d.WT = (unsigned char*)F.MDN + (size_t)je * D * DFE; d.ldwt = DFE; d.drow0 = 32 * nb; d.fp8 = 1; return d; }
}
__device__ __forceinline__ void p0_prologue(Frame& F, const Args& a_unused) {
    LAS float* scr = (LAS float*)(F.lds + F.wave * 16384);
    const int gw = F.vcu * NWAVES + F.wave, NGW = F.G * NWAVES, lane = F.lane;
    if (gw < NITEMS) {
        TrDesc dc = tr_decode(F, gw); float tv[32], kv[32];
        tr_load(dc, tv, kv, lane);
        for (int it = gw;;) {
            const int itn = it + NGW; const bool has = itn < NITEMS;
            TrDesc dn = dc; float tn[32], kn[32];
            if (has) { dn = tr_decode(F, itn); tr_load(dn, tn, kn, lane); }
            tr_store(dc, tv, kv, scr, lane);
            if (!has) break;
            dc = dn; it = itn;
#pragma unroll
            for (int i = 0; i < 32; ++i) { tv[i] = tn[i]; kv[i] = kn[i]; }
        }
    }
    const Args& a = fresh_args();
    {
        float sv, cv; sincospif((float)lane * (1.0f / 32.0f), &sv, &cv); const float ctab = cv * 0.125f, stab = sv * 0.125f;
        for (int itq = gw; itq < 4 * 4 * 8 * 16; itq += NGW) {
            const int it = itq >> 2, jq = itq & 3;
            const int l = it >> 7, g = (it >> 4) & 7, db = it & 15, d = db * 64 + lane;
            const float* wsrc = a.w_branch + ((size_t)(l * 3 + 1) * 512 + g * 64) * D + d;
            float w[64];
#pragma unroll
            for (int c = 0; c < 64; ++c) w[c] = wsrc[(size_t)c * D];
            bf16* dst = F.WBR + (size_t)l * D * BRP + (size_t)d * BRP + 512 + g * 64;
            for (int j = 8 * jq; j <= 8 * jq + 8; ++j) {
                float ac = 0.f, as = 0.f;
#pragma unroll
                for (int c = 0; c < 64; ++c) { const int mi = (j * c) & 63; ac += __uint_as_float((unsigned)__builtin_amdgcn_readlane((int)__float_as_uint(ctab), mi)) * w[c]; as += __uint_as_float((unsigned)__builtin_amdgcn_readlane((int)__float_as_uint(stab), mi)) * w[c]; }
                dst[j] = (bf16)(pk2(ac, 0.f) & 0xffffu); dst[512 + j] = (bf16)(pk2(as, 0.f) & 0xffffu);
                if (j > 0) { dst[64 - j] = (bf16)(pk2(ac, 0.f) & 0xffffu); dst[512 + 64 - j] = (bf16)(pk2(-as, 0.f) & 0xffffu); }
            }
        }
    }
    const int gt = F.vcu * 512 + F.tid, NGT = F.G * 512;
    for (int o0 = gt; o0 < 4 * 8 * 4 * 4096; o0 += 4 * NGT) {
        float t[4];
#pragma unroll
        for (int q = 0; q < 4; ++q) { const int o = min(o0 + q * NGT, 4 * 8 * 4 * 4096 - 1);
            const int in = o & 63, out = (o >> 6) & 63, mat = (o >> 12) & 3, n = (o >> 14) & 7, l = o >> 17, dir = mat >> 1;
            const float* src = (mat & 1) ? a.lru_wx : a.lru_wa;
            t[q] = src[((((size_t)(l * 2 + dir) * 8 + n) * 64 + in) * 64) + out]; }
#pragma unroll
        for (int q = 0; q < 4; ++q) { const int o = o0 + q * NGT; if (o < 4 * 8 * 4 * 4096) F.WL[o] = (bf16)(pk2(t[q], 0.f) & 0xffffu); }
    }
    for (int o = gt; o < 4096 + 2048; o += NGT) { u32x4* dst = (u32x4*)(F.GW) + 12288; if (o < 4096) dst[o] = dft_table_entry<0>(o); else dst[o] = dft_table_entry<1>(o - 4096); }
    for (int o = gt; o < 4 * 2 * 512; o += NGT) { const float lam = a.lru_lambda[o]; F.NSP[o] = -8.0f * log1pf(expf(-lam)); }
    for (int o = gt; o < 2 * 1024 * 8; o += NGT) { const int j = o >> 13, k = (o >> 3) & 1023; F.GW[o] = a.norm_ffn_g[(2 * j + 1) * D + k] * a.router_w[o]; }
    for (int m0 = gw; m0 < M; m0 += 4 * NGW) {
        f32x4 v[4][4];
#pragma unroll
        for (int q = 0; q < 4; ++q) { const int m = min(m0 + q * NGW, M - 1); const f32x4* xr = (const f32x4*)(a.x + (size_t)m * D) + lane;
#pragma unroll
            for (int j = 0; j < 4; ++j) v[q][j] = xr[64 * j]; }
#pragma unroll
        for (int q = 0; q < 4; ++q) {
            const int m = m0 + q * NGW; if (m >= M) break;
            float s = 0.f;
#pragma unroll
            for (int j = 0; j < 4; ++j) s += (v[q][j][0] * v[q][j][0] + v[q][j][1] * v[q][j][1]) + (v[q][j][2] * v[q][j][2] + v[q][j][3] * v[q][j][3]);
            s = wave_sum(s);
            u32x2* o8 = (u32x2*)(F.HB + (size_t)m * D) + lane;
#pragma unroll
            for (int j = 0; j < 4; ++j) { u32x2 w; w.x = pk2(v[q][j][0], v[q][j][1]); w.y = pk2(v[q][j][2], v[q][j][3]); o8[64 * j] = w; }
            { unsigned* q8 = (unsigned*)(F.HB8 + (size_t)m * D) + lane;
#pragma unroll
              for (int j = 0; j < 4; ++j) q8[64 * j] = pk4_fp8(v[q][j][0], v[q][j][1], v[q][j][2], v[q][j][3]); }
            if (lane == 0) F.RS[m] = (unsigned long long)(s * RS_SCALE);
        }
    }
}

__device__ __forceinline__ f32x4 mfma16(bf16x8 a, bf16x8 b, f32x4 c) { return __builtin_amdgcn_mfma_f32_16x16x32_bf16(a, b, c, 0, 0, 0); }
__device__ __forceinline__ bf16x8 tr_frag(const LAS unsigned char* p0, const LAS unsigned char* p1) {
    const s16x4 lo = __builtin_bit_cast(s16x4, __builtin_amdgcn_ds_read_tr16_b64_v4i16((LAS s16x4*)p0));
    const s16x4 hi = __builtin_bit_cast(s16x4, __builtin_amdgcn_ds_read_tr16_b64_v4i16((LAS s16x4*)p1));
    bf16x8 r; r[0] = lo[0]; r[1] = lo[1]; r[2] = lo[2]; r[3] = lo[3]; r[4] = hi[0]; r[5] = hi[1]; r[6] = hi[2]; r[7] = hi[3]; return r;
}
constexpr int AT_V1 = 65536, AT_RPB = 131072;
struct AttnK { bf16x8 q0, q1; bf16x8 kf[8][2][2]; };
__device__ __forceinline__ void attn_load_k(AttnK& K, const bf16* __restrict__ PROJ, int b, int r, int h, int j, int lane) {
    const int fr = lane & 15, rq = lane >> 4;
    const int rs = min(max(r - 4, 0), 120);
    const int cb = (j == 0) ? 0 : (j == 1) ? 8 : (j == 2) ? 24 : 32;
    const size_t tq = (size_t)b * SEQ + 64 * r + 16 * j + fr;
    const bf16* qp = PROJ + tq * PPITCH + C_Q + h * 64 + 16 * rq;
    K.q0 = *(const bf16x8*)qp; K.q1 = *(const bf16x8*)(qp + 8);
    const bf16* kbase = PROJ + ((size_t)b * SEQ + 64 * rs + cb + fr) * PPITCH + C_K + h * 64 + 16 * rq;
#pragma unroll
    for (int ir = 0; ir < 8; ++ir)
#pragma unroll
        for (int hf = 0; hf < 2; ++hf) {
            const bf16* kp = kbase + (size_t)(64 * ir + 16 * hf) * PPITCH;
            K.kf[ir][hf][0] = *(const bf16x8*)kp; K.kf[ir][hf][1] = *(const bf16x8*)(kp + 8);
        }
}
__device__ __forceinline__ void attn_compute(const AttnK& K, const LAS unsigned char* vt, const LAS float* rpb, bf16* __restrict__ BR, int b, int r, int h, int j, int lane) {
    const int fr = lane & 15, rq = lane >> 4;
    const int rs = min(max(r - 4, 0), 120);
    const int cb = (j == 0) ? 0 : (j == 1) ? 8 : (j == 2) ? 24 : 32;
    const size_t tq = (size_t)b * SEQ + 64 * r + 16 * j + fr;
    f32x4 S[8][2];
#pragma unroll
    for (int ir = 0; ir < 8; ++ir)
#pragma unroll
        for (int hf = 0; hf < 2; ++hf) {
            f32x4 s = {0.f, 0.f, 0.f, 0.f};
            s = mfma16(K.kf[ir][hf][0], K.q0, s); s = mfma16(K.kf[ir][hf][1], K.q1, s);
            S[ir][hf] = s;
        }
    const int c = 16 * j + fr, cs = min(max(c - 8, 0), 48);
    float mx = -1e30f;
#pragma unroll
    for (int ir = 0; ir < 8; ++ir) {
        const LAS float* brow = rpb + (rs + ir - r + 7) * 31;
#pragma unroll
        for (int hf = 0; hf < 2; ++hf)
#pragma unroll
            for (int i = 0; i < 4; ++i) {
                const int kc = cb + 16 * hf + 4 * rq + i; const bool valid = (kc >= cs) && (kc < cs + 16);
                const int bi = min(max(kc - c + 15, 0), 30);
                const float sv = valid ? S[ir][hf][i] + brow[bi] : -1e30f;
                S[ir][hf][i] = sv; mx = fmaxf(mx, sv);
            }
    }
    mx = fmaxf(mx, __shfl_xor(mx, 16)); mx = fmaxf(mx, __shfl_xor(mx, 32));
    float sum = 0.f;
#pragma unroll
    for (int ir = 0; ir < 8; ++ir)
#pragma unroll
        for (int hf = 0; hf < 2; ++hf)
#pragma unroll
            for (int i = 0; i < 4; ++i) { const float p = __builtin_amdgcn_exp2f((S[ir][hf][i] - mx) * 1.44269504f); S[ir][hf][i] = p; sum += p; }
    sum += __shfl_xor(sum, 16); sum += __shfl_xor(sum, 32);
    f32x4 O[4];
#pragma unroll
    for (int d = 0; d < 4; ++d) O[d] = (f32x4){0.f, 0.f, 0.f, 0.f};
    const int q4 = (lane & 15) >> 2, p4 = lane & 3;
    const LAS unsigned char* vb = vt + (cb + 4 * rq + q4) * 128 + 8 * p4;
#pragma unroll
    for (int ir = 0; ir < 8; ++ir) {
        u32x4 pw; pw.x = pk2(S[ir][0][0], S[ir][0][1]); pw.y = pk2(S[ir][0][2], S[ir][0][3]); pw.z = pk2(S[ir][1][0], S[ir][1][1]); pw.w = pk2(S[ir][1][2], S[ir][1][3]);
        const bf16x8 Bp = __builtin_bit_cast(bf16x8, pw);
#pragma unroll
        for (int d = 0; d < 4; ++d) {
            const LAS unsigned char* p0 = vb + (64 * ir) * 128 + 32 * d;
            O[d] = mfma16(tr_frag(p0, p0 + 16 * 128), Bp, O[d]);
        }
    }
    const float inv = 1.0f / sum;
#pragma unroll
    for (int dp = 0; dp < 2; ++dp) { u32x2 w[2];
#pragma unroll
        for (int hh = 0; hh < 2; ++hh) { const int d = 2 * dp + hh; w[hh].x = pk2(O[d][0] * inv, O[d][1] * inv); w[hh].y = pk2(O[d][2] * inv, O[d][3] * inv); }
        *(u32x4*)(BR + tq * BRP + h * 64 + 32 * dp + 16 * (rq & 1) + 4 * (rq & ~1)) = pair16(w[0], w[1]); }
}
constexpr int XP = 544;
constexpr int FX_OFF = 0, FT_OFF = 128 * XP;
template <int NMT, int NNT>
__device__ __forceinline__ void dft_core(const LAS unsigned char* xl, const LAS unsigned char* tl, int wm, int cbase, int lane, f32x4 (&acc)[2][NMT][NNT]) {
#pragma unroll
    for (int p = 0; p < 2; ++p)
#pragma unroll
        for (int m = 0; m < NMT; ++m)
#pragma unroll
            for (int n = 0; n < NNT; ++n) acc[p][m][n] = (f32x4){0.f, 0.f, 0.f, 0.f};
    const int g = lane >> 4, q = (lane & 15) >> 2, p4 = lane & 3;
#pragma unroll 1
    for (int ks = 0; ks < 4; ++ks) {
        bf16x8 Bf[NNT];
#pragma unroll
        for (int n = 0; n < NNT; ++n) {
            const LAS unsigned char* p0 = xl + (32 * ks + 8 * g + q) * XP + (cbase + 16 * n + 4 * p4) * 2;
            Bf[n] = tr_frag(p0, p0 + 4 * XP);
        }
#pragma unroll
        for (int p = 0; p < 2; ++p)
#pragma unroll
            for (int m = 0; m < NMT; ++m) {
                const int tile = p * (2 * NMT) + wm * NMT + m;
                const bf16x8 Af = *(const LAS bf16x8*)(tl + ((tile * 4 + ks) * 64 + lane) * 16);
#pragma unroll
                for (int n = 0; n < NNT; ++n) acc[p][m][n] = mfma16(Bf[n], Af, acc[p][m][n]);
            }
    }
}
__device__ __forceinline__ void dft_load_x(Frame& F, const bf16* src, size_t rstride) {
    const int chunk = F.tid & 31, row0 = F.tid >> 5;
    u32x4 v[8];
#pragma unroll
    for (int it = 0; it < 8; ++it) v[it] = *(const u32x4*)(src + (size_t)(row0 + 16 * it) * rstride + chunk * 8);
#pragma unroll
    for (int it = 0; it < 8; ++it) *(LAS u32x4*)(F.lds + FX_OFF + (row0 + 16 * it) * XP + chunk * 16) = v[it];
}
template <int STEP>
__device__ __forceinline__ u32x4 dft_table_entry(int idx) {
    const int tile = idx >> 8, ks = (idx >> 6) & 3, ln = idx & 63;
    float v[8];
#pragma unroll
    for (int j = 0; j < 8; ++j) {
        const int k = 32 * ks + 8 * (ln >> 4) + j; float sv, cv;
        if (STEP == 0) { const int part = tile >> 3, prow = (tile & 7) * 16 + (ln & 15); const int mi = (prow * k) & 127; sincospif((float)mi * (1.0f / 64.0f), &sv, &cv);
            v[j] = (part == 0 ? cv : -sv) * 0.08838834764831845f; }
        else { const int part = tile >> 2, prow = (tile & 3) * 16 + (ln & 15), pin = k >> 6, n2 = k & 63; const int mi = (prow * n2) & 63; sincospif((float)mi * (1.0f / 32.0f), &sv, &cv);
            v[j] = (part == 0 ? (pin == 0 ? cv : sv) : (pin == 0 ? -sv : cv)) * 0.125f; }
    }
    u32x4 w; w.x = pk2(v[0], v[1]); w.y = pk2(v[2], v[3]); w.z = pk2(v[4], v[5]); w.w = pk2(v[6], v[7]);
    return w;
}
template <int STEP>
__device__ __forceinline__ void dft_fill_table(Frame& F) {
    constexpr int NE = (STEP == 0 ? 16 : 8) * 256;
    const u32x4* src = (const u32x4*)(F.GW) + (STEP == 0 ? 12288 : 16384);
#pragma unroll
    for (int it = 0; it < NE / 512; ++it) { const int idx = F.tid + 512 * it; *(LAS u32x4*)(F.lds + FT_OFF + idx * 16) = src[idx]; }
}
__device__ __forceinline__ void fft_a_unit(Frame& F, int unit) {
    const int b = unit >> 7, n2 = (unit >> 1) & 63, chh = unit & 1, lane = F.lane, wm = F.wave >> 2, wn = F.wave & 3, rq = lane >> 4;
    dft_load_x(F, F.PROJ + ((size_t)b * SEQ + n2) * PPITCH + C_UF + 256 * chh, (size_t)64 * PPITCH);
    LDS_WAIT(); __syncthreads();
#pragma unroll 1
    for (int cp = 0; cp < 2; ++cp) {
    f32x4 acc[2][4][2];
    dft_core<4, 2>(F.lds + FX_OFF, F.lds + FT_OFF, wm, 64 * wn + 32 * cp, lane, acc);
#pragma unroll
    for (int m = 0; m < 4; ++m) {
        const int k1 = 64 * wm + 16 * m + (lane & 15); float sv, cv; sincospif((float)(n2 * k1) * (1.0f / 4096.0f), &sv, &cv);
        u32x2 wre[2], wim[2];
#pragma unroll
        for (int n = 0; n < 2; ++n) {
            float re[4], im[4];
#pragma unroll
            for (int i = 0; i < 4; ++i) { const float tr = acc[0][m][n][i], ti = acc[1][m][n][i]; re[i] = tr * cv + ti * sv; im[i] = ti * cv - tr * sv; }
            wre[n].x = pk2(re[0], re[1]); wre[n].y = pk2(re[2], re[3]); wim[n].x = pk2(im[0], im[1]); wim[n].y = pk2(im[2], im[3]);
        }
        bf16* o0 = F.TP + ((((size_t)(b * 128 + k1) * 2 + 0) * 64 + n2) * 512) + 256 * chh + 64 * wn + 32 * cp + 16 * (rq & 1) + 4 * (rq & ~1);
        *(u32x4*)o0 = pair16(wre[0], wre[1]);
        *(u32x4*)(o0 + 64 * 512) = pair16(wim[0], wim[1]);
    }
    }
    __syncthreads();
}
__device__ __forceinline__ void fft_c_unit(Frame& F, int unit) {
    const int b = unit >> 8, k1 = (unit >> 1) & 127, chh = unit & 1, lane = F.lane, wm = F.wave >> 2, wn = F.wave & 3, rq = lane >> 4;
    dft_load_x(F, F.TP + ((size_t)(b * 128 + k1) * 128) * 512 + 256 * chh, (size_t)512);
    LDS_WAIT(); __syncthreads();
    f32x4 acc[2][2][4];
    dft_core<2, 4>(F.lds + FX_OFF, F.lds + FT_OFF, wm, 64 * wn, lane, acc);
#pragma unroll
    for (int p = 0; p < 2; ++p)
#pragma unroll
        for (int m = 0; m < 2; ++m) {
            const int k2 = 32 * wm + 16 * m + (lane & 15);
            bf16* o0 = F.BR + ((size_t)b * SEQ + k1 + 128 * k2) * BRP + 512 + p * 512 + 256 * chh + 64 * wn + 16 * (rq & 1) + 4 * (rq & ~1);
#pragma unroll
            for (int np = 0; np < 2; ++np) {
                u32x2 w[2];
#pragma unroll
                for (int h = 0; h < 2; ++h) { w[h].x = pk2(acc[p][m][2 * np + h][0], acc[p][m][2 * np + h][1]); w[h].y = pk2(acc[p][m][2 * np + h][2], acc[p][m][2 * np + h][3]); }
                *(u32x4*)(o0 + 32 * np) = pair16(w[0], w[1]);
            }
        }
    __syncthreads();
}

template <bool REV, bool FULL>
__device__ __forceinline__ void lru_scan(const f32x4 (&a)[4], const f32x4 (&bt)[4], float carry_in, f32x4 (&h)[4], f32x4 (&P)[4], float& Atot, float& Btot, int lane) {
    const int rq = lane >> 4, fr = lane & 15;
    float carry = carry_in, At = 1.f;
#pragma unroll
    for (int mm = 0; mm < 4; ++mm) {
        const int mt = REV ? 3 - mm : mm;
        float hl[4], cA[4];
        if (!REV) { hl[0] = bt[mt][0]; cA[0] = a[mt][0];
#pragma unroll
            for (int i = 1; i < 4; ++i) { hl[i] = a[mt][i] * hl[i - 1] + bt[mt][i]; cA[i] = a[mt][i] * cA[i - 1]; } }
        else { hl[3] = bt[mt][3]; cA[3] = a[mt][3];
#pragma unroll
            for (int i = 2; i >= 0; --i) { hl[i] = a[mt][i] * hl[i + 1] + bt[mt][i]; cA[i] = a[mt][i] * cA[i + 1]; } }
        float SA = REV ? cA[0] : cA[3], SB = REV ? hl[0] : hl[3];
        float pA, pB;
        if (!REV) {
            pA = __shfl_up(SA, 16); pB = __shfl_up(SB, 16); if (rq >= 1) { SB = SA * pB + SB; SA = SA * pA; }
            pA = __shfl_up(SA, 32); pB = __shfl_up(SB, 32); if (rq >= 2) { SB = SA * pB + SB; SA = SA * pA; }
        } else {
            pA = __shfl_down(SA, 16); pB = __shfl_down(SB, 16); if (rq <= 2) { SB = SA * pB + SB; SA = SA * pA; }
            pA = __shfl_down(SA, 32); pB = __shfl_down(SB, 32); if (rq <= 1) { SB = SA * pB + SB; SA = SA * pA; }
        }
        float eA, eB;
        if (!REV) { eA = __shfl_up(SA, 16); eB = __shfl_up(SB, 16); if (rq == 0) { eA = 1.f; eB = 0.f; } }
        else { eA = __shfl_down(SA, 16); eB = __shfl_down(SB, 16); if (rq == 3) { eA = 1.f; eB = 0.f; } }
        const float tA = __shfl(SA, REV ? fr : 48 + fr), tB = __shfl(SB, REV ? fr : 48 + fr);
        if (FULL) { const float hs = eA * carry + eB, pe = eA * At;
#pragma unroll
            for (int i = 0; i < 4; ++i) { h[mt][i] += hl[i] + cA[i] * hs; P[mt][i] = cA[i] * pe; } }
        carry = tA * carry + tB; At *= tA;
        __builtin_amdgcn_sched_barrier(0);
    }
    Atot = At; Btot = carry;
}
template <int PASS>
__device__ __forceinline__ void lru_unit(Frame& F, const Args& a, int l, int b, int r) {
    const int w = F.wave, ch0 = 64 * w;
    LAS float* carry_lds = (LAS float*)(F.lds);
    if (PASS == 2) {
        const int ch = F.wave * 64 + lane_id(); float hf = 0.f, hb = 0.f;
        const f32x2* sf = F.LSUM + ((size_t)(0 * 2 + b) * 128) * 512 + ch; const f32x2* sb = F.LSUM + ((size_t)(1 * 2 + b) * 128) * 512 + ch;
        for (int r0 = 0; r0 < r; r0 += 32) {
            f32x2 sv[32];
#pragma unroll
            for (int k = 0; k < 32; ++k) sv[k] = sf[(size_t)min(r0 + k, 127) * 512];
#pragma unroll
            for (int k = 0; k < 32; ++k) if (r0 + k < r) hf = sv[k].x * hf + sv[k].y;
        }
        for (int r0 = 127; r0 > r; r0 -= 32) {
            f32x2 sv[32];
#pragma unroll
            for (int k = 0; k < 32; ++k) sv[k] = sb[(size_t)max(r0 - k, 0) * 512];
#pragma unroll
            for (int k = 0; k < 32; ++k) if (r0 - k > r) hb = sv[k].x * hb + sv[k].y;
        }
        carry_lds[ch] = hf; carry_lds[512 + ch] = hb;
        LDS_WAIT(); __syncthreads();
    }
    const int lane = lane_id(), fr = lane & 15, rq = lane >> 4;
    if constexpr (PASS == 2) {
#pragma unroll 1
        for (int nt = 0; nt < 4; ++nt) {
            const int ch = ch0 + 16 * nt + fr;
            const size_t sb = ((size_t)((b * 128 + r) * 8 + w) * 4 + nt);
            const u32x4* ph = F.LSTH + sb * 128 + lane; const u32x4* pp = F.LSTP + sb * 256 + lane;
            u32x4 hv[2], pf[2], pb[2];
#pragma unroll
            for (int hh = 0; hh < 2; ++hh) { hv[hh] = ph[64 * hh]; pf[hh] = pp[64 * hh]; pb[hh] = pp[128 + 64 * hh]; }
            unsigned short ggv[4][4];
#pragma unroll
            for (int mt = 0; mt < 4; ++mt)
#pragma unroll
                for (int i = 0; i < 4; ++i) ggv[mt][i] = F.PROJ[((size_t)b * SEQ + 64 * r + 16 * mt + 4 * rq + i) * PPITCH + C_UG + ch];
            const float cf = carry_lds[ch], cb = carry_lds[512 + ch];
#pragma unroll
            for (int mt = 0; mt < 4; ++mt)
#pragma unroll
                for (int i = 0; i < 4; ++i) {
                    const int hh = mt >> 1, dwi = (mt & 1) * 2 + (i >> 1);
                    const unsigned hw = hv[hh][dwi], fw = pf[hh][dwi], bw = pb[hh][dwi];
                    const float hval = (i & 1) ? bfhi(hw) : bflo(hw), fval = (i & 1) ? bfhi(fw) : bflo(fw), bval = (i & 1) ? bfhi(bw) : bflo(bw);
                    const size_t tok = (size_t)b * SEQ + 64 * r + 16 * mt + 4 * rq + i;
                    F.BR[tok * BRP + 1536 + ch] = (bf16)(pk2((hval + fval * cf + bval * cb) * bf2f(ggv[mt][i]), 0.f) & 0xffffu);
                }
        }
        __syncthreads();
        return;
    }
    bf16x8 Af[4][2];
#pragma unroll
    for (int ks = 0; ks < 2; ++ks) {
        const int chA = ch0 + 32 * ks + 8 * rq;
        float cw[4][8], cbv[8];
#pragma unroll
        for (int t = 0; t < 4; ++t) { const f32x4 w0 = *(const f32x4*)(a.conv_w + ((size_t)l * 4 + t) * 512 + chA), w1 = *(const f32x4*)(a.conv_w + ((size_t)l * 4 + t) * 512 + chA + 4);
            cw[t][0] = w0[0]; cw[t][1] = w0[1]; cw[t][2] = w0[2]; cw[t][3] = w0[3]; cw[t][4] = w1[0]; cw[t][5] = w1[1]; cw[t][6] = w1[2]; cw[t][7] = w1[3]; }
        { const f32x4 b0 = *(const f32x4*)(a.conv_b + (size_t)l * 512 + chA), b1 = *(const f32x4*)(a.conv_b + (size_t)l * 512 + chA + 4);
            cbv[0] = b0[0]; cbv[1] = b0[1]; cbv[2] = b0[2]; cbv[3] = b0[3]; cbv[4] = b1[0]; cbv[5] = b1[1]; cbv[6] = b1[2]; cbv[7] = b1[3]; }
#pragma unroll
        for (int mt = 0; mt < 4; ++mt) {
            const int s = 64 * r + 16 * mt + fr;
            float c8[8];
#pragma unroll
            for (int e = 0; e < 8; ++e) c8[e] = cbv[e];
#pragma unroll
            for (int t = 0; t < 4; ++t) {
                const int sp = s + t - 2;
                if (sp >= 0 && sp < SEQ) {
                    const u32x4 uv = *(const u32x4*)(F.PROJ + ((size_t)b * SEQ + sp) * PPITCH + C_UX + chA);
                    c8[0] += cw[t][0] * bflo(uv.x); c8[1] += cw[t][1] * bfhi(uv.x); c8[2] += cw[t][2] * bflo(uv.y); c8[3] += cw[t][3] * bfhi(uv.y);
                    c8[4] += cw[t][4] * bflo(uv.z); c8[5] += cw[t][5] * bfhi(uv.z); c8[6] += cw[t][6] * bflo(uv.w); c8[7] += cw[t][7] * bfhi(uv.w);
                }
            }
            u32x4 pw; pw.x = pk2(c8[0], c8[1]); pw.y = pk2(c8[2], c8[3]); pw.z = pk2(c8[4], c8[5]); pw.w = pk2(c8[6], c8[7]);
            Af[mt][ks] = __builtin_bit_cast(bf16x8, pw);
            __builtin_amdgcn_sched_barrier(0);
        }
    }
    const bf16* WLb = F.WL + ((size_t)(l * 8 + w) * 4) * 4096;
#pragma unroll 1
    for (int nt = 0; nt < 4; ++nt) {
        const int ch = ch0 + 16 * nt + fr;
        f32x4 cD[4];
#pragma unroll
        for (int mt = 0; mt < 4; ++mt) cD[mt] = (f32x4){0.f, 0.f, 0.f, 0.f};
#pragma unroll
        for (int ks = 0; ks < 2; ++ks) {
            bf16x8 I8;
#pragma unroll
            for (int j = 0; j < 8; ++j) I8[j] = (32 * ks + 8 * rq + j == 16 * nt + fr) ? (short)0x3F80 : (short)0;
#pragma unroll
            for (int mt = 0; mt < 4; ++mt) cD[mt] = mfma16(Af[mt][ks], I8, cD[mt]);
        }
        f32x4 hsum[4];
#pragma unroll
        for (int mt = 0; mt < 4; ++mt) hsum[mt] = (f32x4){0.f, 0.f, 0.f, 0.f};
        bf16x8 Bw[2][2][2];
#pragma unroll
        for (int dir = 0; dir < 2; ++dir)
#pragma unroll
            for (int mat = 0; mat < 2; ++mat)
#pragma unroll
                for (int ks = 0; ks < 2; ++ks) Bw[dir][mat][ks] = *(const bf16x8*)(WLb + (size_t)(2 * dir + mat) * 4096 + (16 * nt + fr) * 64 + 32 * ks + 8 * rq);
        float pba[2], pbx[2], pns[2];
#pragma unroll
        for (int dir = 0; dir < 2; ++dir) { pba[dir] = -1.44269504f * a.lru_ba[(size_t)(l * 2 + dir) * 512 + ch]; pbx[dir] = -1.44269504f * a.lru_bx[(size_t)(l * 2 + dir) * 512 + ch]; pns[dir] = 1.44269504f * F.NSP[(l * 2 + dir) * 512 + ch]; }
#pragma unroll
        for (int dir = 0; dir < 2; ++dir) {
            __builtin_amdgcn_sched_barrier(0);
            f32x4 xa[4], xx[4];
#pragma unroll
            for (int mt = 0; mt < 4; ++mt) { xa[mt] = (f32x4){0.f, 0.f, 0.f, 0.f}; xx[mt] = (f32x4){0.f, 0.f, 0.f, 0.f}; }
#pragma unroll
            for (int ks = 0; ks < 2; ++ks) {
#pragma unroll
                for (int mt = 0; mt < 4; ++mt) { xa[mt] = mfma16(Af[mt][ks], Bw[dir][0][ks], xa[mt]); xx[mt] = mfma16(Af[mt][ks], Bw[dir][1][ks], xx[mt]); }
            }
            const float ba = pba[dir], bx = pbx[dir], ns = pns[dir];
            f32x4 av[4], bt[4]; float igc_first = 0.f, igc_last = 0.f;
#pragma unroll
            for (int mt = 0; mt < 4; ++mt)
#pragma unroll
                for (int i = 0; i < 4; ++i) {
                    const float rg = __builtin_amdgcn_rcpf(1.0f + __builtin_amdgcn_exp2f(__builtin_fmaf(xa[mt][i], -1.44269504f, ba)));
                    const float ig = __builtin_amdgcn_rcpf(1.0f + __builtin_amdgcn_exp2f(__builtin_fmaf(xx[mt][i], -1.44269504f, bx)));
                    const float aa = __builtin_amdgcn_exp2f(ns * rg);
                    const float mult = __builtin_amdgcn_sqrtf(fmaxf(__builtin_fmaf(-aa, aa, 1.0f), 0.f));
                    const float igc = ig * cD[mt][i];
                    if (mt == 0 && i == 0) igc_first = igc;
                    if (mt == 3 && i == 3) igc_last = igc;
                    av[mt][i] = aa; bt[mt][i] = mult * igc;
                    if (i == 3) __builtin_amdgcn_sched_barrier(0);
                }
            if (dir == 0) { if (r == 0 && rq == 0) bt[0][0] = igc_first; }
            else { if (r == 127 && rq == 3) bt[3][3] = igc_last; }
            float At, Bt; f32x4 Pd[4];
            if (dir == 0) lru_scan<false, true>(av, bt, 0.f, hsum, Pd, At, Bt, lane); else lru_scan<true, true>(av, bt, 0.f, hsum, Pd, At, Bt, lane);
            if (rq == 0) { f32x2 sm; sm.x = At; sm.y = Bt; F.LSUM[((size_t)(dir * 2 + b) * 128 + r) * 512 + ch] = sm; }
            { u32x4* pp = F.LSTP + ((size_t)((b * 128 + r) * 8 + w) * 4 + nt) * 256 + dir * 128 + lane;
#pragma unroll
              for (int hh = 0; hh < 2; ++hh) { u32x4 o; o.x = pk2(Pd[2 * hh][0], Pd[2 * hh][1]); o.y = pk2(Pd[2 * hh][2], Pd[2 * hh][3]); o.z = pk2(Pd[2 * hh + 1][0], Pd[2 * hh + 1][1]); o.w = pk2(Pd[2 * hh + 1][2], Pd[2 * hh + 1][3]); pp[64 * hh] = o; } }

        }
        { u32x4* ph = F.LSTH + ((size_t)((b * 128 + r) * 8 + w) * 4 + nt) * 128 + lane;
#pragma unroll
          for (int hh = 0; hh < 2; ++hh) { u32x4 o; o.x = pk2(hsum[2 * hh][0], hsum[2 * hh][1]); o.y = pk2(hsum[2 * hh][2], hsum[2 * hh][3]); o.z = pk2(hsum[2 * hh + 1][0], hsum[2 * hh + 1][1]); o.w = pk2(hsum[2 * hh + 1][2], hsum[2 * hh + 1][3]); ph[64 * hh] = o; } }
    }
}

__device__ __forceinline__ void moe_router(Frame& F, int jm, const unsigned long long* rs) {
    const int gw = F.vcu * NWAVES + F.wave, NGW = F.G * NWAVES, lane = F.lane;
    const float* GWj = F.GW + (size_t)jm * 1024 * 8;
    unsigned* cnt = F.ctl + CW_MOE + jm * 8 * 64;
    LAS float* gwt = (LAS float*)F.lds;
    for (int i = F.tid; i < 1024 * 8; i += 512) gwt[(i & 7) * 1024 + (i >> 3)] = GWj[i];
    LDS_WAIT(); __syncthreads();
    for (int t = gw; t < M; t += NGW) {
        const u32x2* hr = (const u32x2*)(F.HB + (size_t)t * D) + lane;
        float lg[8];
#pragma unroll
        for (int e = 0; e < 8; ++e) lg[e] = 0.f;
#pragma unroll
        for (int j = 0; j < 4; ++j) {
            const u32x2 hw = hr[64 * j]; const float hv[4] = {bflo(hw.x), bfhi(hw.x), bflo(hw.y), bfhi(hw.y)}; const int k0 = 4 * lane + 256 * j;
#pragma unroll
            for (int e = 0; e < 8; ++e) { const f32x4 g = *(const LAS f32x4*)(gwt + e * 1024 + k0); lg[e] += (hv[0] * g[0] + hv[1] * g[1]) + (hv[2] * g[2] + hv[3] * g[3]); }
        }
#pragma unroll
        for (int e = 0; e < 8; ++e) lg[e] = wave_sum(lg[e]);
        const float sr = 1.0f / sqrtf((float)rs[t] * (1.0f / (RS_SCALE * D)) + RMS_EPS);
        int e0 = 0; float v0 = lg[0];
#pragma unroll
        for (int e = 1; e < 8; ++e) if (lg[e] > v0) { v0 = lg[e]; e0 = e; }
        int e1 = -1; float v1 = -3.0e38f;
#pragma unroll
        for (int e = 0; e < 8; ++e) if (e != e0 && lg[e] > v1) { v1 = lg[e]; e1 = e; }
        const float w0 = 1.0f / (1.0f + expf((v1 - v0) * sr)), w1 = 1.0f - w0;
        if (lane == 0) {
            const int p0 = (int)atomicAdd(cnt + e0 * 64, 1u), p1 = (int)atomicAdd(cnt + e1 * 64, 1u);
            F.LIST[e0 * 16384 + p0] = t; F.LIST[e1 * 16384 + p1] = t;
            F.SROW[e0 * 16384 + p0] = sr; F.SROW[e1 * 16384 + p1] = sr;
            F.WSLOT[e0 * 16384 + p0] = w0; F.WSLOT[e1 * 16384 + p1] = w1;
            int4 ti; ti.x = e0; ti.y = p0; ti.z = e1; ti.w = p1; ((int4*)F.TOKI)[t] = ti;
        }
    }
    __syncthreads();
}
__device__ __forceinline__ void moe_sched_init(Frame& F, int jm, pg8::SchedMoe& S) {
    const unsigned* cnt = F.ctl + CW_MOE + jm * 8 * 64;
#define RFL(x) __builtin_amdgcn_readfirstlane((int)(x))
    S.cntp = cnt;
    const int c0 = RFL(cnt[0]), c1 = RFL(cnt[64]), c2 = RFL(cnt[128]), c3 = RFL(cnt[192]), c4 = RFL(cnt[256]), c5 = RFL(cnt[320]), c6 = RFL(cnt[384]), c7 = RFL(cnt[448]);
#undef RFL
    S.t1 = (c0 + 255) >> 8; S.t2 = S.t1 + ((c1 + 255) >> 8); S.t3 = S.t2 + ((c2 + 255) >> 8); S.t4 = S.t3 + ((c3 + 255) >> 8);
    S.t5 = S.t4 + ((c4 + 255) >> 8); S.t6 = S.t5 + ((c5 + 255) >> 8); S.t7 = S.t6 + ((c6 + 255) >> 8); S.t8 = S.t7 + ((c7 + 255) >> 8);
}
__device__ __forceinline__ void moe_combine(Frame& F, const Args& a, int jm, unsigned long long* rs_next, bool final_layer) {
    const int gw = F.vcu * NWAVES + F.wave, NGW = F.G * NWAVES, lane = F.lane;
    pg8::SchedMoe S; moe_sched_init(F, jm, S);
    for (int t = gw; t < M; t += NGW) {
        const int4 ti = ((const int4*)F.TOKI)[t];
        const int ta = ti.x == 0 ? 0 : ti.x == 1 ? S.t1 : ti.x == 2 ? S.t2 : ti.x == 3 ? S.t3 : ti.x == 4 ? S.t4 : ti.x == 5 ? S.t5 : ti.x == 6 ? S.t6 : S.t7;
        const int tb = ti.z == 0 ? 0 : ti.z == 1 ? S.t1 : ti.z == 2 ? S.t2 : ti.z == 3 ? S.t3 : ti.z == 4 ? S.t4 : ti.z == 5 ? S.t5 : ti.z == 6 ? S.t6 : S.t7;
        const size_t s0 = (size_t)ta * 256 + ti.y, s1 = (size_t)tb * 256 + ti.w;
        u32x2* hr = (u32x2*)(F.HB + (size_t)t * D) + lane;
        const u32x2* y0 = (const u32x2*)(F.YBUF + s0 * D) + lane; const u32x2* y1 = (const u32x2*)(F.YBUF + s1 * D) + lane;
        f32x4 v[4]; float ss = 0.f;
#pragma unroll
        for (int j = 0; j < 4; ++j) { const u32x2 a0 = y0[64 * j], a1 = y1[64 * j], hw = hr[64 * j]; f32x4 hv;
            hv[0] = bflo(hw.x) + bflo(a0.x) + bflo(a1.x); hv[1] = bfhi(hw.x) + bfhi(a0.x) + bfhi(a1.x); hv[2] = bflo(hw.y) + bflo(a0.y) + bflo(a1.y); hv[3] = bfhi(hw.y) + bfhi(a0.y) + bfhi(a1.y);
            v[j] = hv; ss += (hv[0] * hv[0] + hv[1] * hv[1]) + (hv[2] * hv[2] + hv[3] * hv[3]); }
        ss = wave_sum(ss);
        if (final_layer) {
            const float sr = 1.0f / sqrtf(ss * (1.0f / D) + RMS_EPS);
            f32x4* orow = (f32x4*)(F.H + (size_t)t * D) + lane;
#pragma unroll
            for (int j = 0; j < 4; ++j) { const f32x4 g = *((const f32x4*)a.final_g + lane + 64 * j); orow[64 * j] = v[j] * sr * g; }
        } else {
#pragma unroll
            for (int j = 0; j < 4; ++j) { u32x2 w; w.x = pk2(v[j][0], v[j][1]); w.y = pk2(v[j][2], v[j][3]); hr[64 * j] = w; }
            { unsigned* q8 = (unsigned*)(F.HB8 + (size_t)t * D) + lane;
#pragma unroll
              for (int j = 0; j < 4; ++j) q8[64 * j] = pk4_fp8(v[j][0], v[j][1], v[j][2], v[j][3]); }
            if (lane == 0) rs_next[t] = (unsigned long long)(ss * RS_SCALE);
        }
    }
}

__device__ __forceinline__ Frame mk_frame(const Args& args, LAS unsigned char* ldsp, int wave0) {
    Frame F;
    F.lds = ldsp;
    F.tid = tid_of(wave0); F.lane = F.tid & 63; F.wave = __builtin_amdgcn_readfirstlane(F.tid >> 6);
    F.G = gridDim.x; { const int bx = blockIdx.x; F.vcu = (F.G % 8 == 0) ? (bx % 8) * (F.G / 8) + bx / 8 : bx; }
    size_t zoff = 0; asm volatile("" : "+s"(zoff)); unsigned char* ws = args.ws + zoff; float* outp = args.out + zoff;
    F.ctl = (unsigned*)(ws + WS_CTL); F.H = outp;
    F.HB8 = ws + WS_HB8; F.HB = (bf16*)(ws + WS_HB); F.VT = nullptr; F.WIN8 = ws + WS_WIN8; F.BR = (bf16*)(ws + WS_BR); F.TP = (bf16*)(ws + WS_TP); F.MERGED = (bf16*)(ws + WS_MERGED);
    F.PROJ = (bf16*)(ws + WS_PROJ); F.HID = (bf16*)(ws + WS_HID); F.YBUF = (bf16*)(ws + WS_YBUF);
    F.WIN = (bf16*)(ws + WS_WIN); F.WBR = (bf16*)(ws + WS_WBR); F.WOUT = (bf16*)(ws + WS_WOUT); F.WGU = (bf16*)(ws + WS_WGU); F.WDN = (bf16*)(ws + WS_WDN);
    F.MGU = (bf16*)(ws + WS_MGU); F.MDN = (bf16*)(ws + WS_MDN); F.WL = (bf16*)(ws + WS_WL);
    F.NSP = (float*)(ws + WS_MISC); F.GW = (float*)(ws + WS_MISC + 65536); F.LSUM = (f32x2*)(ws + WS_LSUM); F.LSTH = (u32x4*)(ws + WS_LSTH); F.LSTP = (u32x4*)(ws + WS_LSTP); F.RS = (unsigned long long*)(ws + WS_RS);
    F.LIST = (int*)(ws + WS_MOEI); F.SROW = (float*)(ws + WS_MOEI + 524288); F.WSLOT = (float*)(ws + WS_MOEI + 2 * 524288); F.TOKI = (int*)(ws + WS_MOEI + 3 * 524288);
    return F;
}
__global__ void __launch_bounds__(NWAVES * 64, 2) enc_fwd(Args args) {
    extern __shared__ __attribute__((aligned(16))) unsigned char lds[];
    LAS unsigned char* const ldsp = (LAS unsigned char*)lds;
    volatile LAS unsigned* MISC = (volatile LAS unsigned*)(ldsp + MISC_OFF);
    const int wave0 = __builtin_amdgcn_readfirstlane((int)threadIdx.x >> 6);
    for (int u = wave0 * 64 + lane_id(); u < (LDS_BYTES - MISC_OFF) / 4; u += NWAVES * 64) ((LAS unsigned*)(ldsp + MISC_OFF))[u] = 0u;
    __syncthreads();
    XcdBarrier bar = xcd_barrier_post((unsigned*)(args.ws + WS_CTL) + CW_BAR + args.bar_region * XCD_BAR_WORDS, MISC + 8, wave0);
    const int lo = args.ph_lo, hi = args.ph_hi;
#ifndef PHASE_MASK
#define PHASE_MASK 0xFFFF
#endif
#define PM(k) (((PHASE_MASK) >> (k)) & 1)
#define IN(k) (lo <= (k) && (k) < hi)
#define SEAM(k) do { if (IN(k) && IN((k) + 1)) xcd_barrier(bar, wave0); } while (0)
#define RETID() Frame F = mk_frame(args, ldsp, wave0)

    if (PM(0) && IN(0)) { RETID(); p0_prologue(F, args); }
    SEAM(0);
#pragma unroll 1
    for (int l = 0; l < DEPTH; ++l) {
        const int pb = 1 + 9 * l;
        if (PM(1) && IN(pb + 0)) {
            RETID();
            { pg8::SchedPlain S; S.A = (const char*)F.HB; S.B = (const char*)(F.WIN + (size_t)l * INC * D); S.lda2 = D * 2; S.ldb2 = D * 2; S.nt = D / 64; S.nM = M / 256; S.nN = 12; S.G = F.G; S.c = (int)blockIdx.x;
              pg8::EpiProj<false> E; E.P = F.PROJ; E.VT = F.VT; E.bias = args.b_in + (size_t)l * INC; E.rs = F.RS + (size_t)(2 * l) * M; E.pn_off = 0; E.cs = 1.0f;
              pg8::gemm_phase<pg8::EpiProj<false>, pg8::SchedPlain, true, false>(F.lds, S, E, wave0); }
        }
        if (PM(1) && IN(pb + 0)) {
            RETID();
            { pg8::SchedPlain S; S.A = (const char*)F.HB8; S.B = (const char*)(F.WIN8 + (size_t)l * 3072 * D); S.lda2 = D; S.ldb2 = D; S.nt = D / 128; S.nM = M / 256; S.nN = 12; S.G = F.G; S.c = (int)blockIdx.x;
              pg8::EpiProj<true> E; E.P = F.PROJ; E.VT = F.VT; E.bias = args.b_in + (size_t)l * INC; E.rs = F.RS + (size_t)(2 * l) * M; E.pn_off = 12; E.cs = 1.0f / W8S;
              pg8::gemm_phase<pg8::EpiProj<true>, pg8::SchedPlain, true, false, true>(F.lds, S, E, wave0); }
        }
        SEAM(pb + 0);
        if (PM(2) && IN(pb + 1)) {
            RETID();
#ifndef P2M
#define P2M 7
#endif
            if (P2M & 1) {
            dft_fill_table<0>(F);
            LDS_WAIT(); __syncthreads();
            for (int u = F.vcu; u < 256; u += F.G) fft_a_unit(F, u);
            __syncthreads(); }
            if (P2M & 2) {
            for (int u = F.vcu; u < 256; u += F.G) { const int b = u >> 7, r = u & 127, rs = min(max(r - 4, 0), 120);
#pragma unroll 1
                for (int hp = 0; hp < 4; ++hp) {
                    const int h = 2 * hp + (F.wave >> 2), j = F.wave & 3;
                    AttnK K; attn_load_k(K, F.PROJ, b, r, h, j, F.lane);
                    __syncthreads();
                    { const int chunk = F.tid & 15, t0 = F.tid >> 4;
                      const bf16* vsrc = F.PROJ + ((size_t)b * SEQ + 64 * rs) * PPITCH + C_V + 128 * hp + 8 * chunk;
#pragma unroll 1
                      for (int hh = 0; hh < 2; ++hh) {
                      u32x4 vv[8];
#pragma unroll
                      for (int it = 0; it < 8; ++it) vv[it] = *(const u32x4*)(vsrc + (size_t)(t0 + 32 * (8 * hh + it)) * PPITCH);
#pragma unroll
                      for (int it = 0; it < 8; ++it) *(LAS u32x4*)(F.lds + (chunk >> 3) * AT_V1 + (t0 + 32 * (8 * hh + it)) * 128 + (chunk & 7) * 16) = vv[it];
                      }
                      const float* rp = args.na_rpb + ((size_t)l * 8 + 2 * hp) * 465; LAS float* rl = (LAS float*)(F.lds + AT_RPB);
                      for (int i = F.tid; i < 2 * 465; i += 512) rl[i] = rp[i]; }
                    LDS_WAIT(); __syncthreads();
                    attn_compute(K, F.lds + (F.wave >> 2) * AT_V1, (const LAS float*)(F.lds + AT_RPB) + (F.wave >> 2) * 465, F.BR, b, r, h, j, F.lane);
                } }
            __syncthreads(); }
            if (P2M & 4) for (int u = F.vcu; u < 256; u += F.G) lru_unit<1>(F, args, l, u >> 7, u & 127);
        }
        SEAM(pb + 1);
        if (PM(3) && IN(pb + 2)) {
            RETID();
            dft_fill_table<1>(F);
            LDS_WAIT(); __syncthreads();
            for (int u = F.vcu; u < 512; u += F.G) fft_c_unit(F, u);
            __syncthreads();
            for (int u = F.vcu; u < 256; u += F.G) lru_unit<2>(F, args, l, u >> 7, u & 127);
        }
        SEAM(pb + 2);
        if (PM(4) && IN(pb + 3)) {
            RETID();
            pg8::SchedMerge S; S.A = (const char*)F.BR; S.B = (const char*)(F.WBR + (size_t)l * D * BRP); S.lda2 = BRP * 2; S.ldb2 = BRP * 2; S.nM = M / 256; S.nN = D / 256; S.G = F.G; S.c = (int)blockIdx.x;
            pg8::EpiMerge E; E.G = (const unsigned char*)(F.PROJ + C_GATE); E.O = F.MERGED;
            pg8::gemm_phase<pg8::EpiMerge, pg8::SchedMerge, true, false>(F.lds, S, E, wave0);
        }
        SEAM(pb + 3);
        if (PM(5) && IN(pb + 4)) {
            RETID();
            pg8::SchedPlain S; S.A = (const char*)F.MERGED; S.B = (const char*)(F.WOUT + (size_t)l * D * D); S.lda2 = D * 2; S.ldb2 = D * 2; S.nt = D / 64; S.nM = M / 256; S.nN = D / 256; S.G = F.G; S.c = (int)blockIdx.x;
            pg8::EpiOut E; E.hb = F.HB; E.rs = F.RS + (size_t)(2 * l + 1) * M; E.hb8 = nullptr; E.cs = 1.0f;
            pg8::gemm_phase<pg8::EpiOut, pg8::SchedPlain, true, false>(F.lds, S, E, wave0);
        }
        SEAM(pb + 4);
        if ((l & 1) == 0) {
            const int j = l >> 1;
            if (PM(6) && IN(pb + 5)) {
                RETID();
                pg8::SchedPlain S; S.A = (const char*)F.HB; S.B = (const char*)(F.WGU + (size_t)j * 2 * DFF * D); S.lda2 = D * 2; S.ldb2 = D * 2; S.nt = D / 64; S.nM = M / 256; S.nN = 2 * DFF / 256; S.G = F.G; S.c = (int)blockIdx.x;
                pg8::EpiGU E; E.Hd = (unsigned char*)F.HID; E.ldh = DFF; E.rs = F.RS + (size_t)(2 * l + 1) * M; E.srow = nullptr; E.moe = false; E.cs = 1.0f;
                pg8::gemm_phase<pg8::EpiGU, pg8::SchedPlain, true, false, false>(F.lds, S, E, wave0);
            }
            SEAM(pb + 5);
            if (PM(7) && IN(pb + 6)) {
                RETID();
                pg8::SchedPlain S; S.A = (const char*)F.HID; S.B = (const char*)F.WDN + (size_t)j * D * DFF; S.lda2 = DFF; S.ldb2 = DFF; S.nt = DFF / 128; S.nM = M / 256; S.nN = D / 256; S.G = F.G; S.c = (int)blockIdx.x;
                pg8::EpiOut E; E.hb = F.HB; E.rs = F.RS + (size_t)(2 * l + 2) * M; E.hb8 = F.HB8; E.cs = 1.0f / (W8S * H8S);
                pg8::gemm_phase<pg8::EpiOut, pg8::SchedPlain, true, false, true>(F.lds, S, E, wave0);
            }
            SEAM(pb + 6);
        } else {
            const int jm = l >> 1;
            if (PM(8) && IN(pb + 5)) { RETID(); moe_router(F, jm, F.RS + (size_t)(2 * l + 1) * M); }
            SEAM(pb + 5);
            if (PM(9) && IN(pb + 6)) {
                RETID();
                pg8::SchedMoe S; moe_sched_init(F, jm, S);
                S.A = (const char*)F.HB; S.B = (const char*)(F.MGU + (size_t)(jm * 8) * 2 * DFE * D); S.list = F.LIST; S.lda2 = D * 2; S.ldb2 = D * 2; S.nt = D / 64; S.nN = 2 * DFE / 256; S.G = F.G; S.c = (int)blockIdx.x;
                S.bstride = (size_t)2 * DFE * D * 2; S.gather = true;
                pg8::EpiGU E; E.Hd = (unsigned char*)F.HID; E.ldh = DFE; E.rs = nullptr; E.srow = F.SROW; E.moe = true; E.cs = 1.0f;
                pg8::gemm_phase<pg8::EpiGU, pg8::SchedMoe, true, true, false>(F.lds, S, E, wave0);
            }
            SEAM(pb + 6);
            if (PM(10) && IN(pb + 7)) {
                RETID();
                pg8::SchedMoe S; moe_sched_init(F, jm, S);
                S.A = (const char*)F.HID; S.B = (const char*)F.MDN + (size_t)(jm * 8) * D * DFE; S.list = F.LIST; S.lda2 = DFE; S.ldb2 = DFE; S.nt = DFE / 128; S.nN = D / 256; S.G = F.G; S.c = (int)blockIdx.x;
                S.bstride = (size_t)D * DFE; S.gather = false;
                pg8::EpiMoeDown E; E.Y = F.YBUF; E.wslot = F.WSLOT;
                pg8::gemm_phase<pg8::EpiMoeDown, pg8::SchedMoe, true, false, true>(F.lds, S, E, wave0);
            }
            SEAM(pb + 7);
            if (PM(11) && IN(pb + 8)) { RETID(); moe_combine(F, args, jm, F.RS + (size_t)((2 * l + 2) & 7) * M, l == DEPTH - 1); }
            SEAM(pb + 8);
        }
    }
#undef IN
#undef SEAM
}

#ifndef ABL
#define ABL 0
#endif
#ifndef MK_PER_PHASE
#define MK_PER_PHASE 0
#endif
extern "C" void kernel_launch(void* const* d_in, const int* in_sizes, int n_in, void* d_out, int out_size, void* d_ws, size_t ws_size, hipStream_t stream) {
    static int grid = 0;
    if (grid == 0) {
        if (n_in != 21 || out_size != M * D || ws_size < WS_END) { fprintf(stderr, "kernel_launch: unexpected shapes (n_in %d out %d ws %zu)\n", n_in, out_size, ws_size); grid = -1; return; }
        int dev = 0, cus = 0, per_cu = 0;
        if (hipGetDevice(&dev) != hipSuccess || hipDeviceGetAttribute(&cus, hipDeviceAttributeMultiprocessorCount, dev) != hipSuccess) { grid = -1; return; }
        if (hipFuncSetAttribute((const void*)enc_fwd, hipFuncAttributeMaxDynamicSharedMemorySize, LDS_BYTES) != hipSuccess) { fprintf(stderr, "kernel_launch: hipFuncSetAttribute failed\n"); grid = -1; return; }
        if (hipOccupancyMaxActiveBlocksPerMultiprocessor(&per_cu, (const void*)enc_fwd, NWAVES * 64, LDS_BYTES) != hipSuccess || per_cu < 1)
            fprintf(stderr, "kernel_launch: note: occupancy query reports %d workgroups per CU\n", per_cu);
        (void)hipGetLastError();
        grid = cus;
    }
    if (grid < 0) return;
    (void)hipMemsetAsync((char*)d_ws + WS_CTL, 0, CTL_ZERO_BYTES, stream);
    (void)hipMemsetAsync((char*)d_ws + WS_RS, 0, 1 * MiB, stream);
    Args a{};
    a.x = (const float*)d_in[0]; a.norm_mix_g = (const float*)d_in[1]; a.w_in = (const float*)d_in[2]; a.b_in = (const float*)d_in[3]; a.na_rpb = (const float*)d_in[4];
    a.conv_w = (const float*)d_in[5]; a.conv_b = (const float*)d_in[6]; a.lru_wa = (const float*)d_in[7]; a.lru_ba = (const float*)d_in[8]; a.lru_wx = (const float*)d_in[9];
    a.lru_bx = (const float*)d_in[10]; a.lru_lambda = (const float*)d_in[11]; a.w_branch = (const float*)d_in[12]; a.w_out = (const float*)d_in[13]; a.norm_ffn_g = (const float*)d_in[14];
    a.ffn_w_gu = (const float*)d_in[15]; a.ffn_w_down = (const float*)d_in[16]; a.router_w = (const float*)d_in[17]; a.moe_w_gu = (const float*)d_in[18]; a.moe_w_down = (const float*)d_in[19];
    a.final_g = (const float*)d_in[20];
    a.out = (float*)d_out; a.ws = (unsigned char*)d_ws;
    constexpr int NPH = 1 + 9 * DEPTH;
#ifndef PROBE_LO
#define PROBE_LO -1
#define PROBE_HI -1
#endif
    if (PROBE_LO >= 0) {
        a.ph_lo = 0; a.ph_hi = PROBE_HI; a.bar_region = 0; hipLaunchKernelGGL(enc_fwd, dim3(grid), dim3(NWAVES * 64), LDS_BYTES, stream, a);
        a.ph_lo = PROBE_LO; a.ph_hi = PROBE_HI; a.bar_region = 1; hipLaunchKernelGGL(enc_fwd, dim3(grid), dim3(NWAVES * 64), LDS_BYTES, stream, a);
        a.ph_lo = PROBE_HI; a.ph_hi = NPH; a.bar_region = 2; hipLaunchKernelGGL(enc_fwd, dim3(grid), dim3(NWAVES * 64), LDS_BYTES, stream, a);
    } else {
        a.ph_lo = 0; a.ph_hi = NPH; a.bar_region = 0;
        hipLaunchKernelGGL(enc_fwd, dim3(grid), dim3(NWAVES * 64), LDS_BYTES, stream, a);
    }
    const hipError_t le = hipPeekAtLastError();
    if (le != hipSuccess) fprintf(stderr, "kernel_launch: launch failed: %s\n", hipGetErrorName(le));
}
```
